# Optimizing an MI355X kernel written in HIP

```python
import math
import jax, jax.numpy as jnp
from jax import lax
import numpy as np

D_MODEL = 1024
BATCH = 32
SEQ = 256
DEPTH = 2
DEC_BATCH = 2
DEC_SEQ = 1024
PAST_LEN = 512

GRID_W = 64
HEAD_DIM = 64
N_Q_HEADS = 8
N_KV_HEADS = 2
Q_PER_KV = N_Q_HEADS // N_KV_HEADS
ATTN_W = N_Q_HEADS * HEAD_DIM
KV_W = N_KV_HEADS * HEAD_DIM
Q_BLOCK = 128
ROPE_THETA = 10000.0
ATTN_SCALE = HEAD_DIM ** -0.5
HY_W = 512
HY_SHORT = 3
HY_BANDS = 16
HY_EMB = 2 * HY_BANDS + 1
HY_FH = 64
HY_DECAY_MIN = math.log(100.0) / 1.5
HY_DECAY_MAX = math.log(100.0) / 0.3
LRU_W = 512
LRU_BLOCKS = 8
LRU_BS = LRU_W // LRU_BLOCKS
LRU_CONV = 4
LRU_C = 8.0
D_MIX = ATTN_W + HY_W + LRU_W
PROJ_SIZES = (ATTN_W, KV_W, KV_W, ATTN_W, HY_W, HY_W, HY_W, HY_W, LRU_W, LRU_W)
D_PROJ = sum(PROJ_SIZES)
PROJ_SPLITS = tuple(int(s) for s in np.cumsum(PROJ_SIZES)[:-1])
EPS = 1e-6
F32 = jnp.float32

kernel_name = 'hymba_flow_hybrid_step'


def rmsnorm(x, g):
    xf = x.astype(F32)
    y = xf * lax.rsqrt(jnp.mean(xf * xf, axis=-1, keepdims=True) + EPS)
    return (y * g.astype(F32)).astype(x.dtype)


def dwconv_centred(x, w, b):
    K = w.shape[0]
    L = x.shape[1]
    left = (K - 1) // 2
    xp = jnp.pad(x, ((0, 0), (left, K - 1 - left), (0, 0)))
    y = b
    for j in range(K):
        y = y + xp[:, j:j + L] * w[j]
    return y


def axial_rope(x):
    L = x.shape[1]
    rows = L // GRID_W
    row = jnp.repeat(jnp.arange(rows), GRID_W).astype(F32)
    col = jnp.tile(jnp.arange(GRID_W), rows).astype(F32)
    n_freq = HEAD_DIM // 4
    inv = ROPE_THETA ** (-jnp.arange(n_freq, dtype=F32) / n_freq)
    ang = jnp.concatenate([row[:, None] * inv, col[:, None] * inv], axis=-1)
    cos = jnp.cos(ang)[None, :, None, :]
    sin = jnp.sin(ang)[None, :, None, :]
    xf = x.astype(F32).reshape(x.shape[:-1] + (HEAD_DIM // 2, 2))
    x1, x2 = xf[..., 0], xf[..., 1]
    out = jnp.stack([x1 * cos - x2 * sin, x1 * sin + x2 * cos], axis=-1)
    return out.reshape(x.shape).astype(x.dtype)


def blocked_attention(q, k, v):
    B, Lq, H, Dh = q.shape
    nb = Lq // Q_BLOCK
    qb = q.reshape(B, nb, Q_BLOCK, N_KV_HEADS, Q_PER_KV, Dh).transpose(1, 0, 2, 3, 4, 5)

    def one_block(qblk):
        s = jnp.einsum('bqkgd,bskd->bkgqs', qblk, k).astype(F32) * ATTN_SCALE
        p = jax.nn.softmax(s, axis=-1).astype(v.dtype)
        return jnp.einsum('bkgqs,bskd->bqkgd', p, v)

    o = lax.map(one_block, qb)
    return o.transpose(1, 0, 2, 3, 4, 5).reshape(B, Lq, H * Dh)


def hyena_filter(L, p):
    t = jnp.linspace(0.0, 1.0, L, dtype=F32)[:, None]
    w = 2.0 * math.pi * jnp.arange(L, dtype=F32)[:, None] / L
    f = jnp.linspace(1e-4, HY_BANDS - 1, HY_BANDS, dtype=F32)[None, :]
    feats = jnp.concatenate([t, jnp.cos(f * w), -jnp.sin(f * w)], axis=-1)
    freq = p['hy_filt_freq'].astype(F32)
    hdn = jnp.sin(freq[0] * (feats @ p['hy_filt_w1'].astype(F32) + p['hy_filt_b1'].astype(F32)))
    hdn = jnp.sin(freq[1] * (hdn @ p['hy_filt_w2'].astype(F32) + p['hy_filt_b2'].astype(F32)))
    h = (hdn @ p['hy_filt_w3'].astype(F32)) * jnp.exp(-t * p['hy_filt_decay'].astype(F32))
    h_fwd, h_bwd = h[:, :HY_W], h[:, HY_W:]
    filt = jnp.concatenate([h_fwd, jnp.zeros((1, HY_W), F32), h_bwd[:0:-1]], axis=0)
    return filt / jnp.sum(jnp.abs(filt), axis=0, keepdims=True)


def long_conv(z, filt, bias):
    L = z.shape[1]
    zf = z.astype(F32)
    y = jnp.fft.irfft(jnp.fft.rfft(zf, n=2 * L, axis=1) * jnp.fft.rfft(filt, n=2 * L, axis=0)[None],
                      n=2 * L, axis=1)[:, :L]
    return (y + zf * bias.astype(F32)).astype(z.dtype)


def _lin_combine(e1, e2):
    a1, b1 = e1
    a2, b2 = e2
    return a1 * a2, a2 * b1 + b2


def rg_lru(xc, wa, ba, wx, bx, lam, h0, reverse):
    B, L, W = xc.shape
    xf = xc.astype(F32)
    xb = xf.reshape(B, L, LRU_BLOCKS, LRU_BS)
    r = jax.nn.sigmoid(jnp.einsum('blnc,ncd->blnd', xb, wa.astype(F32)).reshape(B, L, W) + ba.astype(F32))
    i = jax.nn.sigmoid(jnp.einsum('blnc,ncd->blnd', xb, wx.astype(F32)).reshape(B, L, W) + bx.astype(F32))
    log_a = -LRU_C * r * jax.nn.softplus(-lam.astype(F32))
    a = jnp.exp(log_a)
    b = jnp.sqrt(-jnp.expm1(2.0 * log_a)) * (i * xf)
    if reverse:
        a, b = a[:, ::-1], b[:, ::-1]
    b = b.at[:, 0].add(a[:, 0] * h0.astype(F32))
    _, hs = lax.associative_scan(_lin_combine, (a, b), axis=1)
    h_last = hs[:, -1]
    if reverse:
        hs = hs[:, ::-1]
    return hs, h_last


def mixer_layer(x, cvec, p, ctx_k=None, ctx_v=None, ctx_h=None):
    B, L, _ = x.shape
    latent = ctx_k is not None
    mod = jnp.dot(jax.nn.silu(cvec.astype(F32)), p['w_ada'].astype(F32)) + p['b_ada'].astype(F32)
    shift, scale, gate = jnp.split(mod[:, None, :], 3, axis=-1)
    h = (rmsnorm(x, p['norm_g']).astype(F32) * (1.0 + scale) + shift).astype(x.dtype)
    u = jnp.einsum('bld,de->ble', h, p['w_in'])
    q, k, v, g_attn, hy_x0, hy_x1, hy_v, g_hy, lru_x, g_lru = jnp.split(u, PROJ_SPLITS, axis=-1)

    q = rmsnorm(q.reshape(B, L, N_Q_HEADS, HEAD_DIM), p['q_norm_g'])
    k = rmsnorm(k.reshape(B, L, N_KV_HEADS, HEAD_DIM), p['k_norm_g'])
    v = v.reshape(B, L, N_KV_HEADS, HEAD_DIM)
    if latent:
        q = axial_rope(q)
        k_all = jnp.concatenate([ctx_k.astype(k.dtype), axial_rope(k)], axis=1)
        v_all = jnp.concatenate([ctx_v.astype(v.dtype), v], axis=1)
    else:
        k_all, v_all = k, v
    y_attn = blocked_attention(q, k_all, v_all)

    hz = dwconv_centred(jnp.concatenate([hy_x0, hy_x1, hy_v], axis=-1), p['hy_short_w'], p['hy_short_b'])
    x0, x1, hv = jnp.split(hz, 3, axis=-1)
    y_hy = x0 * long_conv(x1 * hv, hyena_filter(L, p), p['hy_bias'])

    xc = dwconv_centred(lru_x, p['lru_conv_w'], p['lru_conv_b'])
    h0 = ctx_h if latent else jnp.zeros((B, 2, LRU_W), F32)
    y_f, h_f = rg_lru(xc, p['lru_wa'][0], p['lru_ba'][0], p['lru_wx'][0], p['lru_bx'][0],
                      p['lru_lambda'][0], h0[:, 0], False)
    y_b, h_b = rg_lru(xc, p['lru_wa'][1], p['lru_ba'][1], p['lru_wx'][1], p['lru_bx'][1],
                      p['lru_lambda'][1], h0[:, 1], True)
    y_lru = (y_f + y_b).astype(x.dtype)

    mix = jnp.concatenate([y_attn * jax.nn.silu(g_attn), y_hy * jax.nn.silu(g_hy),
                           y_lru * jax.nn.silu(g_lru)], axis=-1)
    out = jnp.einsum('ble,ed->bld', mix, p['w_out'])
    x_new = (x.astype(F32) + gate * out.astype(F32)).astype(x.dtype)
    return x_new, k, v, jnp.stack([h_f, h_b], axis=1).astype(x.dtype)


def setup_inputs(seed: int = 0) -> dict:
    key = jax.random.key(seed)
    ks = iter(jax.random.split(key, 48))

    def nrm(shape, s):
        return jax.random.normal(next(ks), shape, F32) * s

    a_c = jax.random.uniform(next(ks), (DEPTH, 2, LRU_W), F32, 0.9, 0.999)
    sig = a_c ** (1.0 / LRU_C)
    return {
        'x_prompt': nrm((BATCH, SEQ, D_MODEL), 1.0),
        'x_sample': nrm((DEC_BATCH, DEC_SEQ, D_MODEL), 1.0),
        'cache_k': nrm((DEC_BATCH, DEPTH, PAST_LEN, N_KV_HEADS, HEAD_DIM), 1.0),
        'cache_v': nrm((DEC_BATCH, DEPTH, PAST_LEN, N_KV_HEADS, HEAD_DIM), 1.0),
        'state_lru': nrm((DEC_BATCH, DEPTH, 2, LRU_W), 0.5),
        'c': nrm((DEC_BATCH, D_MODEL), 1.0),
        'c_ctx': nrm((D_MODEL,), 1.0),
        'norm_g': 1.0 + nrm((DEPTH, D_MODEL), 0.02),
        'w_ada': nrm((DEPTH, D_MODEL, 3 * D_MODEL), D_MODEL ** -0.5),
        'b_ada': nrm((DEPTH, 3 * D_MODEL), 0.02),
        'w_in': nrm((DEPTH, D_MODEL, D_PROJ), D_MODEL ** -0.5),
        'q_norm_g': 1.0 + nrm((DEPTH, HEAD_DIM), 0.02),
        'k_norm_g': 1.0 + nrm((DEPTH, HEAD_DIM), 0.02),
        'hy_short_w': nrm((DEPTH, HY_SHORT, 3 * HY_W), HY_SHORT ** -0.5),
        'hy_short_b': nrm((DEPTH, 3 * HY_W), 0.02),
        'hy_filt_w1': nrm((DEPTH, HY_EMB, HY_FH), HY_EMB ** -0.5),
        'hy_filt_b1': nrm((DEPTH, HY_FH), 0.02),
        'hy_filt_w2': nrm((DEPTH, HY_FH, HY_FH), HY_FH ** -0.5),
        'hy_filt_b2': nrm((DEPTH, HY_FH), 0.02),
        'hy_filt_w3': nrm((DEPTH, HY_FH, 2 * HY_W), HY_FH ** -0.5),
        'hy_filt_freq': 1.0 + nrm((DEPTH, 2, HY_FH), 0.02),
        'hy_filt_decay': jax.random.uniform(next(ks), (DEPTH, 2 * HY_W), F32, HY_DECAY_MIN, HY_DECAY_MAX),
        'hy_bias': nrm((DEPTH, HY_W), 0.1),
        'lru_conv_w': nrm((DEPTH, LRU_CONV, LRU_W), LRU_CONV ** -0.5),
        'lru_conv_b': nrm((DEPTH, LRU_W), 0.02),
        'lru_wa': nrm((DEPTH, 2, LRU_BLOCKS, LRU_BS, LRU_BS), LRU_BS ** -0.5),
        'lru_ba': nrm((DEPTH, 2, LRU_W), 0.02),
        'lru_wx': nrm((DEPTH, 2, LRU_BLOCKS, LRU_BS, LRU_BS), LRU_BS ** -0.5),
        'lru_bx': nrm((DEPTH, 2, LRU_W), 0.02),
        'lru_lambda': jnp.log(sig) - jnp.log1p(-sig),
        'w_out': nrm((DEPTH, D_MIX, D_MODEL), D_MIX ** -0.5),
        'final_g': 1.0 + nrm((D_MODEL,), 0.02),
    }


def reference(x_prompt, x_sample, cache_k, cache_v, state_lru, c, c_ctx, norm_g, w_ada, b_ada, w_in,
              q_norm_g, k_norm_g, hy_short_w, hy_short_b, hy_filt_w1, hy_filt_b1, hy_filt_w2, hy_filt_b2,
              hy_filt_w3, hy_filt_freq, hy_filt_decay, hy_bias, lru_conv_w, lru_conv_b, lru_wa, lru_ba,
              lru_wx, lru_bx, lru_lambda, w_out, final_g):
    def layer_params(l):
        return {
            'norm_g': norm_g[l], 'w_ada': w_ada[l], 'b_ada': b_ada[l], 'w_in': w_in[l],
            'q_norm_g': q_norm_g[l], 'k_norm_g': k_norm_g[l],
            'hy_short_w': hy_short_w[l], 'hy_short_b': hy_short_b[l],
            'hy_filt_w1': hy_filt_w1[l], 'hy_filt_b1': hy_filt_b1[l],
            'hy_filt_w2': hy_filt_w2[l], 'hy_filt_b2': hy_filt_b2[l],
            'hy_filt_w3': hy_filt_w3[l], 'hy_filt_freq': hy_filt_freq[l],
            'hy_filt_decay': hy_filt_decay[l], 'hy_bias': hy_bias[l],
            'lru_conv_w': lru_conv_w[l], 'lru_conv_b': lru_conv_b[l],
            'lru_wa': lru_wa[l], 'lru_ba': lru_ba[l], 'lru_wx': lru_wx[l], 'lru_bx': lru_bx[l],
            'lru_lambda': lru_lambda[l], 'w_out': w_out[l],
        }

    y_p = x_prompt
    k_list, v_list, h_list = [], [], []
    for l in range(DEPTH):
        y_p, k_l, v_l, h_l = mixer_layer(y_p, c_ctx[None, :], layer_params(l))
        k_list.append(k_l)
        v_list.append(v_l)
        h_list.append(h_l)
    y_prompt = rmsnorm(y_p, final_g)
    new_k = jnp.stack(k_list, axis=1)
    new_v = jnp.stack(v_list, axis=1)
    new_lru = jnp.stack(h_list, axis=1)

    y_s = x_sample
    for l in range(DEPTH):
        y_s, _, _, _ = mixer_layer(y_s, c, layer_params(l), cache_k[:, l], cache_v[:, l], state_lru[:, l])
    y_sample = rmsnorm(y_s, final_g)
    return (y_prompt, y_sample, new_k, new_v, new_lru)
```

```cpp
#include <hip/hip_runtime.h>
#include <hip/hip_bf16.h>
#include <hip/hip_cooperative_groups.h>
#include <cstdio>
namespace cg = cooperative_groups;

typedef unsigned short u16;
using bf16x8 = __attribute__((ext_vector_type(8))) short;
using bf16x4 = __attribute__((ext_vector_type(4))) short;
using f32x4 = __attribute__((ext_vector_type(4))) float;

#define NT 512
constexpr int MROWS = 10240, MCTX = 8192, DM = 1024, DP = 4352, DMIX = 1536;
constexpr int LDS_BYTES = 131072 + 8192;
constexpr int OUT_YS = 8388608, OUT_K = 10485760, OUT_V = 12582912, OUT_LRU = 14680064;

constexpr size_t WS_WTIN = 0;
constexpr size_t WS_WTOUT = WS_WTIN + (size_t)2 * 4352 * 1024 * 2;
constexpr size_t WS_WGT = WS_WTOUT + (size_t)2 * 1024 * 1536 * 2;
constexpr size_t WS_MOD = WS_WGT + (size_t)2 * 2 * 2 * 8 * 64 * 64 * 2;
constexpr size_t WS_ROPE = WS_MOD + (size_t)2 * 3 * 3072 * 4;
constexpr size_t WS_HF = WS_ROPE + 8192;
constexpr size_t HF_LSTRIDE = 1310720;
constexpr size_t WS_NP = WS_HF + 2 * HF_LSTRIDE * 4;
constexpr size_t WS_CNT = WS_NP + (size_t)2 * 2 * 16 * 1024 * 4;
constexpr size_t WS_H = WS_CNT + 256;
constexpr size_t WS_U = WS_H + (size_t)MROWS * 1024 * 2;
constexpr size_t WS_KC = WS_U + (size_t)MROWS * DP * 2;
constexpr size_t WS_VC = WS_KC + (size_t)32 * 2 * 256 * 64 * 2;
constexpr size_t WS_KL = WS_VC + (size_t)32 * 2 * 256 * 64 * 2;
constexpr size_t WS_VL = WS_KL + (size_t)2 * 2 * 2 * 1536 * 64 * 2;
constexpr size_t WS_MIX = WS_VL + (size_t)2 * 2 * 2 * 1536 * 64 * 2;
constexpr size_t WS_X = WS_MIX + (size_t)MROWS * DMIX * 2;
constexpr size_t WS_END = WS_X + (size_t)MROWS * 1024 * 4;

struct P { const float* in[32]; float* out; char* ws; };

__device__ __forceinline__ u16 f2bf(float f) { unsigned u = __float_as_uint(f); u += 0x7fffu + ((u >> 16) & 1u); return (u16)(u >> 16); }
__device__ __forceinline__ float bf2f(u16 h) { return __uint_as_float(((unsigned)h) << 16); }
__device__ __forceinline__ float bfs(short h) { return __uint_as_float(((unsigned)(u16)h) << 16); }
__device__ __forceinline__ float siluf(float x) { return x / (1.f + __expf(-x)); }
__device__ __forceinline__ float sigm(float x) { return 1.f / (1.f + __expf(-x)); }

__device__ void p0_filter(const P& p, char* smem, int it) {
  const int l = it / 20, r = it % 20; const int sel = r >= 4; const int chunk = sel ? r - 4 : r;
  const int L = sel ? 1024 : 256;
  float* feats = (float*)smem;
  float* h1 = feats + 64 * 36;
  float* h2 = h1 + 64 * 64;
  const int tid = threadIdx.x;
  const float* w1 = p.in[15] + l * 33 * 64; const float* b1 = p.in[16] + l * 64;
  const float* w2 = p.in[17] + l * 64 * 64; const float* b2 = p.in[18] + l * 64;
  const float* w3 = p.in[19] + l * 64 * 1024; const float* fq = p.in[20] + l * 128; const float* dec = p.in[21] + l * 1024;
  for (int e = tid; e < 64 * 33; e += NT) {
    int tt = e / 33, j = e % 33; int t = chunk * 64 + tt; float v;
    if (j == 0) v = (float)t / (float)(L - 1);
    else { int i = (j - 1) & 15; float f = 1e-4f + (float)i * ((15.0f - 1e-4f) / 15.0f);
      float w = 6.283185307179586f * (float)t / (float)L; float a = f * w; v = (j <= 16) ? __cosf(a) : -__sinf(a); }
    feats[tt * 36 + j] = v;
  }
  __syncthreads();
  { const int j = tid & 63, tq = tid >> 6; float acc[8];
#pragma unroll
    for (int i = 0; i < 8; ++i) acc[i] = b1[j];
    for (int e = 0; e < 33; ++e) { float w = w1[e * 64 + j];
#pragma unroll
      for (int i = 0; i < 8; ++i) acc[i] += feats[(tq * 8 + i) * 36 + e] * w; }
    float f0 = fq[j];
#pragma unroll
    for (int i = 0; i < 8; ++i) h1[(tq * 8 + i) * 64 + j] = __sinf(f0 * acc[i]); }
  __syncthreads();
  { const int j = tid & 63, tq = tid >> 6; float acc[8];
#pragma unroll
    for (int i = 0; i < 8; ++i) acc[i] = b2[j];
    for (int e = 0; e < 64; ++e) { float w = w2[e * 64 + j];
#pragma unroll
      for (int i = 0; i < 8; ++i) acc[i] += h1[(tq * 8 + i) * 64 + e] * w; }
    float f1 = fq[64 + j];
#pragma unroll
    for (int i = 0; i < 8; ++i) h2[(tq * 8 + i) * 64 + j] = __sinf(f1 * acc[i]); }
  __syncthreads();
  float* HF = (float*)(p.ws + WS_HF) + (size_t)l * HF_LSTRIDE + (sel ? 262144 : 0);
  float* NP = (float*)(p.ws + WS_NP) + ((l * 2 + sel) * 16 + chunk) * 1024;
  { const int c2 = tid & 255, th = tid >> 8;
    float asum[4] = {0.f, 0.f, 0.f, 0.f}; float dq[4];
#pragma unroll
    for (int q = 0; q < 4; ++q) dq[q] = dec[c2 + 256 * q];
    for (int tb = 0; tb < 4; ++tb) {
      float acc[4][8];
#pragma unroll
      for (int q = 0; q < 4; ++q)
#pragma unroll
        for (int i = 0; i < 8; ++i) acc[q][i] = 0.f;
      for (int j4 = 0; j4 < 16; ++j4) {
        float w[4][4];
#pragma unroll
        for (int q = 0; q < 4; ++q)
#pragma unroll
          for (int jj = 0; jj < 4; ++jj) w[q][jj] = w3[(j4 * 4 + jj) * 1024 + c2 + 256 * q];
#pragma unroll
        for (int i = 0; i < 8; ++i) { const float4 hv = *(const float4*)(h2 + (th * 32 + tb * 8 + i) * 64 + j4 * 4);
#pragma unroll
          for (int q = 0; q < 4; ++q) acc[q][i] += hv.x * w[q][0] + hv.y * w[q][1] + hv.z * w[q][2] + hv.w * w[q][3]; }
      }
#pragma unroll
      for (int i = 0; i < 8; ++i) { const int t = chunk * 64 + th * 32 + tb * 8 + i; const float tv = (float)t / (float)(L - 1);
#pragma unroll
        for (int q = 0; q < 4; ++q) { const float v = acc[q][i] * expf(-tv * dq[q]); HF[(size_t)t * 1024 + c2 + 256 * q] = v;
          if (!(q >= 2 && t == 0)) asum[q] += fabsf(v); } }
    }
    float* red = feats;
#pragma unroll
    for (int q = 0; q < 4; ++q) red[th * 1024 + c2 + 256 * q] = asum[q];
    __syncthreads();
    for (int c = tid; c < 1024; c += NT) NP[c] = red[c] + red[1024 + c];
  }
  __syncthreads();
}

__device__ void p0_adaln(const P& p, char* smem, int it) {
  const int l = it / 96, j0 = (it % 96) * 32; const int tid = threadIdx.x;
  float* ss = (float*)smem;
  float* red = ss + 3072;
  for (int e = tid; e < 3072; e += NT) { int cv = e >> 10, k = e & 1023; float x = cv == 0 ? p.in[6][k] : p.in[5][(cv - 1) * 1024 + k]; ss[e] = x / (1.f + expf(-x)); }
  __syncthreads();
  const int c = tid & 31, kg = tid >> 5;
  const float* W = p.in[8] + (size_t)l * 1024 * 3072 + j0 + c;
  float a0 = 0.f, a1 = 0.f, a2 = 0.f;
#pragma unroll 8
  for (int k = kg * 64; k < kg * 64 + 64; ++k) { float w = W[(size_t)k * 3072]; a0 += ss[k] * w; a1 += ss[1024 + k] * w; a2 += ss[2048 + k] * w; }
  red[(kg * 3 + 0) * 32 + c] = a0; red[(kg * 3 + 1) * 32 + c] = a1; red[(kg * 3 + 2) * 32 + c] = a2;
  __syncthreads();
  if (tid < 96) { int cv = tid >> 5, cc = tid & 31; float s = p.in[9][l * 3072 + j0 + cc];
    for (int k = 0; k < 16; ++k) s += red[(k * 3 + cv) * 32 + cc];
    ((float*)(p.ws + WS_MOD))[(l * 3 + cv) * 3072 + j0 + cc] = s; }
  __syncthreads();
}

__device__ void p0_transpose(const float* src, u16* dst, int K, int N, int kt, int nt, char* smem) {
  float* T = (float*)smem;
  const int tid = threadIdx.x; const int r = tid >> 4, c4 = (tid & 15) * 4;
#pragma unroll
  for (int h = 0; h < 2; ++h) { int k = r + h * 32; float4 v = *(const float4*)(src + (size_t)(kt * 64 + k) * N + nt * 64 + c4);
    T[k * 65 + c4 + 0] = v.x; T[k * 65 + c4 + 1] = v.y; T[k * 65 + c4 + 2] = v.z; T[k * 65 + c4 + 3] = v.w; }
  __syncthreads();
  const int n = tid >> 3, k8 = (tid & 7) * 8; bf16x8 o;
#pragma unroll
  for (int i = 0; i < 8; ++i) o[i] = (short)f2bf(T[(k8 + i) * 65 + n]);
  *(bf16x8*)(dst + (size_t)(nt * 64 + n) * K + kt * 64 + k8) = o;
  __syncthreads();
}

__device__ void phase0(const P& p, char* smem) {
  const int G = gridDim.x;
  for (int it = blockIdx.x; it < 3176; it += G) {
    if (it < 40) p0_filter(p, smem, it);
    else if (it < 232) p0_adaln(p, smem, it - 40);
    else if (it < 2408) { int i = it - 232; int l = i / 1088, r = i % 1088; int nt = r / 16, kt = r % 16;
      p0_transpose(p.in[10] + (size_t)l * 1024 * 4352, (u16*)(p.ws + WS_WTIN) + (size_t)l * 4352 * 1024, 1024, 4352, kt, nt, smem); }
    else { int i = it - 2408; int l = i / 384, r = i % 384; int nt = r / 24, kt = r % 24;
      p0_transpose(p.in[30] + (size_t)l * 1536 * 1024, (u16*)(p.ws + WS_WTOUT) + (size_t)l * 1024 * 1536, 1536, 1024, kt, nt, smem); }
  }
  const int gt = blockIdx.x * NT + threadIdx.x, gn = G * NT;
  u16* KL = (u16*)(p.ws + WS_KL); u16* VL = (u16*)(p.ws + WS_VL);
  for (int idx = gt; idx < 2 * 2 * 2 * 512 * 64; idx += gn) {
    int d = idx & 63, pp = (idx >> 6) & 511, kvh = (idx >> 15) & 1, b = (idx >> 16) & 1, l = idx >> 17;
    size_t src = ((((size_t)b * 2 + l) * 512 + pp) * 2 + kvh) * 64 + d;
    KL[((size_t)((l * 2 + b) * 2 + kvh) * 1536 + pp) * 64 + d] = f2bf(p.in[2][src]);
    VL[((size_t)((l * 2 + b) * 2 + kvh) * 64 + d) * 1536 + pp] = f2bf(p.in[3][src]);
  }
  float* rope = (float*)(p.ws + WS_ROPE);
  for (int idx = gt; idx < 1024; idx += gn) { int pos = idx >> 4, fi = idx & 15; float inv = powf(10000.0f, -(float)fi / 16.0f); float a = (float)pos * inv;
    rope[idx * 2] = cosf(a); rope[idx * 2 + 1] = sinf(a); }
  u16* WGT = (u16*)(p.ws + WS_WGT);
  for (int idx = gt; idx < 2 * 2 * 2 * 8 * 64 * 64; idx += gn) {
    int c = idx & 63, d = (idx >> 6) & 63, n = (idx >> 12) & 7, gate = (idx >> 15) & 1, dir = (idx >> 16) & 1, l = idx >> 17;
    const float* src = gate ? p.in[27] : p.in[25];
    WGT[idx] = f2bf(src[((size_t)((l * 2 + dir) * 8 + n) * 64 + c) * 64 + d]);
  }
  if (gt < 64) ((int*)(p.ws + WS_CNT))[gt] = 0;
}

__device__ void norm_phase(const P& p, int layer) {
  const int wave = threadIdx.x >> 6, lane = threadIdx.x & 63;
  const float* X = (const float*)(p.ws + WS_X);
  u16* H = (u16*)(p.ws + WS_H);
  for (int row = blockIdx.x * 8 + wave; row < MROWS; row += gridDim.x * 8) {
    const float* x = layer == 0 ? (row < MCTX ? p.in[0] + (size_t)row * 1024 : p.in[1] + (size_t)(row - MCTX) * 1024) : X + (size_t)row * 1024;
    float4 v[4]; float ss = 0.f;
#pragma unroll
    for (int i = 0; i < 4; ++i) { v[i] = *(const float4*)(x + i * 256 + lane * 4); ss += v[i].x * v[i].x + v[i].y * v[i].y + v[i].z * v[i].z + v[i].w * v[i].w; }
#pragma unroll
    for (int o = 32; o >= 1; o >>= 1) ss += __shfl_xor(ss, o);
    const float rstd = rsqrtf(ss * (1.f / 1024.f) + 1e-6f);
    if (layer < 2) {
      const int cv = row < MCTX ? 0 : 1 + ((row - MCTX) >> 10);
      const float* md = (const float*)(p.ws + WS_MOD) + (layer * 3 + cv) * 3072;
      const float* g = p.in[7] + layer * 1024;
#pragma unroll
      for (int i = 0; i < 4; ++i) { const int k = i * 256 + lane * 4;
        float4 g4 = *(const float4*)(g + k), sh = *(const float4*)(md + k), sc = *(const float4*)(md + 1024 + k);
        bf16x4 o;
        o[0] = (short)f2bf(v[i].x * rstd * g4.x * (1.f + sc.x) + sh.x); o[1] = (short)f2bf(v[i].y * rstd * g4.y * (1.f + sc.y) + sh.y);
        o[2] = (short)f2bf(v[i].z * rstd * g4.z * (1.f + sc.z) + sh.z); o[3] = (short)f2bf(v[i].w * rstd * g4.w * (1.f + sc.w) + sh.w);
        *(bf16x4*)(H + (size_t)row * 1024 + k) = o; }
    } else {
      float* o = p.out + (row < MCTX ? (size_t)row * 1024 : (size_t)OUT_YS + (size_t)(row - MCTX) * 1024);
      const float* g = p.in[31];
#pragma unroll
      for (int i = 0; i < 4; ++i) { const int k = i * 256 + lane * 4; float4 g4 = *(const float4*)(g + k); float4 r;
        r.x = v[i].x * rstd * g4.x; r.y = v[i].y * rstd * g4.y; r.z = v[i].z * rstd * g4.z; r.w = v[i].w * rstd * g4.w;
        *(float4*)(o + k) = r; }
    }
  }
}

namespace pg8 {
#define PG8_LAS __attribute__((address_space(3)))
typedef unsigned short bf16_t;
typedef short bf16x8 __attribute__((ext_vector_type(8)));
typedef float f32x4 __attribute__((ext_vector_type(4)));
typedef unsigned u32x4 __attribute__((ext_vector_type(4)));
constexpr int BM = 256, BK = 64, HALF = 128, HTB = HALF * BK * 2  , STAGE_BYTES = 8 * HTB, NXCD = 8, WGM = 8;

__host__ __device__ __forceinline__ int lds_byte(int r, int c) { const int st = (r >> 4) * 2 + (c >> 5), rr = r & 15, cc = c & 31, ob = rr * 64 + cc * 2; return st * 1024 + (ob ^ (((ob >> 9) & 1) << 5)); }
__host__ __device__ __forceinline__ void stage_rc(int b, int& R, int& C) { const int st = b / 1024, sb = b % 1024, swz = sb ^ (((sb >> 9) & 1) << 5); R = (st >> 1) * 16 + swz / 64; C = (st & 1) * 32 + (swz % 64) / 2; }
__host__ __device__ __forceinline__ int perm32(int rho) { const int n = rho >> 4, i = rho & 15; return 8 * (i >> 2) + 4 * n + (i & 3); }

struct Unit { int pm, pn; };
struct Gemm { const bf16_t* A; const bf16_t* Bt; int M, N, K; };

struct StaticOrder {
    int nM, nN, nwg, G, c;
    __host__ __device__ void init(int M, int N, int G_, int c_) { nM = M / BM; nN = N / BM; nwg = nM * nN; G = G_; c = c_; }
    __host__ __device__ bool next(int i, Unit& u) const {
        const long L = (long)i * G + c; if (L >= nwg) return false;
        int wgid = (int)L; { const int q = nwg / NXCD, r = nwg % NXCD, xcd = wgid % NXCD, off = wgid / NXCD; wgid = (xcd < r ? xcd * (q + 1) : r * (q + 1) + (xcd - r) * q) + off; }
        const int nig = WGM * nN, gid = wgid / nig, fm = gid * WGM, gsz = (nM - fm) < WGM ? (nM - fm) : WGM;
        u.pm = fm + ((wgid % nig) % gsz); u.pn = (wgid % nig) / gsz; return true;
    }
    __device__ __forceinline__ void a_ready(const Unit&) const {}
    __device__ __forceinline__ void done(const Unit&) const {}
};
__device__ __forceinline__ unsigned cvt_pk_bf16(float lo, float hi) { unsigned r; asm volatile("v_cvt_pk_bf16_f32 %0, %1, %2" : "=v"(r) : "v"(lo), "v"(hi)); return r; }
template <class Epi, class Sched, bool STAMP = false>
__device__ __forceinline__ void gemm_phase(PG8_LAS unsigned char* lds, const Gemm g, const Sched& S, const Epi& E, unsigned long long* stamps) {
    const int tid = threadIdx.x, wid = __builtin_amdgcn_readfirstlane(tid >> 6), lane = tid & 63, wr = wid >> 2, wc = wid & 3, fr = lane & 15, fq = lane >> 4;
    const int K = g.K, nt = K / BK;
    int ts_lo = 0, ts_hi = 0, nts = 0; const unsigned long long rt_entry = STAMP ? (unsigned long long)wall_clock64() : 0ull;
#define PG8_STAMP() do { if (STAMP && wid == 0 && nts < 64) { const unsigned long long _c = (unsigned long long)clock64(); \
        ts_lo = (lane == nts) ? (int)(unsigned)_c : ts_lo; ts_hi = (lane == nts) ? (int)(unsigned)(_c >> 32) : ts_hi; ++nts; } } while (0)
    PG8_STAMP();
    unsigned voffA[2], voffB[2];
#pragma unroll
    for (int i = 0; i < 2; ++i) { int R, C; stage_rc(tid * 16 + i * 8192, R, C); const int Rb = Epi::PERM ? ((R & ~31) + perm32(R & 31)) : R;
        voffA[i] = (unsigned)(R * K + C) * 2u; voffB[i] = (unsigned)(Rb * K + C) * 2u; }
    const size_t kstep = (size_t)(BK * 2);
    const size_t hstep = (size_t)HALF * K * 2;
    const size_t tstep = 2 * hstep;
    const unsigned ldsw = (unsigned)wid * 1024u;
    const int aoff = lds_byte(wr * 64 + fr, fq * 8), boff = lds_byte(wc * 32 + fr, fq * 8);
#define PG8_SA(b, h) (((b) * 2 + (h)) * HTB)
#define PG8_SB(b, h) ((4 + (b) * 2 + (h)) * HTB)
#define PG8_STAGE(bufoff, gbase, voff) do { _Pragma("unroll") for (int _i = 0; _i < 2; ++_i) \
        __builtin_amdgcn_global_load_lds((const unsigned*)((const char*)(gbase) + (voff)[_i]), (PG8_LAS unsigned*)(lds + (bufoff) + ldsw + _i * 8192), 16, 0, 0); } while (0)
#define PG8_LDA(dst, b, h) do { _Pragma("unroll") for (int m = 0; m < 4; ++m) _Pragma("unroll") for (int k = 0; k < 2; ++k) dst[m][k] = *(const PG8_LAS bf16x8*)(lds + PG8_SA(b, h) + aoff + m * 2048 + k * 1024); } while (0)
#define PG8_LDB(dst, b, h) do { _Pragma("unroll") for (int n = 0; n < 2; ++n) _Pragma("unroll") for (int k = 0; k < 2; ++k) dst[n][k] = *(const PG8_LAS bf16x8*)(lds + PG8_SB(b, h) + boff + n * 2048 + k * 1024); } while (0)
#define PG8_MMA(ai, bj, At, Bt) do { __builtin_amdgcn_s_setprio(1); _Pragma("unroll") for (int m = 0; m < 4; ++m) _Pragma("unroll") for (int n = 0; n < 2; ++n) _Pragma("unroll") for (int k = 0; k < 2; ++k) \
        acc[ai][bj][m][n] = __builtin_amdgcn_mfma_f32_16x16x32_bf16(Bt[n][k], At[m][k], acc[ai][bj][m][n], 0, 0, 0); __builtin_amdgcn_s_setprio(0); } while (0)
#define PG8_WAIT_V(n) asm volatile("s_waitcnt vmcnt(" #n ")" ::: "memory")
#define PG8_WAIT_L(n) asm volatile("s_waitcnt lgkmcnt(" #n ")" ::: "memory")
#define PG8_BAR __builtin_amdgcn_s_barrier()
#define PG8_SCHED __builtin_amdgcn_sched_barrier(0)
    Unit cur, nxt; int ui = 0;
    if (!S.next(0, cur)) return;
    f32x4 acc[2][2][4][2];
#pragma unroll
    for (int a = 0; a < 2; ++a)
#pragma unroll
        for (int b = 0; b < 2; ++b)
#pragma unroll
            for (int m = 0; m < 4; ++m)
#pragma unroll
                for (int n = 0; n < 2; ++n) acc[a][b][m][n] = (f32x4){0.f, 0.f, 0.f, 0.f};
    bf16x8 At[4][2], B0[2][2], B1[2][2];
    const char* cA = (const char*)g.A + (size_t)cur.pm * tstep; const char* cB = (const char*)g.Bt + (size_t)cur.pn * tstep;
    S.a_ready(cur);
    PG8_STAGE(PG8_SB(0, 0), cB, voffB); PG8_STAGE(PG8_SA(0, 0), cA, voffA); PG8_STAGE(PG8_SB(0, 1), cB + hstep, voffB); PG8_STAGE(PG8_SA(0, 1), cA + hstep, voffA);
    if (wr == 1) PG8_BAR;
    PG8_WAIT_V(4); PG8_BAR;
    PG8_STAGE(PG8_SB(1, 0), cB + kstep, voffB); PG8_STAGE(PG8_SA(1, 0), cA + kstep, voffA); PG8_STAGE(PG8_SB(1, 1), cB + hstep + kstep, voffB);
    PG8_WAIT_V(6); PG8_BAR;
    PG8_STAMP();
    for (;;) {
        const bool has_next = S.next(ui + 1, nxt);
        const char* nA = has_next ? (const char*)g.A + (size_t)nxt.pm * tstep : cA; const char* nB = has_next ? (const char*)g.Bt + (size_t)nxt.pn * tstep : cB;
        for (int t = 0; t < nt; t += 2) {
            const bool last = (t == nt - 2);
            const char* a1 = cA + (size_t)(t + 1) * kstep;
            const char* a2 = last ? nA : cA + (size_t)(t + 2) * kstep; const char* b2 = last ? nB : cB + (size_t)(t + 2) * kstep;
            const char* a3 = a2 + kstep; const char* b3 = b2 + kstep;
            if (last && has_next) S.a_ready(nxt);
            PG8_LDB(B0, 0, 0); PG8_SCHED; PG8_LDA(At, 0, 0); PG8_STAGE(PG8_SA(1, 1), a1 + hstep, voffA);
            PG8_WAIT_L(8); PG8_BAR; PG8_WAIT_L(0); PG8_MMA(0, 0, At, B0); PG8_BAR; PG8_SCHED;
            PG8_LDB(B1, 0, 1); PG8_STAGE(PG8_SB(0, 0), b2, voffB);
            PG8_BAR; PG8_WAIT_L(0); PG8_MMA(0, 1, At, B1); PG8_BAR;
            PG8_LDA(At, 0, 1); PG8_STAGE(PG8_SA(0, 0), a2, voffA);
            PG8_BAR; PG8_WAIT_L(0); PG8_MMA(1, 0, At, B0); PG8_BAR; PG8_SCHED;
            PG8_STAGE(PG8_SB(0, 1), b2 + hstep, voffB);
            PG8_WAIT_V(6); PG8_BAR; PG8_MMA(1, 1, At, B1); PG8_BAR;
            PG8_LDB(B0, 1, 0); PG8_SCHED; PG8_LDA(At, 1, 0); PG8_STAGE(PG8_SA(0, 1), a2 + hstep, voffA);
            PG8_WAIT_L(8); PG8_BAR; PG8_WAIT_L(0); PG8_MMA(0, 0, At, B0); PG8_BAR; PG8_SCHED;
            PG8_LDB(B1, 1, 1); PG8_STAGE(PG8_SB(1, 0), b3, voffB);
            PG8_BAR; PG8_WAIT_L(0); PG8_MMA(0, 1, At, B1); PG8_BAR;
            PG8_LDA(At, 1, 1); PG8_STAGE(PG8_SA(1, 0), a3, voffA);
            PG8_BAR; PG8_WAIT_L(0); PG8_MMA(1, 0, At, B0); PG8_BAR; PG8_SCHED;
            PG8_STAGE(PG8_SB(1, 1), b3 + hstep, voffB);
            PG8_WAIT_V(6); PG8_BAR; PG8_MMA(1, 1, At, B1); PG8_BAR;
        }
        PG8_STAMP();
        if constexpr (!Epi::AFTER_DRAIN) { E(acc, cur, wr, wc, fr, fq); S.done(cur); }
        PG8_STAMP();
        if (!has_next) break;
#pragma unroll
        for (int a = 0; a < 2; ++a)
#pragma unroll
            for (int b = 0; b < 2; ++b)
#pragma unroll
                for (int m = 0; m < 4; ++m)
#pragma unroll
                    for (int n = 0; n < 2; ++n) acc[a][b][m][n] = (f32x4){0.f, 0.f, 0.f, 0.f};
        cur = nxt; cA = nA; cB = nB; ++ui;
    }
    PG8_WAIT_V(0);
    if (wr == 0) PG8_BAR;
    PG8_BAR;
    if constexpr (Epi::AFTER_DRAIN) { E.fused(acc, cur, wr, wc, fr, fq, lds, wid, lane); S.done(cur); }
    PG8_STAMP();
    if (STAMP && wid == 0) { stamps[lane] = lane < nts ? (((unsigned long long)(unsigned)ts_hi << 32) | (unsigned)ts_lo) : 0ull;
        if (lane == 62) stamps[62] = rt_entry; if (lane == 63) stamps[63] = (unsigned long long)wall_clock64(); }
#undef PG8_STAMP
#undef PG8_SA
#undef PG8_SB
#undef PG8_STAGE
#undef PG8_LDA
#undef PG8_LDB
#undef PG8_MMA
#undef PG8_WAIT_V
#undef PG8_WAIT_L
#undef PG8_BAR
#undef PG8_SCHED
}
}

struct EpiOut {
  static constexpr bool PERM = false, AFTER_DRAIN = false;
  const float* in0; const float* in1; char* ws; int layer;
  __device__ __forceinline__ void operator()(const f32x4 (&acc)[2][2][4][2], const pg8::Unit& u, int wr, int wc, int fr, int fq) const {
    const int brow = u.pm * 256; const int row0 = brow + wr * 64 + fr, col0 = u.pn * 256 + wc * 32 + 4 * fq;
    float* X = (float*)(ws + WS_X);
    const int cv = brow < MCTX ? 0 : 1 + ((brow - MCTX) >> 10);
    const float* gate = (const float*)(ws + WS_MOD) + (layer * 3 + cv) * 3072 + 2048;
    const float* xin = layer == 0 ? (brow < MCTX ? in0 : in1 - (size_t)MCTX * 1024) : X;
    f32x4 gv[2][2];
#pragma unroll
    for (int bj = 0; bj < 2; ++bj)
#pragma unroll
      for (int n = 0; n < 2; ++n) gv[bj][n] = *(const f32x4*)(gate + col0 + bj * 128 + n * 16);
#pragma unroll
    for (int ai = 0; ai < 2; ++ai)
#pragma unroll
      for (int m = 0; m < 4; ++m) { const size_t ro = (size_t)(row0 + ai * 128 + m * 16) * 1024 + col0;
#pragma unroll
        for (int bj = 0; bj < 2; ++bj)
#pragma unroll
          for (int n = 0; n < 2; ++n) { const f32x4 xv = *(const f32x4*)(xin + ro + bj * 128 + n * 16);
            *(f32x4*)(X + ro + bj * 128 + n * 16) = xv + gv[bj][n] * acc[ai][bj][m][n]; } }
  }
};

struct EpiIn {
  static constexpr bool PERM = true, AFTER_DRAIN = false;
  const float* qg; const float* kg; float* out; char* ws; float* sSS; int layer;
  template <int KIND>
  __device__ __forceinline__ void half(const f32x4 (&acc)[2][2][4][2], const int bj, const int brow, const int pn, const bool lat, int wr, int wc, int fr, int fq) const {
    u16* U = (u16*)(ws + WS_U);
    const float* rope = (const float*)(ws + WS_ROPE);
    const int dh = (wc & 1) * 32 + 8 * fq;
    const int hd = wc >> 1;
    float gn[8];
    if (KIND <= 1) { const float* gp = (KIND == 0 ? qg : kg) + layer * 64 + dh;
      const f32x4 g0 = *(const f32x4*)gp, g1 = *(const f32x4*)(gp + 4);
      gn[0] = g0[0]; gn[1] = g0[1]; gn[2] = g0[2]; gn[3] = g0[3]; gn[4] = g1[0]; gn[5] = g1[1]; gn[6] = g1[2]; gn[7] = g1[3]; }
#pragma unroll
    for (int ai = 0; ai < 2; ++ai)
#pragma unroll
      for (int m = 0; m < 4; ++m) {
        const int rl = ai * 128 + wr * 64 + m * 16 + fr; const int row = brow + rl;
        const f32x4 v0 = acc[ai][bj][m][0], v1 = acc[ai][bj][m][1];
        float v[8] = {v0[0], v0[1], v0[2], v0[3], v1[0], v1[1], v1[2], v1[3]};
        if (KIND <= 1) {
          const float tot = sSS[(bj * 256 + rl) * 4 + wc] + sSS[(bj * 256 + rl) * 4 + (wc ^ 1)];
          const float rstd = rsqrtf(tot * (1.f / 64.f) + 1e-6f);
#pragma unroll
          for (int i = 0; i < 8; ++i) v[i] = v[i] * rstd * gn[i];
          if (KIND == 1 && !lat) { const int b = row >> 8, t = row & 255; float* op = out + (size_t)OUT_K + ((size_t)((b * 2 + layer) * 256 + t)) * 128 + hd * 64 + dh;
            *(f32x4*)op = (f32x4){v[0], v[1], v[2], v[3]}; *(f32x4*)(op + 4) = (f32x4){v[4], v[5], v[6], v[7]}; }
          if (lat) {
            const int t = (row - MCTX) & 1023; const int posv = (wc & 1) ? (t & 63) : (t >> 6);
            const float* rp = rope + (posv * 16 + 4 * fq) * 2;
            const f32x4 r0 = *(const f32x4*)rp, r1 = *(const f32x4*)(rp + 4);
            float x1, x2;
            x1 = v[0]; x2 = v[1]; v[0] = x1 * r0[0] - x2 * r0[1]; v[1] = x1 * r0[1] + x2 * r0[0];
            x1 = v[2]; x2 = v[3]; v[2] = x1 * r0[2] - x2 * r0[3]; v[3] = x1 * r0[3] + x2 * r0[2];
            x1 = v[4]; x2 = v[5]; v[4] = x1 * r1[0] - x2 * r1[1]; v[5] = x1 * r1[1] + x2 * r1[0];
            x1 = v[6]; x2 = v[7]; v[6] = x1 * r1[2] - x2 * r1[3]; v[7] = x1 * r1[3] + x2 * r1[2];
          }
          pg8::u32x4 w;
          if (KIND == 0) { w.x = pg8::cvt_pk_bf16(v[0] * 0.125f, v[1] * 0.125f); w.y = pg8::cvt_pk_bf16(v[2] * 0.125f, v[3] * 0.125f); w.z = pg8::cvt_pk_bf16(v[4] * 0.125f, v[5] * 0.125f); w.w = pg8::cvt_pk_bf16(v[6] * 0.125f, v[7] * 0.125f);
            *(pg8::u32x4*)(U + (size_t)row * DP + pn * 256 + bj * 128 + wc * 32 + 8 * fq) = w; }
          else { w.x = pg8::cvt_pk_bf16(v[0], v[1]); w.y = pg8::cvt_pk_bf16(v[2], v[3]); w.z = pg8::cvt_pk_bf16(v[4], v[5]); w.w = pg8::cvt_pk_bf16(v[6], v[7]);
            if (!lat) { const int b = row >> 8, t = row & 255; *(pg8::u32x4*)((u16*)(ws + WS_KC) + ((size_t)((b * 2 + hd) * 256 + t)) * 64 + dh) = w; }
            else { const int sb = (row - MCTX) >> 10, t = (row - MCTX) & 1023; *(pg8::u32x4*)((u16*)(ws + WS_KL) + ((size_t)(((layer * 2 + sb) * 2 + hd) * 1536 + 512 + t)) * 64 + dh) = w; } }
        } else {
          if (!lat) { const int b = row >> 8, t = row & 255; float* op = out + (size_t)OUT_V + ((size_t)((b * 2 + layer) * 256 + t)) * 128 + hd * 64 + dh;
            *(f32x4*)op = (f32x4){v[0], v[1], v[2], v[3]}; *(f32x4*)(op + 4) = (f32x4){v[4], v[5], v[6], v[7]};
            u16* vp = (u16*)(ws + WS_VC) + ((size_t)((b * 2 + hd) * 64 + dh)) * 256 + t;
#pragma unroll
            for (int i = 0; i < 8; ++i) vp[i * 256] = f2bf(v[i]); }
          else { const int sb = (row - MCTX) >> 10, t = (row - MCTX) & 1023;
            u16* vp = (u16*)(ws + WS_VL) + ((size_t)(((layer * 2 + sb) * 2 + hd) * 64 + dh)) * 1536 + 512 + t;
#pragma unroll
            for (int i = 0; i < 8; ++i) vp[i * 1536] = f2bf(v[i]); }
        }
      }
  }
  __device__ __forceinline__ void operator()(const f32x4 (&acc)[2][2][4][2], const pg8::Unit& u, int wr_, int wc_, int fr_, int fq_) const {
    int tid2; asm volatile("v_mov_b32 %0, %1" : "=v"(tid2) : "v"((int)threadIdx.x));
    const int wid = tid2 >> 6, lane = tid2 & 63, wr = wid >> 2, wc = wid & 3, fr = lane & 15, fq = lane >> 4;
    const int brow = u.pm * 256, pn = u.pn; const bool lat = brow >= MCTX;
    u16* U = (u16*)(ws + WS_U);
    if (pn >= 3) {
#pragma unroll
      for (int ai = 0; ai < 2; ++ai)
#pragma unroll
        for (int m = 0; m < 4; ++m) { u16* rowp = U + (size_t)(brow + ai * 128 + wr * 64 + m * 16 + fr) * DP + pn * 256 + wc * 32 + 8 * fq;
#pragma unroll
          for (int bj = 0; bj < 2; ++bj) { const f32x4 v0 = acc[ai][bj][m][0], v1 = acc[ai][bj][m][1]; pg8::u32x4 w;
            w.x = pg8::cvt_pk_bf16(v0[0], v0[1]); w.y = pg8::cvt_pk_bf16(v0[2], v0[3]); w.z = pg8::cvt_pk_bf16(v1[0], v1[1]); w.w = pg8::cvt_pk_bf16(v1[2], v1[3]);
            *(pg8::u32x4*)(rowp + bj * 128) = w; } }
      return;
    }
    const bool kvtile = pn == 2;
#pragma unroll
    for (int ai = 0; ai < 2; ++ai)
#pragma unroll
      for (int m = 0; m < 4; ++m)
#pragma unroll
        for (int bj = 0; bj < 2; ++bj) {
          const f32x4 v0 = acc[ai][bj][m][0], v1 = acc[ai][bj][m][1];
          float s = v0[0] * v0[0] + v0[1] * v0[1] + v0[2] * v0[2] + v0[3] * v0[3] + v1[0] * v1[0] + v1[1] * v1[1] + v1[2] * v1[2] + v1[3] * v1[3];
          s += __shfl_xor(s, 16); s += __shfl_xor(s, 32);
          if (fq == 0) sSS[(bj * 256 + ai * 128 + wr * 64 + m * 16 + fr) * 4 + wc] = s;
        }
    asm volatile("s_waitcnt lgkmcnt(0)" ::: "memory");
    __builtin_amdgcn_s_barrier();
    asm volatile("" ::: "memory");
    if (kvtile) { half<1>(acc, 0, brow, pn, lat, wr, wc, fr, fq); half<2>(acc, 1, brow, pn, lat, wr, wc, fr, fq); }
    else { half<0>(acc, 0, brow, pn, lat, wr, wc, fr, fq); half<0>(acc, 1, brow, pn, lat, wr, wc, fr, fq); }
  }
};

template <int EPI>
__device__ void gemm_phase(const P& p, const int layer, char* smem) {
  pg8::Gemm g;
  g.M = MROWS;
  if (EPI == 0) { g.A = (const u16*)(p.ws + WS_H); g.Bt = (const u16*)(p.ws + WS_WTIN) + (size_t)layer * 4352 * 1024; g.N = 4352; g.K = 1024; }
  else { g.A = (const u16*)(p.ws + WS_MIX); g.Bt = (const u16*)(p.ws + WS_WTOUT) + (size_t)layer * 1024 * 1536; g.N = 1024; g.K = 1536; }
  pg8::StaticOrder S; S.init(g.M, g.N, (int)gridDim.x, (int)blockIdx.x);
  if (EPI == 0) { EpiIn E{p.in[11], p.in[12], p.out, p.ws, (float*)(smem + 131072), layer};
    pg8::gemm_phase<EpiIn, pg8::StaticOrder, false>((PG8_LAS unsigned char*)smem, g, S, E, nullptr); }
  else { EpiOut E{p.in[0], p.in[1], p.ws, layer};
    pg8::gemm_phase<EpiOut, pg8::StaticOrder, false>((PG8_LAS unsigned char*)smem, g, S, E, nullptr); }
  __syncthreads();
}

__device__ __forceinline__ f32x4 mfma16(bf16x8 a, bf16x8 b, f32x4 c) { return __builtin_amdgcn_mfma_f32_16x16x32_bf16(a, b, c, 0, 0, 0); }

__device__ void attn_item(const P& p, int layer, int lat, int sb, int h, int qt, char* smem) {
  const int tid = threadIdx.x, w = tid >> 6, lane = tid & 63, lr = lane & 15, g = lane >> 4;
  const int qg = w & 3, ksp = w >> 2, kvh = h >> 2;
  const int nkeys = lat ? 1536 : 256;
  const int m0 = lat ? (MCTX + sb * 1024 + qt * 64) : (sb * 256 + qt * 64);
  const u16* U = (const u16*)(p.ws + WS_U);
  const u16* Kb = lat ? (const u16*)(p.ws + WS_KL) + (size_t)((layer * 2 + sb) * 2 + kvh) * 1536 * 64 : (const u16*)(p.ws + WS_KC) + (size_t)(sb * 2 + kvh) * 256 * 64;
  const u16* Vt = lat ? (const u16*)(p.ws + WS_VL) + (size_t)((layer * 2 + sb) * 2 + kvh) * 64 * 1536 : (const u16*)(p.ws + WS_VC) + (size_t)(sb * 2 + kvh) * 64 * 256;
  u16* sK = (u16*)smem;
  u16* sV = sK + 128 * 72;
  float* sC = (float*)(sV + 64 * 144);
  const int qrow = m0 + qg * 16 + lr;
  bf16x8 qf[2];
  qf[0] = *(const bf16x8*)(U + (size_t)qrow * DP + h * 64 + g * 8);
  qf[1] = *(const bf16x8*)(U + (size_t)qrow * DP + h * 64 + 32 + g * 8);
  f32x4 o[4];
#pragma unroll
  for (int i = 0; i < 4; ++i) o[i] = (f32x4){0.f, 0.f, 0.f, 0.f};
  float mrun = -1e30f, lsum = 0.f;
  for (int k0 = 0; k0 < nkeys; k0 += 128) {
    __syncthreads();
#pragma unroll
    for (int i = 0; i < 2; ++i) { int id = tid + i * 512; int key = id >> 3, part = id & 7;
      *(bf16x8*)(sK + key * 72 + part * 8) = *(const bf16x8*)(Kb + (size_t)(k0 + key) * 64 + part * 8); }
#pragma unroll
    for (int i = 0; i < 2; ++i) { int id = tid + i * 512; int d = id >> 4, part = id & 15;
      *(bf16x8*)(sV + d * 144 + part * 8) = *(const bf16x8*)(Vt + (size_t)d * nkeys + k0 + part * 8); }
    __syncthreads();
    f32x4 s[4];
#pragma unroll
    for (int mt = 0; mt < 4; ++mt) { s[mt] = (f32x4){0.f, 0.f, 0.f, 0.f};
#pragma unroll
      for (int kk = 0; kk < 2; ++kk) { bf16x8 a = *(const bf16x8*)(sK + (ksp * 64 + mt * 16 + lr) * 72 + kk * 32 + g * 8); s[mt] = mfma16(a, qf[kk], s[mt]); } }
    float mx = -1e30f;
#pragma unroll
    for (int mt = 0; mt < 4; ++mt)
#pragma unroll
      for (int r = 0; r < 4; ++r) mx = fmaxf(mx, s[mt][r]);
    mx = fmaxf(mx, __shfl_xor(mx, 16)); mx = fmaxf(mx, __shfl_xor(mx, 32));
    const float mnew = fmaxf(mrun, mx); const float alpha = __expf(mrun - mnew); mrun = mnew;
    float ps = 0.f;
#pragma unroll
    for (int mt = 0; mt < 4; ++mt)
#pragma unroll
      for (int r = 0; r < 4; ++r) { float pv = __expf(s[mt][r] - mnew); s[mt][r] = pv; ps += pv; }
    lsum = lsum * alpha + ps;
#pragma unroll
    for (int dt = 0; dt < 4; ++dt) { o[dt][0] *= alpha; o[dt][1] *= alpha; o[dt][2] *= alpha; o[dt][3] *= alpha; }
#pragma unroll
    for (int j = 0; j < 2; ++j) {
      bf16x8 pf;
#pragma unroll
      for (int i = 0; i < 4; ++i) { pf[i] = (short)f2bf(s[2 * j][i]); pf[4 + i] = (short)f2bf(s[2 * j + 1][i]); }
#pragma unroll
      for (int dt = 0; dt < 4; ++dt) {
        const u16* vp = sV + (dt * 16 + lr) * 144 + ksp * 64 + j * 32 + g * 4;
        bf16x4 v0 = *(const bf16x4*)vp, v1 = *(const bf16x4*)(vp + 16);
        bf16x8 a; a[0] = v0[0]; a[1] = v0[1]; a[2] = v0[2]; a[3] = v0[3]; a[4] = v1[0]; a[5] = v1[1]; a[6] = v1[2]; a[7] = v1[3];
        o[dt] = mfma16(a, pf, o[dt]);
      }
    }
  }
  lsum += __shfl_xor(lsum, 16); lsum += __shfl_xor(lsum, 32);
  __syncthreads();
  float* cb = sC + (qg * 18) * 64 + lane;
  if (ksp == 1) { cb[0] = mrun; cb[64] = lsum;
#pragma unroll
    for (int dt = 0; dt < 4; ++dt)
#pragma unroll
      for (int r = 0; r < 4; ++r) cb[(2 + dt * 4 + r) * 64] = o[dt][r]; }
  __syncthreads();
  if (ksp == 0) {
    const float m1 = cb[0], l1 = cb[64]; const float mm = fmaxf(mrun, m1); const float a0 = __expf(mrun - mm), a1 = __expf(m1 - mm);
    const float inv = 1.f / (lsum * a0 + l1 * a1);
    u16* MIX = (u16*)(p.ws + WS_MIX);
#pragma unroll
    for (int dt = 0; dt < 4; ++dt) {
      bf16x4 gv = *(const bf16x4*)(U + (size_t)qrow * DP + 768 + h * 64 + dt * 16 + g * 4);
      bf16x4 ov;
#pragma unroll
      for (int r = 0; r < 4; ++r) { float val = (o[dt][r] * a0 + cb[(2 + dt * 4 + r) * 64] * a1) * inv; ov[r] = (short)f2bf(val * siluf(bfs(gv[r]))); }
      *(bf16x4*)(MIX + (size_t)qrow * DMIX + h * 64 + dt * 16 + g * 4) = ov;
    }
  }
  __syncthreads();
}

template <int L, int CH>
__device__ void hyena_item(const P& p, int layer, int m0, int c0, char* smem) {
  constexpr int SEL = (L == 1024) ? 1 : 0;
  float* sz = (float*)smem;
  float* sG = sz + L * CH;
  float* sInv = sG + (2 * L - 1) * CH;
  const int tid = threadIdx.x;
  const float* HF = (const float*)(p.ws + WS_HF) + (size_t)layer * HF_LSTRIDE + (SEL ? 262144 : 0);
  const float* NP = (const float*)(p.ws + WS_NP) + (layer * 2 + SEL) * 16 * 1024;
  const u16* U = (const u16*)(p.ws + WS_U);
  const float* sw = p.in[13] + layer * 3 * 1536; const float* sbias = p.in[14] + layer * 1536;
  if (tid < CH) { float s = 0.f; for (int ch = 0; ch < L / 64; ++ch) s += NP[ch * 1024 + c0 + tid] + NP[ch * 1024 + 512 + c0 + tid]; sInv[tid] = 1.f / s; }
  __syncthreads();
  for (int e = tid; e < (2 * L - 1) * CH; e += NT) { const int xi = e / CH, c = e % CH; const int x = xi - (L - 1);
    float v = x >= 0 ? HF[(size_t)x * 1024 + c0 + c] : HF[(size_t)(-x) * 1024 + 512 + c0 + c]; sG[e] = v * sInv[c]; }
  for (int e = tid; e < L * CH; e += NT) { const int t = e / CH, c = e % CH; const int ch = c0 + c;
    float a = sbias[512 + ch], b = sbias[1024 + ch];
#pragma unroll
    for (int j = 0; j < 3; ++j) { const int tt = t + j - 1; if (tt >= 0 && tt < L) {
        a += bf2f(U[(size_t)(m0 + tt) * DP + 1792 + ch]) * sw[j * 1536 + 512 + ch];
        b += bf2f(U[(size_t)(m0 + tt) * DP + 2304 + ch]) * sw[j * 1536 + 1024 + ch]; } }
    sz[e] = a * b; }
  __syncthreads();
  const int c = tid % CH, tg = tid / CH, t0 = tg * 16; const int ch = c0 + c;
  float y[16], R[16];
#pragma unroll
  for (int i = 0; i < 16; ++i) y[i] = 0.f;
  R[0] = 0.f;
#pragma unroll
  for (int k = 1; k < 16; ++k) R[k] = sG[(t0 + k + L - 1) * CH + c];
  const float* gp = sG + (t0 + L - 1) * CH + c;
  const float* zp = sz + c;
  for (int s0 = 0; s0 < L; s0 += 16) {
#pragma unroll
    for (int u = 0; u < 16; ++u) {
      R[(16 - u) & 15] = gp[-(s0 + u) * CH];
      const float zs = zp[(s0 + u) * CH];
#pragma unroll
      for (int i = 0; i < 16; ++i) y[i] += R[(i - u) & 15] * zs;
    }
  }
  const float bias = p.in[22][layer * 512 + ch];
  const float w0 = sw[ch], w1 = sw[1536 + ch], w2 = sw[2 * 1536 + ch], bb = sbias[ch];
  u16* MIX = (u16*)(p.ws + WS_MIX);
#pragma unroll
  for (int i = 0; i < 16; ++i) { const int t = t0 + i;
    float x0 = bb + w1 * bf2f(U[(size_t)(m0 + t) * DP + 1280 + ch]);
    if (t > 0) x0 += w0 * bf2f(U[(size_t)(m0 + t - 1) * DP + 1280 + ch]);
    if (t < L - 1) x0 += w2 * bf2f(U[(size_t)(m0 + t + 1) * DP + 1280 + ch]);
    const float gv = bf2f(U[(size_t)(m0 + t) * DP + 2816 + ch]);
    const float val = x0 * (y[i] + bias * sz[t * CH + c]) * siluf(gv);
    MIX[(size_t)(m0 + t) * DMIX + 512 + ch] = f2bf(val); }
  __syncthreads();
}

__device__ void lru_item(const P& p, int layer, int lat, int sb, int n, int qd, char* smem) {
  const int L = lat ? 1024 : 256; const int m0 = lat ? MCTX + sb * 1024 : sb * 256;
  const int tid = threadIdx.x, w = tid >> 6, lane = tid & 63, lr = lane & 15, g = lane >> 4;
  u16* sW = (u16*)smem;
  float* sCw = (float*)(smem + 4608);
  float* sX = (float*)(smem + 6144);
  float* sTot = (float*)(smem + 6144 + 33280);
  float* sCar = sTot + 512;
  float* Yf = (float*)(p.ws + WS_H);
  const u16* U = (const u16*)(p.ws + WS_U);
  u16* MIX = (u16*)(p.ws + WS_MIX);
  const u16* WGT = (const u16*)(p.ws + WS_WGT);
  const int chb = n * 64; const int dch = chb + qd * 16 + lr;
  if (tid < 320) sCw[tid] = tid < 256 ? p.in[23][layer * 4 * 512 + (tid >> 6) * 512 + chb + (tid & 63)] : p.in[24][layer * 512 + chb + tid - 256];
  for (int dir = 0; dir < 2; ++dir) {
    __syncthreads();
    if (tid < 256) { const int gate = tid >> 7, d = (tid >> 3) & 15, part = tid & 7;
      *(bf16x8*)(sW + (gate * 16 + d) * 72 + part * 8) = *(const bf16x8*)(WGT + ((size_t)((((layer * 2 + dir) * 2 + gate) * 8 + n) * 64 + qd * 16 + d)) * 64 + part * 8); }
    if (tid < 16) sCar[tid] = lat ? p.in[4][((sb * 2 + layer) * 2 + dir) * 512 + chb + qd * 16 + tid] : 0.f;
    const float ba = p.in[26][(layer * 2 + dir) * 512 + dch], bx = p.in[28][(layer * 2 + dir) * 512 + dch];
    const float lam = p.in[29][(layer * 2 + dir) * 512 + dch];
    const float sp = log1pf(expf(-lam));
    __syncthreads();
    bf16x8 wrf[2], wif[2];
#pragma unroll
    for (int ks = 0; ks < 2; ++ks) { wrf[ks] = *(const bf16x8*)(sW + (lr) * 72 + ks * 32 + g * 8); wif[ks] = *(const bf16x8*)(sW + (16 + lr) * 72 + ks * 32 + g * 8); }
    const int nch = L >> 7;
    for (int ci = 0; ci < nch; ++ci) {
      const int par = ci & 1; const int pbase = ci * 128 + w * 16;
      const int pA = pbase + lr; const int tA = dir ? L - 1 - pA : pA;
      bf16x8 af[2];
#pragma unroll
      for (int ks = 0; ks < 2; ++ks) {
        const int cb = ks * 32 + g * 8; float a8[8];
#pragma unroll
        for (int i = 0; i < 8; ++i) a8[i] = sCw[256 + cb + i];
#pragma unroll
        for (int j = 0; j < 4; ++j) { const int tt = tA + j - 1;
          if (tt >= 0 && tt < L) { bf16x8 xv = *(const bf16x8*)(U + (size_t)(m0 + tt) * DP + 3328 + chb + cb);
#pragma unroll
            for (int i = 0; i < 8; ++i) a8[i] += bfs(xv[i]) * sCw[j * 64 + cb + i]; } }
#pragma unroll
        for (int i = 0; i < 8; ++i) { sX[(w * 16 + lr) * 65 + cb + i] = a8[i]; af[ks][i] = (short)f2bf(a8[i]); }
      }
      f32x4 pr = (f32x4){0.f, 0.f, 0.f, 0.f}, pi = (f32x4){0.f, 0.f, 0.f, 0.f};
#pragma unroll
      for (int ks = 0; ks < 2; ++ks) { pr = mfma16(af[ks], wrf[ks], pr); pi = mfma16(af[ks], wif[ks], pi); }
      float Ap[4], Bp[4];
#pragma unroll
      for (int r = 0; r < 4; ++r) {
        const float x = sX[(w * 16 + 4 * g + r) * 65 + qd * 16 + lr];
        const float rr = sigm(pr[r] + ba), ii = sigm(pi[r] + bx);
        const float la = -8.f * rr * sp; const float a = expf(la); const float b = sqrtf(-expm1f(2.f * la)) * ii * x;
        if (r == 0) { Ap[0] = a; Bp[0] = b; } else { Ap[r] = a * Ap[r - 1]; Bp[r] = a * Bp[r - 1] + b; }
      }
      const float A4 = Ap[3], B4 = Bp[3];
      float EA = 1.f, EB = 0.f, TA = 1.f, TB = 0.f;
#pragma unroll
      for (int k = 0; k < 4; ++k) { const float ak = __shfl(A4, lr + 16 * k), bk = __shfl(B4, lr + 16 * k);
        if (k < g) { EB = ak * EB + bk; EA = ak * EA; }
        TB = ak * TB + bk; TA = ak * TA; }
      if (g == 0) { sTot[((par * 8 + w) * 2 + 0) * 16 + lr] = TA; sTot[((par * 8 + w) * 2 + 1) * 16 + lr] = TB; }
      __syncthreads();
      float hin = sCar[par * 16 + lr];
      for (int k = 0; k < 7; ++k) { if (k < w) { const float ak = sTot[((par * 8 + k) * 2 + 0) * 16 + lr], bk = sTot[((par * 8 + k) * 2 + 1) * 16 + lr]; hin = ak * hin + bk; } }
      if (w == 7 && g == 0) sCar[(par ^ 1) * 16 + lr] = TA * hin + TB;
      const float hg = EA * hin + EB;
#pragma unroll
      for (int r = 0; r < 4; ++r) {
        const float hv = Ap[r] * hg + Bp[r];
        const int pp = pbase + 4 * g + r; const int t = dir ? L - 1 - pp : pp;
        if (dir == 0) Yf[(size_t)(m0 + t) * 512 + dch] = hv;
        else { const float yv = Yf[(size_t)(m0 + t) * 512 + dch] + hv; const float gl = bf2f(U[(size_t)(m0 + t) * DP + 3840 + dch]);
          MIX[(size_t)(m0 + t) * DMIX + 1024 + dch] = f2bf(yv * siluf(gl)); }
        if (!lat && pp == L - 1) p.out[(size_t)OUT_LRU + ((sb * 2 + layer) * 2 + dir) * 512 + dch] = hv;
      }
    }
  }
  __syncthreads();
}

__device__ void mixers_phase(const P& p, int layer, char* smem) {
  __shared__ int s_item;
  int* cnt = (int*)(p.ws + WS_CNT) + layer;
  for (;;) {
    if (threadIdx.x == 0) s_item = atomicAdd(cnt, 1);
    __syncthreads();
    const int it = s_item;
    __syncthreads();
    if (it >= 3008) break;
    if (it < 128) hyena_item<1024, 8>(p, layer, MCTX + (it >> 6) * 1024, (it & 63) * 8, smem);
    else if (it < 384) { const int i = it - 128; attn_item(p, layer, 1, i >> 7, (i >> 4) & 7, i & 15, smem); }
    else if (it < 448) { const int i = it - 384; lru_item(p, layer, 1, i >> 5, (i >> 2) & 7, i & 3, smem); }
    else if (it < 960) { const int i = it - 448; hyena_item<256, 32>(p, layer, (i >> 4) * 256, (i & 15) * 32, smem); }
    else if (it < 1984) { const int i = it - 960; attn_item(p, layer, 0, i >> 5, (i >> 2) & 7, i & 3, smem); }
    else { const int i = it - 1984; lru_item(p, layer, 0, i >> 5, (i >> 2) & 7, i & 3, smem); }
  }
}

#ifndef MULTI
#define MULTI 1
#endif
#if MULTI
__global__ void __launch_bounds__(NT) k_phase0(P p) { extern __shared__ __attribute__((aligned(16))) char smem[]; phase0(p, smem); }
__global__ void __launch_bounds__(NT) k_norm(P p, int layer) { norm_phase(p, layer); }
__global__ void __launch_bounds__(NT) k_gemm0(P p, int layer) { extern __shared__ __attribute__((aligned(16))) char smem[]; gemm_phase<0>(p, layer, smem); }
__global__ void __launch_bounds__(NT) k_gemm1(P p, int layer) { extern __shared__ __attribute__((aligned(16))) char smem[]; gemm_phase<1>(p, layer, smem); }
__global__ void __launch_bounds__(NT) k_hy_lat(P p, int layer) { extern __shared__ __attribute__((aligned(16))) char smem[];
  for (int it = blockIdx.x; it < 128; it += gridDim.x) hyena_item<1024, 8>(p, layer, MCTX + (it >> 6) * 1024, (it & 63) * 8, smem); }
__global__ void __launch_bounds__(NT) k_hy_ctx(P p, int layer) { extern __shared__ __attribute__((aligned(16))) char smem[];
  for (int i = blockIdx.x; i < 512; i += gridDim.x) hyena_item<256, 32>(p, layer, (i >> 4) * 256, (i & 15) * 32, smem); }
__global__ void __launch_bounds__(NT) k_attn(P p, int layer) { extern __shared__ __attribute__((aligned(16))) char smem[];
  for (int it = blockIdx.x; it < 1280; it += gridDim.x) { if (it < 256) attn_item(p, layer, 1, it >> 7, (it >> 4) & 7, it & 15, smem); else { const int i = it - 256; attn_item(p, layer, 0, i >> 5, (i >> 2) & 7, i & 3, smem); } } }
__global__ void __launch_bounds__(NT) k_lru(P p, int layer) { extern __shared__ __attribute__((aligned(16))) char smem[];
  for (int it = blockIdx.x; it < 1088; it += gridDim.x) { if (it < 64) lru_item(p, layer, 1, it >> 5, (it >> 2) & 7, it & 3, smem); else { const int i = it - 64; lru_item(p, layer, 0, i >> 5, (i >> 2) & 7, i & 3, smem); } } }
#else
__global__ void __launch_bounds__(NT) mega(P p) {
  extern __shared__ __attribute__((aligned(16))) char smem[];
  cg::grid_group grid = cg::this_grid();
  phase0(p, smem);
  grid.sync();
  for (int layer = 0; layer < 2; ++layer) {
    norm_phase(p, layer);
    grid.sync();
    gemm_phase<0>(p, layer, smem);
    grid.sync();
    mixers_phase(p, layer, smem);
    grid.sync();
    gemm_phase<1>(p, layer, smem);
    grid.sync();
  }
  norm_phase(p, 2);
}
#endif

extern "C" void kernel_launch(void* const* d_in, const int* in_sizes, int n_in, void* d_out, int out_size, void* d_ws, size_t ws_size, hipStream_t stream) {
  static int grid = 0;
  if (grid == 0) {
    if (n_in != 32 || ws_size < WS_END) { fprintf(stderr, "kernel_launch: unexpected n_in %d / ws %zu (need %zu)\n", n_in, ws_size, (size_t)WS_END); grid = -1; return; }
    int dev = 0, cus = 0, per_cu = 0;
    (void)hipGetDevice(&dev);
    (void)hipDeviceGetAttribute(&cus, hipDeviceAttributeMultiprocessorCount, dev);
#if MULTI
    const void* ks[] = {(const void*)k_phase0, (const void*)k_gemm0, (const void*)k_gemm1, (const void*)k_hy_lat, (const void*)k_hy_ctx, (const void*)k_attn, (const void*)k_lru};
    for (int i = 0; i < 7; ++i) if (hipFuncSetAttribute(ks[i], hipFuncAttributeMaxDynamicSharedMemorySize, LDS_BYTES) != hipSuccess) { fprintf(stderr, "hipFuncSetAttribute failed\n"); grid = -1; return; }
    (void)per_cu;
#else
    if (hipFuncSetAttribute((const void*)mega, hipFuncAttributeMaxDynamicSharedMemorySize, LDS_BYTES) != hipSuccess) { fprintf(stderr, "hipFuncSetAttribute failed\n"); grid = -1; return; }
    if (hipOccupancyMaxActiveBlocksPerMultiprocessor(&per_cu, (const void*)mega, NT, LDS_BYTES) != hipSuccess || per_cu < 1) { fprintf(stderr, "occupancy query failed (%d)\n", per_cu); grid = -1; return; }
#endif
    grid = cus;
  }
  if (grid < 0) return;
  P prm{};
  for (int i = 0; i < 32; ++i) prm.in[i] = (const float*)d_in[i];
  prm.out = (float*)d_out; prm.ws = (char*)d_ws;
#if MULTI
  k_phase0<<<grid, NT, LDS_BYTES, stream>>>(prm);
  for (int layer = 0; layer < 2; ++layer) {
    k_norm<<<grid, NT, 0, stream>>>(prm, layer);
    k_gemm0<<<grid, NT, LDS_BYTES, stream>>>(prm, layer);
    k_hy_lat<<<128, NT, LDS_BYTES, stream>>>(prm, layer);
    k_attn<<<grid * 2, NT, LDS_BYTES, stream>>>(prm, layer);
    k_lru<<<grid * 2, NT, LDS_BYTES, stream>>>(prm, layer);
    k_hy_ctx<<<grid * 2, NT, LDS_BYTES, stream>>>(prm, layer);
    k_gemm1<<<grid, NT, LDS_BYTES, stream>>>(prm, layer);
  }
  k_norm<<<grid, NT, 0, stream>>>(prm, 2);
#else
  void* args[] = {&prm};
  hipError_t e = hipLaunchCooperativeKernel((const void*)mega, dim3(grid), dim3(NT), args, LDS_BYTES, stream);
  if (e != hipSuccess) fprintf(stderr, "cooperative launch failed: %s (grid %d)\n", hipGetErrorString(e), grid);
#endif
}
```

```cpp
#include <hip/hip_runtime.h>
#include <hip/hip_bf16.h>
#include <hip/hip_cooperative_groups.h>
#include <cstdio>
namespace cg = cooperative_groups;

#ifndef REP_HY
#define REP_HY 1
#endif
#ifndef REP_AT
#define REP_AT 1
#endif
#ifndef REP_LRU
#define REP_LRU 1
#endif
typedef unsigned short u16;
using bf16x8 = __attribute__((ext_vector_type(8))) short;
using bf16x4 = __attribute__((ext_vector_type(4))) short;
using f32x4 = __attribute__((ext_vector_type(4))) float;

#define NT 512
constexpr int MROWS = 10240, MCTX = 8192, DM = 1024, DP = 2336  , DMIX = 1536;
constexpr int LDS_BYTES = 131072 + 8192;
constexpr int OUT_YS = 8388608, OUT_K = 10485760, OUT_V = 12582912, OUT_LRU = 14680064;

constexpr size_t WS_WTIN = 0;
constexpr size_t WS_WTOUT = WS_WTIN + (size_t)2 * 4352 * 1024 * 2;
constexpr size_t WS_WGT = WS_WTOUT + (size_t)2 * 1024 * 1536 * 2;
constexpr size_t WS_MOD = WS_WGT + (size_t)2 * 2 * 2 * 8 * 64 * 64 * 2;
constexpr size_t WS_ROPE = WS_MOD + (size_t)2 * 3 * 3072 * 4;
constexpr size_t WS_HF = WS_ROPE + 8192;
constexpr int HFS = 1040;
constexpr size_t HF_LSTRIDE = (size_t)1280 * HFS;
constexpr size_t WS_NP = WS_HF + 2 * HF_LSTRIDE * 4;
constexpr size_t WS_CNT = WS_NP + (size_t)2 * 2 * 32 * 1024 * 4;
constexpr size_t WS_BAR = WS_CNT + 256;
constexpr size_t WS_H = WS_BAR + 13824;
constexpr size_t WS_U = WS_H + (size_t)MROWS * 1024 * 2;
constexpr size_t WS_UH = WS_U + (size_t)MROWS * DP * 2;
constexpr size_t WS_KC = WS_UH + (size_t)256 * MROWS * 8 * 2;
constexpr size_t WS_VC = WS_KC + (size_t)32 * 2 * 256 * 64 * 2;
constexpr size_t WS_KL = WS_VC + (size_t)32 * 2 * 256 * 64 * 2;
constexpr size_t WS_VL = WS_KL + (size_t)2 * 2 * 2 * 1536 * 64 * 2;
constexpr size_t WS_MIX = WS_VL + (size_t)2 * 2 * 2 * 1536 * 64 * 2;
constexpr size_t WS_X = WS_MIX + (size_t)MROWS * DMIX * 2;
constexpr size_t WS_END = WS_X + (size_t)MROWS * 1024 * 4;

struct P { const float* in[32]; float* out; char* ws; };

__device__ __forceinline__ u16 f2bf(float f) { unsigned u = __float_as_uint(f); u += 0x7fffu + ((u >> 16) & 1u); return (u16)(u >> 16); }
__device__ __forceinline__ unsigned cvtpk(float lo, float hi) { unsigned r; asm("v_cvt_pk_bf16_f32 %0, %1, %2" : "=v"(r) : "v"(lo), "v"(hi)); return r; }
__device__ __forceinline__ bf16x4 pk4(float a, float b, float c, float d) { typedef unsigned u32x2 __attribute__((ext_vector_type(2))); u32x2 t; t.x = cvtpk(a, b); t.y = cvtpk(c, d); return __builtin_bit_cast(bf16x4, t); }
__device__ __forceinline__ bf16x8 pk8(float a, float b, float c, float d, float e, float f, float g, float h) { typedef unsigned u32x4_ __attribute__((ext_vector_type(4))); u32x4_ t; t.x = cvtpk(a, b); t.y = cvtpk(c, d); t.z = cvtpk(e, f); t.w = cvtpk(g, h); return __builtin_bit_cast(bf16x8, t); }
__device__ __forceinline__ float bf2f(u16 h) { return __uint_as_float(((unsigned)h) << 16); }
__device__ __forceinline__ float bfs(short h) { return __uint_as_float(((unsigned)(u16)h) << 16); }
__device__ __forceinline__ float fexp(float x) { return __expf(x); }
__device__ __forceinline__ float siluf(float x) { return x * __builtin_amdgcn_rcpf(1.f + fexp(-x)); }
__device__ __forceinline__ float sigm(float x) { return __builtin_amdgcn_rcpf(1.f + fexp(-x)); }

__device__ __forceinline__ int otid() { int t; asm volatile("v_mov_b32 %0, %1" : "=v"(t) : "v"((int)threadIdx.x)); return t; }
__device__ __forceinline__ int osgpr(int x) { asm volatile("" : "+s"(x)); return x; }
__device__ void p0_filter(const P& p, char* smem, int it) {
  const int l = it / 40, r = it % 40; const int sel = r >= 8; const int chunk = sel ? r - 8 : r;
  const int L = sel ? 1024 : 256;
  float* feats = (float*)smem;
  float* h1 = feats + 32 * 36;
  float* h2 = h1 + 32 * 64;
  const int tid = otid();
  const float* w1 = p.in[15] + l * 33 * 64; const float* b1 = p.in[16] + l * 64;
  const float* w2 = p.in[17] + l * 64 * 64; const float* b2 = p.in[18] + l * 64;
  const float* w3 = p.in[19] + l * 64 * 1024; const float* fq = p.in[20] + l * 128; const float* dec = p.in[21] + l * 1024;
  const int c0 = tid;
  float wq[2][64];
#pragma unroll
  for (int j = 0; j < 64; ++j) { wq[0][j] = w3[j * 1024 + c0]; wq[1][j] = w3[j * 1024 + 512 + c0]; }
  for (int e = tid; e < 32 * 33; e += NT) {
    int tt = e / 33, j = e % 33; int t = chunk * 32 + tt; float v;
    if (j == 0) v = (float)t / (float)(L - 1);
    else { int i = (j - 1) & 15; float f = 1e-4f + (float)i * ((15.0f - 1e-4f) / 15.0f);
      float w = 6.283185307179586f * (float)t / (float)L; float a = f * w; v = (j <= 16) ? __cosf(a) : -__sinf(a); }
    feats[tt * 36 + j] = v;
  }
  __syncthreads();
  { const int j = tid & 63, tq = tid >> 6; float acc[4];
#pragma unroll
    for (int i = 0; i < 4; ++i) acc[i] = b1[j];
    float wcol[33];
#pragma unroll
    for (int e = 0; e < 33; ++e) wcol[e] = w1[e * 64 + j];
#pragma unroll
    for (int e = 0; e < 33; ++e) {
#pragma unroll
      for (int i = 0; i < 4; ++i) acc[i] += feats[(tq * 4 + i) * 36 + e] * wcol[e]; }
    float f0 = fq[j];
#pragma unroll
    for (int i = 0; i < 4; ++i) h1[(tq * 4 + i) * 64 + j] = __sinf(f0 * acc[i]); }
  __syncthreads();
  { const int j = tid & 63, tq = tid >> 6; float acc[4];
#pragma unroll
    for (int i = 0; i < 4; ++i) acc[i] = b2[j];
    float wcol[64];
#pragma unroll
    for (int e = 0; e < 64; ++e) wcol[e] = w2[e * 64 + j];
#pragma unroll
    for (int e = 0; e < 64; ++e) {
#pragma unroll
      for (int i = 0; i < 4; ++i) acc[i] += h1[(tq * 4 + i) * 64 + e] * wcol[e]; }
    float f1 = fq[64 + j];
#pragma unroll
    for (int i = 0; i < 4; ++i) h2[(tq * 4 + i) * 64 + j] = __sinf(f1 * acc[i]); }
  __syncthreads();
  float* HF = (float*)(p.ws + WS_HF) + (size_t)l * HF_LSTRIDE + (sel ? 256 * HFS : 0);
  float* NP = (float*)(p.ws + WS_NP) + ((l * 2 + sel) * 32 + chunk) * 1024;
  { const float d0 = dec[c0], d1 = dec[512 + c0]; float as0 = 0.f, as1 = 0.f;
#pragma unroll 1
    for (int tt = 0; tt < 32; ++tt) {
      float a0 = 0.f, a1 = 0.f;
#pragma unroll
      for (int j4 = 0; j4 < 16; ++j4) { const float4 hv = *(const float4*)(h2 + tt * 64 + j4 * 4);
        a0 += hv.x * wq[0][j4 * 4] + hv.y * wq[0][j4 * 4 + 1] + hv.z * wq[0][j4 * 4 + 2] + hv.w * wq[0][j4 * 4 + 3];
        a1 += hv.x * wq[1][j4 * 4] + hv.y * wq[1][j4 * 4 + 1] + hv.z * wq[1][j4 * 4 + 2] + hv.w * wq[1][j4 * 4 + 3]; }
      const int t = chunk * 32 + tt; const float tv = (float)t / (float)(L - 1);
      const float v0 = a0 * expf(-tv * d0), v1 = a1 * expf(-tv * d1);
      HF[(size_t)t * HFS + c0] = v0; HF[(size_t)t * HFS + 512 + c0] = v1;
      as0 += fabsf(v0); if (t != 0) as1 += fabsf(v1);
    }
    NP[c0] = as0; NP[512 + c0] = as1;
  }
  __syncthreads();
}

__device__ void p0_adaln(const P& p, char* smem, int it) {
  const int l = it / 96, j0 = (it % 96) * 32; const int tid = otid();
  float* ss = (float*)smem;
  float* red = ss + 3072;
  for (int e = tid; e < 3072; e += NT) { int cv = e >> 10, k = e & 1023; float x = cv == 0 ? p.in[6][k] : p.in[5][(cv - 1) * 1024 + k]; ss[e] = x / (1.f + expf(-x)); }
  __syncthreads();
  const int c = tid & 31, kg = tid >> 5;
  const float* W = p.in[8] + (size_t)l * 1024 * 3072 + j0 + c;
  float a0 = 0.f, a1 = 0.f, a2 = 0.f;
#pragma unroll 32
  for (int k = kg * 64; k < kg * 64 + 64; ++k) { float w = W[(size_t)k * 3072]; a0 += ss[k] * w; a1 += ss[1024 + k] * w; a2 += ss[2048 + k] * w; }
  red[(kg * 3 + 0) * 32 + c] = a0; red[(kg * 3 + 1) * 32 + c] = a1; red[(kg * 3 + 2) * 32 + c] = a2;
  __syncthreads();
  if (tid < 96) { int cv = tid >> 5, cc = tid & 31; float s = p.in[9][l * 3072 + j0 + cc];
    for (int k = 0; k < 16; ++k) s += red[(k * 3 + cv) * 32 + cc];
    ((float*)(p.ws + WS_MOD))[(l * 3 + cv) * 3072 + j0 + cc] = s; }
  __syncthreads();
}

__device__ void p0_transpose(const float* src, u16* dst, int K, int N, int kt, int nt, char* smem) {
  float* T = (float*)smem;
  const int tid = otid(); const int r = tid >> 6, c4 = (tid & 63) * 4;
  float4 v[8];
#pragma unroll
  for (int h = 0; h < 8; ++h) v[h] = *(const float4*)(src + (size_t)(kt * 64 + r + h * 8) * N + nt * 256 + c4);
#pragma unroll
  for (int h = 0; h < 8; ++h) { float* tp = T + (r + h * 8) * 257 + c4; tp[0] = v[h].x; tp[1] = v[h].y; tp[2] = v[h].z; tp[3] = v[h].w; }
  __syncthreads();
  const int n = tid >> 1, kh = (tid & 1) * 32;
#pragma unroll
  for (int q = 0; q < 4; ++q) { bf16x8 o;
#pragma unroll
    for (int i = 0; i < 8; ++i) o[i] = (short)f2bf(T[(kh + q * 8 + i) * 257 + n]);
    *(bf16x8*)(dst + (size_t)(nt * 256 + n) * K + kt * 64 + kh + q * 8) = o; }
  __syncthreads();
}

template <int l, int part>
__device__ void phase0_items(const P& p, char* smem) {
  __shared__ int s_it0;
  int* cnt = (int*)(p.ws + WS_CNT) + 8 + l * 4 + part;
  const int n_fil = part == 0 ? 0 : 40, n_ada = part == 1 ? 0 : 96, n_win = part == 1 ? 0 : 272, n_wout = part == 0 ? 0 : 96;
  for (;;) {
    if (otid() == 0) s_it0 = atomicAdd(cnt, 1);
    __syncthreads();
    int it = s_it0;
    __syncthreads();
    if (it >= n_fil + n_ada + n_win + n_wout) break;
    if (n_fil > 0 && it < n_fil) { p0_filter(p, smem, l * 40 + it); continue; }
    it -= n_fil;
    if (n_ada > 0 && it < n_ada) { p0_adaln(p, smem, l * 96 + it); continue; }
    it -= n_ada;
    if (n_win > 0 && it < n_win) { const int nt = it / 16, kt = it % 16;
      p0_transpose(p.in[10] + (size_t)l * 1024 * 4352, (u16*)(p.ws + WS_WTIN) + (size_t)l * 4352 * 1024, 1024, 4352, kt, nt, smem); continue; }
    it -= n_win;
    if (n_wout > 0) { const int nt = it / 24, kt = it % 24;
      p0_transpose(p.in[30] + (size_t)l * 1536 * 1024, (u16*)(p.ws + WS_WTOUT) + (size_t)l * 1024 * 1536, 1536, 1024, kt, nt, smem); }
  }
}

__device__ void phase0(const P& p, char* smem) {
  const int G = gridDim.x;
  phase0_items<0, 0>(p, smem);
  const int gt = blockIdx.x * NT + otid(), gn = G * NT;
  u16* KL = (u16*)(p.ws + WS_KL); u16* VL = (u16*)(p.ws + WS_VL);
  for (int idx = gt; idx < 2 * 2 * 2 * 512 * 64; idx += gn) {
    int d = idx & 63, pp = (idx >> 6) & 511, kvh = (idx >> 15) & 1, b = (idx >> 16) & 1, l = idx >> 17;
    size_t src = ((((size_t)b * 2 + l) * 512 + pp) * 2 + kvh) * 64 + d;
    KL[((size_t)((l * 2 + b) * 2 + kvh) * 1536 + pp) * 64 + d] = f2bf(p.in[2][src]);
    VL[((size_t)((l * 2 + b) * 2 + kvh) * 64 + d) * 1536 + pp] = f2bf(p.in[3][src]);
  }
  float* rope = (float*)(p.ws + WS_ROPE);
  for (int idx = gt; idx < 1024; idx += gn) { int pos = idx >> 4, fi = idx & 15; float inv = powf(10000.0f, -(float)fi / 16.0f); float a = (float)pos * inv;
    rope[idx * 2] = cosf(a); rope[idx * 2 + 1] = sinf(a); }
  u16* WGT = (u16*)(p.ws + WS_WGT);
  for (int idx = gt; idx < 2 * 2 * 2 * 8 * 64 * 64; idx += gn) {
    int c = idx & 63, d = (idx >> 6) & 63, n = (idx >> 12) & 7, gate = (idx >> 15) & 1, dir = (idx >> 16) & 1, l = idx >> 17;
    const float* src = gate ? p.in[27] : p.in[25];
    WGT[idx] = f2bf(src[((size_t)((l * 2 + dir) * 8 + n) * 64 + c) * 64 + d]);
  }
}

__device__ void norm_phase(const P& p, int layer) {
  const int wave = otid() >> 6, lane = otid() & 63;
  const float* X = (const float*)(p.ws + WS_X);
  u16* H = (u16*)(p.ws + WS_H);
  const int stride = gridDim.x * 8;
  int row = blockIdx.x * 8 + wave;
  float4 vn[4];
  if (row < MROWS) { const float* x = layer == 0 ? (row < MCTX ? p.in[0] + (size_t)row * 1024 : p.in[1] + (size_t)(row - MCTX) * 1024) : X + (size_t)row * 1024;
#pragma unroll
    for (int i = 0; i < 4; ++i) vn[i] = *(const float4*)(x + i * 256 + lane * 4); }
  for (; row < MROWS; row += stride) {
    float4 v[4]; float ss = 0.f;
#pragma unroll
    for (int i = 0; i < 4; ++i) { v[i] = vn[i]; ss += v[i].x * v[i].x + v[i].y * v[i].y + v[i].z * v[i].z + v[i].w * v[i].w; }
    { const int rn = row + stride;
      if (rn < MROWS) { const float* x = layer == 0 ? (rn < MCTX ? p.in[0] + (size_t)rn * 1024 : p.in[1] + (size_t)(rn - MCTX) * 1024) : X + (size_t)rn * 1024;
#pragma unroll
        for (int i = 0; i < 4; ++i) vn[i] = *(const float4*)(x + i * 256 + lane * 4); } }
#pragma unroll
    for (int o = 32; o >= 1; o >>= 1) ss += __shfl_xor(ss, o);
    const float rstd = rsqrtf(ss * (1.f / 1024.f) + 1e-6f);
    if (layer < 2) {
      const int cv = row < MCTX ? 0 : 1 + ((row - MCTX) >> 10);
      const float* md = (const float*)(p.ws + WS_MOD) + (layer * 3 + cv) * 3072;
      const float* g = p.in[7] + layer * 1024;
#pragma unroll
      for (int i = 0; i < 4; ++i) { const int k = i * 256 + lane * 4;
        float4 g4 = *(const float4*)(g + k), sh = *(const float4*)(md + k), sc = *(const float4*)(md + 1024 + k);
        *(bf16x4*)(H + (size_t)row * 1024 + k) = pk4(v[i].x * rstd * g4.x * (1.f + sc.x) + sh.x, v[i].y * rstd * g4.y * (1.f + sc.y) + sh.y,
                                                     v[i].z * rstd * g4.z * (1.f + sc.z) + sh.z, v[i].w * rstd * g4.w * (1.f + sc.w) + sh.w); }
    } else {
      float* o = p.out + (row < MCTX ? (size_t)row * 1024 : (size_t)OUT_YS + (size_t)(row - MCTX) * 1024);
      const float* g = p.in[31];
#pragma unroll
      for (int i = 0; i < 4; ++i) { const int k = i * 256 + lane * 4; float4 g4 = *(const float4*)(g + k); float4 r;
        r.x = v[i].x * rstd * g4.x; r.y = v[i].y * rstd * g4.y; r.z = v[i].z * rstd * g4.z; r.w = v[i].w * rstd * g4.w;
        *(float4*)(o + k) = r; }
    }
  }
}

namespace pg8 {
#define PG8_LAS __attribute__((address_space(3)))
typedef unsigned short bf16_t;
typedef short bf16x8 __attribute__((ext_vector_type(8)));
typedef float f32x4 __attribute__((ext_vector_type(4)));
typedef unsigned u32x4 __attribute__((ext_vector_type(4)));
constexpr int BM = 256, BK = 64, HALF = 128, HTB = HALF * BK * 2  , STAGE_BYTES = 8 * HTB, NXCD = 8, WGM = 8;

__host__ __device__ __forceinline__ int lds_byte(int r, int c) { const int st = (r >> 4) * 2 + (c >> 5), rr = r & 15, cc = c & 31, ob = rr * 64 + cc * 2; return st * 1024 + (ob ^ (((ob >> 9) & 1) << 5)); }
__host__ __device__ __forceinline__ void stage_rc(int b, int& R, int& C) { const int st = b / 1024, sb = b % 1024, swz = sb ^ (((sb >> 9) & 1) << 5); R = (st >> 1) * 16 + swz / 64; C = (st & 1) * 32 + (swz % 64) / 2; }
__host__ __device__ __forceinline__ int perm32(int rho) { const int n = rho >> 4, i = rho & 15; return 8 * (i >> 2) + 4 * n + (i & 3); }

struct Unit { int pm, pn; };
struct Gemm { const bf16_t* A; const bf16_t* Bt; int M, N, K; };

struct StaticOrder {
    int nM, nN, nwg, G, c;
    __host__ __device__ void init(int M, int N, int G_, int c_) { nM = M / BM; nN = N / BM; nwg = nM * nN; G = G_; c = c_; }
    __host__ __device__ bool next(int i, Unit& u) const {
        const long L = (long)i * G + c; if (L >= nwg) return false;
        int wgid = (int)L; { const int q = nwg / NXCD, r = nwg % NXCD, xcd = wgid % NXCD, off = wgid / NXCD; wgid = (xcd < r ? xcd * (q + 1) : r * (q + 1) + (xcd - r) * q) + off; }
        const int nig = WGM * nN, gid = wgid / nig, fm = gid * WGM, gsz = (nM - fm) < WGM ? (nM - fm) : WGM;
        u.pm = fm + ((wgid % nig) % gsz); u.pn = (wgid % nig) / gsz; return true;
    }
    __device__ __forceinline__ void a_ready(const Unit&) const {}
    __device__ __forceinline__ void done(const Unit&) const {}
};
__device__ __forceinline__ unsigned cvt_pk_bf16(float lo, float hi) { unsigned r; asm volatile("v_cvt_pk_bf16_f32 %0, %1, %2" : "=v"(r) : "v"(lo), "v"(hi)); return r; }
template <class Epi, class Sched, bool STAMP = false>
__device__ __forceinline__ void gemm_phase(PG8_LAS unsigned char* lds, const Gemm g, const Sched& S, const Epi& E, unsigned long long* stamps) {
    const int tid = otid(), wid = __builtin_amdgcn_readfirstlane(tid >> 6), lane = tid & 63, wr = wid >> 2, wc = wid & 3, fr = lane & 15, fq = lane >> 4;
    const int K = g.K, nt = K / BK;
    int ts_lo = 0, ts_hi = 0, nts = 0; const unsigned long long rt_entry = STAMP ? (unsigned long long)wall_clock64() : 0ull;
#define PG8_STAMP() do { if (STAMP && wid == 0 && nts < 64) { const unsigned long long _c = (unsigned long long)clock64(); \
        ts_lo = (lane == nts) ? (int)(unsigned)_c : ts_lo; ts_hi = (lane == nts) ? (int)(unsigned)(_c >> 32) : ts_hi; ++nts; } } while (0)
    PG8_STAMP();
    unsigned voffA[2], voffB[2];
#pragma unroll
    for (int i = 0; i < 2; ++i) { int R, C; stage_rc(tid * 16 + i * 8192, R, C); const int Rb = Epi::PERM ? ((R & ~31) + perm32(R & 31)) : R;
        voffA[i] = (unsigned)(R * K + C) * 2u; voffB[i] = (unsigned)(Rb * K + C) * 2u; }
    const size_t kstep = (size_t)(BK * 2);
    const size_t hstep = (size_t)HALF * K * 2;
    const size_t tstep = 2 * hstep;
    const unsigned ldsw = (unsigned)wid * 1024u;
    const int aoff = lds_byte(wr * 64 + fr, fq * 8), boff = lds_byte(wc * 32 + fr, fq * 8);
#define PG8_SA(b, h) (((b) * 2 + (h)) * HTB)
#define PG8_SB(b, h) ((4 + (b) * 2 + (h)) * HTB)
#define PG8_STAGE(bufoff, gbase, voff) do { _Pragma("unroll") for (int _i = 0; _i < 2; ++_i) \
        __builtin_amdgcn_global_load_lds((const unsigned*)((const char*)(gbase) + (voff)[_i]), (PG8_LAS unsigned*)(lds + (bufoff) + ldsw + _i * 8192), 16, 0, 0); } while (0)
#define PG8_LDA(dst, b, h) do { _Pragma("unroll") for (int m = 0; m < 4; ++m) _Pragma("unroll") for (int k = 0; k < 2; ++k) dst[m][k] = *(const PG8_LAS bf16x8*)(lds + PG8_SA(b, h) + aoff + m * 2048 + k * 1024); } while (0)
#define PG8_LDB(dst, b, h) do { _Pragma("unroll") for (int n = 0; n < 2; ++n) _Pragma("unroll") for (int k = 0; k < 2; ++k) dst[n][k] = *(const PG8_LAS bf16x8*)(lds + PG8_SB(b, h) + boff + n * 2048 + k * 1024); } while (0)
#define PG8_MMA(ai, bj, At, Bt) do { __builtin_amdgcn_s_setprio(1); _Pragma("unroll") for (int m = 0; m < 4; ++m) _Pragma("unroll") for (int n = 0; n < 2; ++n) _Pragma("unroll") for (int k = 0; k < 2; ++k) \
        acc[ai][bj][m][n] = __builtin_amdgcn_mfma_f32_16x16x32_bf16(Bt[n][k], At[m][k], acc[ai][bj][m][n], 0, 0, 0); __builtin_amdgcn_s_setprio(0); } while (0)
#define PG8_WAIT_V(n) asm volatile("s_waitcnt vmcnt(" #n ")" ::: "memory")
#define PG8_WAIT_L(n) asm volatile("s_waitcnt lgkmcnt(" #n ")" ::: "memory")
#define PG8_BAR __builtin_amdgcn_s_barrier()
#define PG8_SCHED __builtin_amdgcn_sched_barrier(0)
    Unit cur, nxt; int ui = 0;
    if (!S.next(0, cur)) return;
    f32x4 acc[2][2][4][2];
#pragma unroll
    for (int a = 0; a < 2; ++a)
#pragma unroll
        for (int b = 0; b < 2; ++b)
#pragma unroll
            for (int m = 0; m < 4; ++m)
#pragma unroll
                for (int n = 0; n < 2; ++n) acc[a][b][m][n] = (f32x4){0.f, 0.f, 0.f, 0.f};
    bf16x8 At[4][2], B0[2][2], B1[2][2];
    const char* cA = (const char*)g.A + (size_t)cur.pm * tstep; const char* cB = (const char*)g.Bt + (size_t)cur.pn * tstep;
    S.a_ready(cur);
    PG8_STAGE(PG8_SB(0, 0), cB, voffB); PG8_STAGE(PG8_SA(0, 0), cA, voffA); PG8_STAGE(PG8_SB(0, 1), cB + hstep, voffB); PG8_STAGE(PG8_SA(0, 1), cA + hstep, voffA);
    if (wr == 1) PG8_BAR;
    PG8_WAIT_V(4); PG8_BAR;
    PG8_STAGE(PG8_SB(1, 0), cB + kstep, voffB); PG8_STAGE(PG8_SA(1, 0), cA + kstep, voffA); PG8_STAGE(PG8_SB(1, 1), cB + hstep + kstep, voffB);
    PG8_WAIT_V(6); PG8_BAR;
    PG8_STAMP();
    for (;;) {
        const bool has_next = S.next(ui + 1, nxt);
        const char* nA = has_next ? (const char*)g.A + (size_t)nxt.pm * tstep : cA; const char* nB = has_next ? (const char*)g.Bt + (size_t)nxt.pn * tstep : cB;
        for (int t = 0; t < nt; t += 2) {
            const bool last = (t == nt - 2);
            const char* a1 = cA + (size_t)(t + 1) * kstep;
            const char* a2 = last ? nA : cA + (size_t)(t + 2) * kstep; const char* b2 = last ? nB : cB + (size_t)(t + 2) * kstep;
            const char* a3 = a2 + kstep; const char* b3 = b2 + kstep;
            if (last && has_next) S.a_ready(nxt);
            PG8_LDB(B0, 0, 0); PG8_SCHED; PG8_LDA(At, 0, 0); PG8_STAGE(PG8_SA(1, 1), a1 + hstep, voffA);
            PG8_WAIT_L(8); PG8_BAR; PG8_WAIT_L(0); PG8_MMA(0, 0, At, B0); PG8_BAR; PG8_SCHED;
            PG8_LDB(B1, 0, 1); PG8_STAGE(PG8_SB(0, 0), b2, voffB);
            PG8_BAR; PG8_WAIT_L(0); PG8_MMA(0, 1, At, B1); PG8_BAR;
            PG8_LDA(At, 0, 1); PG8_STAGE(PG8_SA(0, 0), a2, voffA);
            PG8_BAR; PG8_WAIT_L(0); PG8_MMA(1, 0, At, B0); PG8_BAR; PG8_SCHED;
            PG8_STAGE(PG8_SB(0, 1), b2 + hstep, voffB);
            PG8_WAIT_V(6); PG8_BAR; PG8_MMA(1, 1, At, B1); PG8_BAR;
            PG8_LDB(B0, 1, 0); PG8_SCHED; PG8_LDA(At, 1, 0); PG8_STAGE(PG8_SA(0, 1), a2 + hstep, voffA);
            PG8_WAIT_L(8); PG8_BAR; PG8_WAIT_L(0); PG8_MMA(0, 0, At, B0); PG8_BAR; PG8_SCHED;
            PG8_LDB(B1, 1, 1); PG8_STAGE(PG8_SB(1, 0), b3, voffB);
            PG8_BAR; PG8_WAIT_L(0); PG8_MMA(0, 1, At, B1); PG8_BAR;
            PG8_LDA(At, 1, 1); PG8_STAGE(PG8_SA(1, 0), a3, voffA);
            PG8_BAR; PG8_WAIT_L(0); PG8_MMA(1, 0, At, B0); PG8_BAR; PG8_SCHED;
            PG8_STAGE(PG8_SB(1, 1), b3 + hstep, voffB);
            PG8_WAIT_V(6); PG8_BAR; PG8_MMA(1, 1, At, B1); PG8_BAR;
        }
        PG8_STAMP();
        if constexpr (!Epi::AFTER_DRAIN) { E(acc, cur, wr, wc, fr, fq); S.done(cur); }
        PG8_STAMP();
        if (!has_next) break;
#pragma unroll
        for (int a = 0; a < 2; ++a)
#pragma unroll
            for (int b = 0; b < 2; ++b)
#pragma unroll
                for (int m = 0; m < 4; ++m)
#pragma unroll
                    for (int n = 0; n < 2; ++n) acc[a][b][m][n] = (f32x4){0.f, 0.f, 0.f, 0.f};
        cur = nxt; cA = nA; cB = nB; ++ui;
    }
    PG8_WAIT_V(0);
    if (wr == 0) PG8_BAR;
    PG8_BAR;
    if constexpr (Epi::AFTER_DRAIN) { E.fused(acc, cur, wr, wc, fr, fq, lds, wid, lane); S.done(cur); }
    PG8_STAMP();
    if (STAMP && wid == 0) { stamps[lane] = lane < nts ? (((unsigned long long)(unsigned)ts_hi << 32) | (unsigned)ts_lo) : 0ull;
        if (lane == 62) stamps[62] = rt_entry; if (lane == 63) stamps[63] = (unsigned long long)wall_clock64(); }
#undef PG8_STAMP
#undef PG8_SA
#undef PG8_SB
#undef PG8_STAGE
#undef PG8_LDA
#undef PG8_LDB
#undef PG8_MMA
#undef PG8_WAIT_V
#undef PG8_WAIT_L
#undef PG8_BAR
#undef PG8_SCHED
}
}

struct EpiOut {
  static constexpr bool PERM = false, AFTER_DRAIN = false;
  const float* in0; const float* in1; char* ws; int layer;
  __device__ __forceinline__ void operator()(const f32x4 (&acc)[2][2][4][2], const pg8::Unit& u, int wr, int wc, int fr, int fq) const {
    const int brow = u.pm * 256; const int row0 = brow + wr * 64 + fr, col0 = u.pn * 256 + wc * 32 + 4 * fq;
    float* X = (float*)(ws + WS_X);
    const int cv = brow < MCTX ? 0 : 1 + ((brow - MCTX) >> 10);
    const float* gate = (const float*)(ws + WS_MOD) + (layer * 3 + cv) * 3072 + 2048;
    const float* xin = layer == 0 ? (brow < MCTX ? in0 : in1 - (size_t)MCTX * 1024) : X;
    f32x4 gv[2][2];
#pragma unroll
    for (int bj = 0; bj < 2; ++bj)
#pragma unroll
      for (int n = 0; n < 2; ++n) gv[bj][n] = *(const f32x4*)(gate + col0 + bj * 128 + n * 16);
#pragma unroll
    for (int ai = 0; ai < 2; ++ai)
#pragma unroll
      for (int m = 0; m < 4; ++m) { const size_t ro = (size_t)(row0 + ai * 128 + m * 16) * 1024 + col0;
#pragma unroll
        for (int bj = 0; bj < 2; ++bj)
#pragma unroll
          for (int n = 0; n < 2; ++n) { const f32x4 xv = *(const f32x4*)(xin + ro + bj * 128 + n * 16);
            *(f32x4*)(X + ro + bj * 128 + n * 16) = xv + gv[bj][n] * acc[ai][bj][m][n]; } }
  }
};

struct EpiIn {
  static constexpr bool PERM = true, AFTER_DRAIN = false;
  const float* qg; const float* kg; float* out; char* ws; float* sSS; int layer;
  template <int KIND>
  __device__ __forceinline__ void half(const f32x4 (&acc)[2][2][4][2], const int bj, const int brow, const int pn, const bool lat, int wr, int wc, int fr, int fq) const {
    u16* U = (u16*)(ws + WS_U);
    const float* rope = (const float*)(ws + WS_ROPE);
    const int dh = (wc & 1) * 32 + 8 * fq;
    const int hd = wc >> 1;
    float gn[8];
    if (KIND <= 1) { const float* gp = (KIND == 0 ? qg : kg) + layer * 64 + dh;
      const f32x4 g0 = *(const f32x4*)gp, g1 = *(const f32x4*)(gp + 4);
      gn[0] = g0[0]; gn[1] = g0[1]; gn[2] = g0[2]; gn[3] = g0[3]; gn[4] = g1[0]; gn[5] = g1[1]; gn[6] = g1[2]; gn[7] = g1[3]; }
#pragma unroll
    for (int ai = 0; ai < 2; ++ai)
#pragma unroll
      for (int m = 0; m < 4; ++m) {
        const int rl = ai * 128 + wr * 64 + m * 16 + fr; const int row = brow + rl;
        const f32x4 v0 = acc[ai][bj][m][0], v1 = acc[ai][bj][m][1];
        float v[8] = {v0[0], v0[1], v0[2], v0[3], v1[0], v1[1], v1[2], v1[3]};
        if (KIND <= 1) {
          const float tot = sSS[(bj * 256 + rl) * 4 + wc] + sSS[(bj * 256 + rl) * 4 + (wc ^ 1)];
          const float rstd = rsqrtf(tot * (1.f / 64.f) + 1e-6f);
#pragma unroll
          for (int i = 0; i < 8; ++i) v[i] = v[i] * rstd * gn[i];
          if (KIND == 1 && !lat) { const int b = row >> 8, t = row & 255; float* op = out + (size_t)OUT_K + ((size_t)((b * 2 + layer) * 256 + t)) * 128 + hd * 64 + dh;
            *(f32x4*)op = (f32x4){v[0], v[1], v[2], v[3]}; *(f32x4*)(op + 4) = (f32x4){v[4], v[5], v[6], v[7]}; }
          if (lat) {
            const int t = (row - MCTX) & 1023; const int posv = (wc & 1) ? (t & 63) : (t >> 6);
            const float* rp = rope + (posv * 16 + 4 * fq) * 2;
            const f32x4 r0 = *(const f32x4*)rp, r1 = *(const f32x4*)(rp + 4);
            float x1, x2;
            x1 = v[0]; x2 = v[1]; v[0] = x1 * r0[0] - x2 * r0[1]; v[1] = x1 * r0[1] + x2 * r0[0];
            x1 = v[2]; x2 = v[3]; v[2] = x1 * r0[2] - x2 * r0[3]; v[3] = x1 * r0[3] + x2 * r0[2];
            x1 = v[4]; x2 = v[5]; v[4] = x1 * r1[0] - x2 * r1[1]; v[5] = x1 * r1[1] + x2 * r1[0];
            x1 = v[6]; x2 = v[7]; v[6] = x1 * r1[2] - x2 * r1[3]; v[7] = x1 * r1[3] + x2 * r1[2];
          }
          pg8::u32x4 w;
          if (KIND == 0) { w.x = pg8::cvt_pk_bf16(v[0] * 0.125f, v[1] * 0.125f); w.y = pg8::cvt_pk_bf16(v[2] * 0.125f, v[3] * 0.125f); w.z = pg8::cvt_pk_bf16(v[4] * 0.125f, v[5] * 0.125f); w.w = pg8::cvt_pk_bf16(v[6] * 0.125f, v[7] * 0.125f);
            *(pg8::u32x4*)(U + (size_t)row * DP + pn * 256 + bj * 128 + wc * 32 + 8 * fq) = w; }
          else { w.x = pg8::cvt_pk_bf16(v[0], v[1]); w.y = pg8::cvt_pk_bf16(v[2], v[3]); w.z = pg8::cvt_pk_bf16(v[4], v[5]); w.w = pg8::cvt_pk_bf16(v[6], v[7]);
            if (!lat) { const int b = row >> 8, t = row & 255; *(pg8::u32x4*)((u16*)(ws + WS_KC) + ((size_t)((b * 2 + hd) * 256 + t)) * 64 + dh) = w; }
            else { const int sb = (row - MCTX) >> 10, t = (row - MCTX) & 1023; *(pg8::u32x4*)((u16*)(ws + WS_KL) + ((size_t)(((layer * 2 + sb) * 2 + hd) * 1536 + 512 + t)) * 64 + dh) = w; } }
        } else {
          if (!lat) { const int b = row >> 8, t = row & 255; float* op = out + (size_t)OUT_V + ((size_t)((b * 2 + layer) * 256 + t)) * 128 + hd * 64 + dh;
            *(f32x4*)op = (f32x4){v[0], v[1], v[2], v[3]}; *(f32x4*)(op + 4) = (f32x4){v[4], v[5], v[6], v[7]};
            u16* vp = (u16*)(ws + WS_VC) + ((size_t)((b * 2 + hd) * 64 + dh)) * 256 + t;
#pragma unroll
            for (int i = 0; i < 8; ++i) vp[i * 256] = f2bf(v[i]); }
          else { const int sb = (row - MCTX) >> 10, t = (row - MCTX) & 1023;
            u16* vp = (u16*)(ws + WS_VL) + ((size_t)(((layer * 2 + sb) * 2 + hd) * 64 + dh)) * 1536 + 512 + t;
#pragma unroll
            for (int i = 0; i < 8; ++i) vp[i * 1536] = f2bf(v[i]); }
        }
      }
  }
  __device__ __forceinline__ void operator()(const f32x4 (&acc)[2][2][4][2], const pg8::Unit& u, int wr_, int wc_, int fr_, int fq_) const {
    int tid2; asm volatile("v_mov_b32 %0, %1" : "=v"(tid2) : "v"((int)threadIdx.x));
    const int wid = tid2 >> 6, lane = tid2 & 63, wr = wid >> 2, wc = wid & 3, fr = lane & 15, fq = lane >> 4;
    const int brow = u.pm * 256, pn = u.pn; const bool lat = brow >= MCTX;
    u16* U = (u16*)(ws + WS_U);
    if (pn >= 3) {
      const bool hy = pn >= 5 && pn < 13;
      u16* UH = (u16*)(ws + WS_UH);
      const int cg0 = (pn * 256 + wc * 32 + 8 * fq - 1280) >> 3;
      const int ucol = pn * 256 - (pn >= 13 ? 2048 : 0) + wc * 32 + 8 * fq;
#pragma unroll
      for (int ai = 0; ai < 2; ++ai)
#pragma unroll
        for (int m = 0; m < 4; ++m) { const int row = brow + ai * 128 + wr * 64 + m * 16 + fr;
#pragma unroll
          for (int bj = 0; bj < 2; ++bj) { const f32x4 v0 = acc[ai][bj][m][0], v1 = acc[ai][bj][m][1]; pg8::u32x4 w;
            w.x = pg8::cvt_pk_bf16(v0[0], v0[1]); w.y = pg8::cvt_pk_bf16(v0[2], v0[3]); w.z = pg8::cvt_pk_bf16(v1[0], v1[1]); w.w = pg8::cvt_pk_bf16(v1[2], v1[3]);
            u16* dst = hy ? UH + ((size_t)(cg0 + bj * 16) * MROWS + row) * 8 : U + (size_t)row * DP + ucol + bj * 128;
            *(pg8::u32x4*)dst = w; } }
      return;
    }
    const bool kvtile = pn == 2;
#pragma unroll
    for (int ai = 0; ai < 2; ++ai)
#pragma unroll
      for (int m = 0; m < 4; ++m)
#pragma unroll
        for (int bj = 0; bj < 2; ++bj) {
          const f32x4 v0 = acc[ai][bj][m][0], v1 = acc[ai][bj][m][1];
          float s = v0[0] * v0[0] + v0[1] * v0[1] + v0[2] * v0[2] + v0[3] * v0[3] + v1[0] * v1[0] + v1[1] * v1[1] + v1[2] * v1[2] + v1[3] * v1[3];
          s += __shfl_xor(s, 16); s += __shfl_xor(s, 32);
          if (fq == 0) sSS[(bj * 256 + ai * 128 + wr * 64 + m * 16 + fr) * 4 + wc] = s;
        }
    asm volatile("s_waitcnt lgkmcnt(0)" ::: "memory");
    __builtin_amdgcn_s_barrier();
    asm volatile("" ::: "memory");
    if (kvtile) { half<1>(acc, 0, brow, pn, lat, wr, wc, fr, fq); half<2>(acc, 1, brow, pn, lat, wr, wc, fr, fq); }
    else { half<0>(acc, 0, brow, pn, lat, wr, wc, fr, fq); half<0>(acc, 1, brow, pn, lat, wr, wc, fr, fq); }
  }
};

template <int EPI>
__device__ void gemm_phase(const P& p, const int layer, char* smem) {
  pg8::Gemm g;
  g.M = MROWS;
  if (EPI == 0) { g.A = (const u16*)(p.ws + WS_H); g.Bt = (const u16*)(p.ws + WS_WTIN) + (size_t)layer * 4352 * 1024; g.N = 4352; g.K = 1024; }
  else { g.A = (const u16*)(p.ws + WS_MIX); g.Bt = (const u16*)(p.ws + WS_WTOUT) + (size_t)layer * 1024 * 1536; g.N = 1024; g.K = 1536; }
  pg8::StaticOrder S; S.init(g.M, g.N, (int)gridDim.x, (int)blockIdx.x);
  if (EPI == 0) { EpiIn E{p.in[11], p.in[12], p.out, p.ws, (float*)(smem + 131072), layer};
    pg8::gemm_phase<EpiIn, pg8::StaticOrder, false>((PG8_LAS unsigned char*)smem, g, S, E, nullptr); }
  else { EpiOut E{p.in[0], p.in[1], p.ws, layer};
    pg8::gemm_phase<EpiOut, pg8::StaticOrder, false>((PG8_LAS unsigned char*)smem, g, S, E, nullptr); }
  __syncthreads();
}

__device__ __forceinline__ f32x4 mfma16(bf16x8 a, bf16x8 b, f32x4 c) { return __builtin_amdgcn_mfma_f32_16x16x32_bf16(a, b, c, 0, 0, 0); }

__device__ __forceinline__ void attn_softmax(f32x4 (&s)[4], f32x4 (&o)[4], float& mrun, float& lsum) {
  float mx = -1e30f;
#pragma unroll
  for (int mt = 0; mt < 4; ++mt)
#pragma unroll
    for (int r = 0; r < 4; ++r) mx = fmaxf(mx, s[mt][r]);
  mx = fmaxf(mx, __shfl_xor(mx, 16)); mx = fmaxf(mx, __shfl_xor(mx, 32));
  const float mnew = fmaxf(mrun, mx); const float alpha = __expf(mrun - mnew); mrun = mnew;
  float ps = 0.f;
#pragma unroll
  for (int mt = 0; mt < 4; ++mt)
#pragma unroll
    for (int r = 0; r < 4; ++r) { float pv = __expf(s[mt][r] - mnew); s[mt][r] = pv; ps += pv; }
  lsum = lsum * alpha + ps;
#pragma unroll
  for (int dt = 0; dt < 4; ++dt) { o[dt][0] *= alpha; o[dt][1] *= alpha; o[dt][2] *= alpha; o[dt][3] *= alpha; }
}
__device__ __forceinline__ void attn_sub2(const u16* sK, const u16* sV, const int kb, const int lr, const int g,
                                          const bf16x8 qa0, const bf16x8 qa1, const bf16x8 qb0, const bf16x8 qb1,
                                          f32x4 (&oa)[4], f32x4 (&ob)[4], float& ma, float& la, float& mb, float& lb) {
  f32x4 sa[4], sb[4];
#pragma unroll
  for (int mt = 0; mt < 4; ++mt) {
    const bf16x8 a0 = *(const bf16x8*)(sK + (kb + mt * 16 + lr) * 72 + g * 8), a1 = *(const bf16x8*)(sK + (kb + mt * 16 + lr) * 72 + 32 + g * 8);
    sa[mt] = mfma16(a0, qa0, (f32x4){0.f, 0.f, 0.f, 0.f}); sb[mt] = mfma16(a0, qb0, (f32x4){0.f, 0.f, 0.f, 0.f});
    sa[mt] = mfma16(a1, qa1, sa[mt]); sb[mt] = mfma16(a1, qb1, sb[mt]); }
  attn_softmax(sa, oa, ma, la);
  attn_softmax(sb, ob, mb, lb);
#pragma unroll
  for (int j = 0; j < 2; ++j) {
    const bf16x8 pfa = pk8(sa[2 * j][0], sa[2 * j][1], sa[2 * j][2], sa[2 * j][3], sa[2 * j + 1][0], sa[2 * j + 1][1], sa[2 * j + 1][2], sa[2 * j + 1][3]);
    const bf16x8 pfb = pk8(sb[2 * j][0], sb[2 * j][1], sb[2 * j][2], sb[2 * j][3], sb[2 * j + 1][0], sb[2 * j + 1][1], sb[2 * j + 1][2], sb[2 * j + 1][3]);
#pragma unroll
    for (int dt = 0; dt < 4; ++dt) {
      const u16* vp = sV + (dt * 16 + lr) * 272 + kb + j * 32 + g * 4;
      bf16x4 v0 = *(const bf16x4*)vp, v1 = *(const bf16x4*)(vp + 16);
      bf16x8 a; a[0] = v0[0]; a[1] = v0[1]; a[2] = v0[2]; a[3] = v0[3]; a[4] = v1[0]; a[5] = v1[1]; a[6] = v1[2]; a[7] = v1[3];
      oa[dt] = mfma16(a, pfa, oa[dt]); ob[dt] = mfma16(a, pfb, ob[dt]);
    }
  }
}
__device__ __forceinline__ void attn_sub(const u16* sK, const u16* sV, const int kb, const int lr, const int g, const bf16x8 q0, const bf16x8 q1, f32x4 (&o)[4], float& mrun, float& lsum) {
  f32x4 s[4];
#pragma unroll
  for (int mt = 0; mt < 4; ++mt) { s[mt] = (f32x4){0.f, 0.f, 0.f, 0.f};
    const bf16x8 a0 = *(const bf16x8*)(sK + (kb + mt * 16 + lr) * 72 + g * 8), a1 = *(const bf16x8*)(sK + (kb + mt * 16 + lr) * 72 + 32 + g * 8);
    s[mt] = mfma16(a0, q0, s[mt]); s[mt] = mfma16(a1, q1, s[mt]); }
  float mx = -1e30f;
#pragma unroll
  for (int mt = 0; mt < 4; ++mt)
#pragma unroll
    for (int r = 0; r < 4; ++r) mx = fmaxf(mx, s[mt][r]);
  mx = fmaxf(mx, __shfl_xor(mx, 16)); mx = fmaxf(mx, __shfl_xor(mx, 32));
  const float mnew = fmaxf(mrun, mx); const float alpha = __expf(mrun - mnew); mrun = mnew;
  float ps = 0.f;
#pragma unroll
  for (int mt = 0; mt < 4; ++mt)
#pragma unroll
    for (int r = 0; r < 4; ++r) { float pv = __expf(s[mt][r] - mnew); s[mt][r] = pv; ps += pv; }
  lsum = lsum * alpha + ps;
#pragma unroll
  for (int dt = 0; dt < 4; ++dt) { o[dt][0] *= alpha; o[dt][1] *= alpha; o[dt][2] *= alpha; o[dt][3] *= alpha; }
#pragma unroll
  for (int j = 0; j < 2; ++j) {
    const bf16x8 pf = pk8(s[2 * j][0], s[2 * j][1], s[2 * j][2], s[2 * j][3], s[2 * j + 1][0], s[2 * j + 1][1], s[2 * j + 1][2], s[2 * j + 1][3]);
#pragma unroll
    for (int dt = 0; dt < 4; ++dt) {
      const u16* vp = sV + (dt * 16 + lr) * 272 + kb + j * 32 + g * 4;
      bf16x4 v0 = *(const bf16x4*)vp, v1 = *(const bf16x4*)(vp + 16);
      bf16x8 a; a[0] = v0[0]; a[1] = v0[1]; a[2] = v0[2]; a[3] = v0[3]; a[4] = v1[0]; a[5] = v1[1]; a[6] = v1[2]; a[7] = v1[3];
      o[dt] = mfma16(a, pf, o[dt]);
    }
  }
}
__device__ __forceinline__ void attn_store(const P& p, const f32x4 (&o)[4], float lsum, const int qrow, const int h, const int g) {
  lsum += __shfl_xor(lsum, 16); lsum += __shfl_xor(lsum, 32);
  const float inv = 1.f / lsum;
  const u16* U = (const u16*)(p.ws + WS_U); u16* MIX = (u16*)(p.ws + WS_MIX);
#pragma unroll
  for (int dt = 0; dt < 4; ++dt) {
    const bf16x4 gv = *(const bf16x4*)(U + (size_t)qrow * DP + 768 + h * 64 + dt * 16 + g * 4);
    *(bf16x4*)(MIX + (size_t)qrow * DMIX + h * 64 + dt * 16 + g * 4) =
      pk4(o[dt][0] * inv * siluf(bfs(gv[0])), o[dt][1] * inv * siluf(bfs(gv[1])), o[dt][2] * inv * siluf(bfs(gv[2])), o[dt][3] * inv * siluf(bfs(gv[3])));
  }
}

__device__ void attn_item(const P& p, int layer, int lat, int sb, int h, int qt, char* smem) {
  const int tid = otid(), w = tid >> 6, lane = tid & 63, lr = lane & 15, g = lane >> 4;
  const int kvh = h >> 2;
  const int nkeys = 1536;
  const int m0 = MCTX + sb * 1024 + qt * 128;
  const u16* U = (const u16*)(p.ws + WS_U);
  const u16* Kb = (const u16*)(p.ws + WS_KL) + (size_t)((layer * 2 + sb) * 2 + kvh) * 1536 * 64;
  const u16* Vt = (const u16*)(p.ws + WS_VL) + (size_t)((layer * 2 + sb) * 2 + kvh) * 64 * 1536;
  u16* sK = (u16*)smem;
  u16* sV = sK + 256 * 72;
  const int qrow = m0 + w * 16 + lr;
  bf16x8 kr[4], vr[4];
#pragma unroll
  for (int i = 0; i < 4; ++i) { const int id = tid + i * 512; kr[i] = *(const bf16x8*)(Kb + (size_t)(id >> 3) * 64 + (id & 7) * 8); vr[i] = *(const bf16x8*)(Vt + (size_t)(id >> 5) * nkeys + (id & 31) * 8); }
  const bf16x8 q0 = *(const bf16x8*)(U + (size_t)qrow * DP + h * 64 + g * 8), q1 = *(const bf16x8*)(U + (size_t)qrow * DP + h * 64 + 32 + g * 8);
  f32x4 o[4];
#pragma unroll
  for (int i = 0; i < 4; ++i) o[i] = (f32x4){0.f, 0.f, 0.f, 0.f};
  float mrun = -1e30f, lsum = 0.f;
#pragma unroll 1
  for (int step = 0; step < 6; ++step) {
    __syncthreads();
#pragma unroll
    for (int i = 0; i < 4; ++i) { const int id = tid + i * 512; *(bf16x8*)(sK + (id >> 3) * 72 + (id & 7) * 8) = kr[i]; *(bf16x8*)(sV + (id >> 5) * 272 + (id & 31) * 8) = vr[i]; }
    if (step + 1 < 6) { const int k0 = (step + 1) * 256;
#pragma unroll
      for (int i = 0; i < 4; ++i) { const int id = tid + i * 512; kr[i] = *(const bf16x8*)(Kb + (size_t)(k0 + (id >> 3)) * 64 + (id & 7) * 8); vr[i] = *(const bf16x8*)(Vt + (size_t)(id >> 5) * nkeys + k0 + (id & 31) * 8); } }
    __syncthreads();
#pragma unroll
    for (int sub = 0; sub < 4; ++sub) attn_sub(sK, sV, sub * 64, lr, g, q0, q1, o, mrun, lsum);
  }
  attn_store(p, o, lsum, qrow, h, g);
  __syncthreads();
}

__device__ void attn_ctx_item(const P& p, int layer, int b, int kvh, int qt, char* smem) {
  const int tid = otid(), w = tid >> 6, lane = tid & 63, lr = lane & 15, g = lane >> 4;
  const int qg = w & 3, hp = w >> 2;
  const int m0 = b * 256 + qt * 64;
  const u16* U = (const u16*)(p.ws + WS_U);
  const u16* Kb = (const u16*)(p.ws + WS_KC) + (size_t)(b * 2 + kvh) * 256 * 64;
  const u16* Vt = (const u16*)(p.ws + WS_VC) + (size_t)(b * 2 + kvh) * 64 * 256;
  u16* sK = (u16*)smem;
  u16* sV = sK + 256 * 72;
  const int qrow = m0 + qg * 16 + lr;
  bf16x8 kr[4], vr[4];
#pragma unroll
  for (int i = 0; i < 4; ++i) { const int id = tid + i * 512; kr[i] = *(const bf16x8*)(Kb + (size_t)(id >> 3) * 64 + (id & 7) * 8); vr[i] = *(const bf16x8*)(Vt + (size_t)(id >> 5) * 256 + (id & 31) * 8); }
  const int h0 = kvh * 4 + hp * 2;
  const bf16x8 qa0 = *(const bf16x8*)(U + (size_t)qrow * DP + h0 * 64 + g * 8), qa1 = *(const bf16x8*)(U + (size_t)qrow * DP + h0 * 64 + 32 + g * 8);
  const bf16x8 qb0 = *(const bf16x8*)(U + (size_t)qrow * DP + (h0 + 1) * 64 + g * 8), qb1 = *(const bf16x8*)(U + (size_t)qrow * DP + (h0 + 1) * 64 + 32 + g * 8);
  __syncthreads();
#pragma unroll
  for (int i = 0; i < 4; ++i) { const int id = tid + i * 512; *(bf16x8*)(sK + (id >> 3) * 72 + (id & 7) * 8) = kr[i]; *(bf16x8*)(sV + (id >> 5) * 272 + (id & 31) * 8) = vr[i]; }
  __syncthreads();
  f32x4 oa[4], ob[4];
#pragma unroll
  for (int i = 0; i < 4; ++i) { oa[i] = (f32x4){0.f, 0.f, 0.f, 0.f}; ob[i] = (f32x4){0.f, 0.f, 0.f, 0.f}; }
  float ma = -1e30f, la = 0.f, mb = -1e30f, lb = 0.f;
#pragma unroll 2
  for (int sub = 0; sub < 4; ++sub) attn_sub2(sK, sV, sub * 64, lr, g, qa0, qa1, qb0, qb1, oa, ob, ma, la, mb, lb);
  attn_store(p, oa, la, qrow, h0, g);
  attn_store(p, ob, lb, qrow, h0 + 1, g);
  __syncthreads();
}

template <int L, int NSEQ, int CPI>
__device__ void hyena_item(const P& p, int layer, int m0, int c0, char* smem) {
  constexpr int SEL = (L == 1024) ? 1 : 0, NB = L / 16, KS = (NB + 16) / 2, PAD = 256, ZL = L + 2 * PAD, RO = L + 32, CL = 2 * L + 32, CLS = 2 * L + 48, RRL = 2 * L + 48;
  u16* zb = (u16*)smem;
  u16* cp = zb + 8 * NSEQ * ZL;
  u16* rr = cp + CPI * 8 * CLS;
  float* sInv = (float*)(rr + 8 * RRL);
  const int tid = otid(), w = tid >> 6, lane = tid & 63, lr = lane & 15, g = lane >> 4;
  const float* HF = (const float*)(p.ws + WS_HF) + (size_t)layer * HF_LSTRIDE + (SEL ? 256 * HFS : 0);
  const float* NP = (const float*)(p.ws + WS_NP) + (layer * 2 + SEL) * 32 * 1024;
  const u16* UH = (const u16*)(p.ws + WS_UH);
  u16* MIX = (u16*)(p.ws + WS_MIX);
  const float* sw = p.in[13] + layer * 3 * 1536; const float* sbias = p.in[14] + layer * 1536;
  const int sq = tid / (L / 4), t4 = tid % (L / 4);
  const size_t rowb = (size_t)(m0 + sq * L);
  bf16x8 lx1[6], lhv[6], lx0[6], lgv[4];
#pragma unroll
  for (int r6 = 0; r6 < 6; ++r6) { const int t = min(max(t4 * 4 + r6 - 1, 0), L - 1);
    lx1[r6] = *(const bf16x8*)(UH + ((size_t)((512 + c0) >> 3) * MROWS + rowb + t) * 8); lhv[r6] = *(const bf16x8*)(UH + ((size_t)((1024 + c0) >> 3) * MROWS + rowb + t) * 8); lx0[r6] = *(const bf16x8*)(UH + ((size_t)(c0 >> 3) * MROWS + rowb + t) * 8); }
#pragma unroll
  for (int tt = 0; tt < 4; ++tt) lgv[tt] = *(const bf16x8*)(UH + ((size_t)((1536 + c0) >> 3) * MROWS + rowb + t4 * 4 + tt) * 8);
  asm volatile("" ::: "memory");
  if (tid < 8) { float s = 0.f; for (int ch = 0; ch < L / 32; ++ch) s += NP[ch * 1024 + c0 + tid] + NP[ch * 1024 + 512 + c0 + tid]; sInv[tid] = 1.f / s; sInv[8 + tid] = p.in[22][layer * 512 + c0 + tid]; }
  for (int e = tid; e < 8 * NSEQ * 64; e += NT) { const int cs = e >> 6, q = e & 63; const int off = q < 32 ? q * 8 : PAD + L + (q - 32) * 8;
    *(bf16x8*)(zb + cs * ZL + off) = (bf16x8){0, 0, 0, 0, 0, 0, 0, 0}; }
  for (int y = tid; y < RRL; y += NT) { const int d = RO - y; float v[8];
    if (d > -L && d < L) { const float* src = HF + (size_t)(d >= 0 ? d : -d) * HFS + (d >= 0 ? 0 : 512) + c0; const float4 a = *(const float4*)src, b = *(const float4*)(src + 4);
      v[0] = a.x; v[1] = a.y; v[2] = a.z; v[3] = a.w; v[4] = b.x; v[5] = b.y; v[6] = b.z; v[7] = b.w; }
    else {
#pragma unroll
      for (int i = 0; i < 8; ++i) v[i] = 0.f; }
#pragma unroll
    for (int i = 0; i < 8; ++i) rr[i * RRL + y] = f2bf(v[i]); }
  { float wx[3][8], wv[3][8], bx8[8], bv8[8];
#pragma unroll
    for (int j = 0; j < 3; ++j) { const float4 a = *(const float4*)(sw + j * 1536 + 512 + c0), b = *(const float4*)(sw + j * 1536 + 512 + c0 + 4), c = *(const float4*)(sw + j * 1536 + 1024 + c0), d = *(const float4*)(sw + j * 1536 + 1024 + c0 + 4);
      wx[j][0] = a.x; wx[j][1] = a.y; wx[j][2] = a.z; wx[j][3] = a.w; wx[j][4] = b.x; wx[j][5] = b.y; wx[j][6] = b.z; wx[j][7] = b.w;
      wv[j][0] = c.x; wv[j][1] = c.y; wv[j][2] = c.z; wv[j][3] = c.w; wv[j][4] = d.x; wv[j][5] = d.y; wv[j][6] = d.z; wv[j][7] = d.w; }
    { const float4 a = *(const float4*)(sbias + 512 + c0), b = *(const float4*)(sbias + 512 + c0 + 4), c = *(const float4*)(sbias + 1024 + c0), d = *(const float4*)(sbias + 1024 + c0 + 4);
      bx8[0] = a.x; bx8[1] = a.y; bx8[2] = a.z; bx8[3] = a.w; bx8[4] = b.x; bx8[5] = b.y; bx8[6] = b.z; bx8[7] = b.w;
      bv8[0] = c.x; bv8[1] = c.y; bv8[2] = c.z; bv8[3] = c.w; bv8[4] = d.x; bv8[5] = d.y; bv8[6] = d.z; bv8[7] = d.w; }
    float ax[4][8], av[4][8];
#pragma unroll
    for (int tt = 0; tt < 4; ++tt)
#pragma unroll
      for (int i = 0; i < 8; ++i) { ax[tt][i] = bx8[i]; av[tt][i] = bv8[i]; }
#pragma unroll
    for (int rr6 = 0; rr6 < 6; ++rr6) { const int t = t4 * 4 + rr6 - 1;
      if (t >= 0 && t < L) { const bf16x8 x1 = lx1[rr6], hv = lhv[rr6];
#pragma unroll
        for (int tt = 0; tt < 4; ++tt) { const int j = rr6 - tt;
          if (j >= 0 && j < 3) {
#pragma unroll
            for (int i = 0; i < 8; ++i) { ax[tt][i] += bfs(x1[i]) * wx[j][i]; av[tt][i] += bfs(hv[i]) * wv[j][i]; } } } } }
#pragma unroll
    for (int i = 0; i < 8; ++i)
      *(bf16x4*)(zb + (i * NSEQ + sq) * ZL + PAD + t4 * 4) = pk4(ax[0][i] * av[0][i], ax[1][i] * av[1][i], ax[2][i] * av[2][i], ax[3][i] * av[3][i]); }
  float ex[4][8];
  { float w0[3][8], b08[8];
#pragma unroll
    for (int j = 0; j < 3; ++j) { const float4 a = *(const float4*)(sw + j * 1536 + c0), b = *(const float4*)(sw + j * 1536 + c0 + 4);
      w0[j][0] = a.x; w0[j][1] = a.y; w0[j][2] = a.z; w0[j][3] = a.w; w0[j][4] = b.x; w0[j][5] = b.y; w0[j][6] = b.z; w0[j][7] = b.w; }
    { const float4 a = *(const float4*)(sbias + c0), b = *(const float4*)(sbias + c0 + 4); b08[0] = a.x; b08[1] = a.y; b08[2] = a.z; b08[3] = a.w; b08[4] = b.x; b08[5] = b.y; b08[6] = b.z; b08[7] = b.w; }
#pragma unroll
    for (int tt = 0; tt < 4; ++tt)
#pragma unroll
      for (int i = 0; i < 8; ++i) ex[tt][i] = b08[i];
#pragma unroll
    for (int rr6 = 0; rr6 < 6; ++rr6) { const int t = t4 * 4 + rr6 - 1;
      if (t >= 0 && t < L) { const bf16x8 x0 = lx0[rr6];
#pragma unroll
        for (int tt = 0; tt < 4; ++tt) { const int j = rr6 - tt;
          if (j >= 0 && j < 3) {
#pragma unroll
            for (int i = 0; i < 8; ++i) ex[tt][i] += bfs(x0[i]) * w0[j][i]; } } } } }
  __syncthreads();
  const int seq = NSEQ == 2 ? (w >> 2) : w, nt = NSEQ == 2 ? (w & 3) : 0;
  const int Dlo = 16 * nt - NB + 1; const int sh = (-lr) & 7;
  const int a0 = sh * CLS + 8 * (g & 1) - lr - sh - 16 * (Dlo + (g >> 1)) + RO;
  const int b0 = PAD + 16 * (16 * nt + lr - Dlo - (g >> 1)) + 8 * (g & 1);
  f32x4 acc[CPI];
#pragma unroll
  for (int c = 0; c < CPI; ++c) acc[c] = (f32x4){0.f, 0.f, 0.f, 0.f};
  for (int itc = 0; itc <= 8 / CPI; ++itc) {
    if (itc < 8 / CPI) {
#pragma unroll
      for (int c = 0; c < CPI; ++c) { const u16* rc = rr + (itc * CPI + c) * RRL; u16* cpc = cp + c * 8 * CLS;
        for (int chunk = tid; chunk < CL; chunk += NT) { const int k = chunk / (CL / 8), q8 = chunk % (CL / 8); bf16x8 o;
#pragma unroll
          for (int i = 0; i < 8; ++i) o[i] = (short)rc[8 * q8 + k + i];
          *(bf16x8*)(cpc + k * CLS + 8 * q8) = o; } } }
    if (itc > 0) {
#pragma unroll
      for (int c = 0; c < CPI; ++c) { const int chp = (itc - 1) * CPI + (CPI == 2 ? (w >> 2) : c); const int sq_ = CPI == 2 ? 2 * (w & 3) + c : seq;
        u16* zp = zb + (chp * NSEQ + sq_) * ZL + PAD + 16 * (16 * nt + lr) + 4 * g; const float bs = sInv[8 + chp];
        const bf16x4 zv = *(const bf16x4*)zp;
        const float iv = sInv[chp];
        *(bf16x4*)zp = pk4(acc[c][0] * iv + bs * bfs(zv[0]), acc[c][1] * iv + bs * bfs(zv[1]), acc[c][2] * iv + bs * bfs(zv[2]), acc[c][3] * iv + bs * bfs(zv[3])); } }
    __syncthreads();
    if (itc == 8 / CPI) break;
    if (CPI == 1) {
      const u16* zc = zb + (itc * NSEQ + seq) * ZL;
      f32x4 accA = (f32x4){0.f, 0.f, 0.f, 0.f}, accB = (f32x4){0.f, 0.f, 0.f, 0.f};
#pragma unroll 4
      for (int ks = 0; ks < KS; ks += 2) { const bf16x8 a = *(const bf16x8*)(cp + a0 - 32 * ks), b = *(const bf16x8*)(zc + b0 - 32 * ks);
        const bf16x8 a2 = *(const bf16x8*)(cp + a0 - 32 * ks - 32), b2 = *(const bf16x8*)(zc + b0 - 32 * ks - 32);
        accA = mfma16(a, b, accA); accB = mfma16(a2, b2, accB); }
      acc[0] = accA + accB;
    } else {
      const int cw = w >> 2, sp2 = w & 3;
      const u16* zc0 = zb + ((itc * CPI + cw) * NSEQ + 2 * sp2) * ZL; const u16* zc1 = zc0 + ZL; const u16* cpw = cp + cw * 8 * CLS;
      f32x4 accA = (f32x4){0.f, 0.f, 0.f, 0.f}, accB = (f32x4){0.f, 0.f, 0.f, 0.f}, accA1 = (f32x4){0.f, 0.f, 0.f, 0.f}, accB1 = (f32x4){0.f, 0.f, 0.f, 0.f};
#pragma unroll 4
      for (int ks = 0; ks < KS; ks += 2) { const bf16x8 a = *(const bf16x8*)(cpw + a0 - 32 * ks), b = *(const bf16x8*)(zc0 + b0 - 32 * ks), b2 = *(const bf16x8*)(zc1 + b0 - 32 * ks);
        const bf16x8 a1 = *(const bf16x8*)(cpw + a0 - 32 * ks - 32), b1 = *(const bf16x8*)(zc0 + b0 - 32 * ks - 32), b21 = *(const bf16x8*)(zc1 + b0 - 32 * ks - 32);
        accA = mfma16(a, b, accA); accB = mfma16(a, b2, accB); accA1 = mfma16(a1, b1, accA1); accB1 = mfma16(a1, b21, accB1); }
      accA += accA1; accB += accB1;
      acc[0] = accA; acc[CPI - 1] = accB;
    }
    __syncthreads();
  }
  { bf16x4 yz[8];
#pragma unroll
    for (int i = 0; i < 8; ++i) yz[i] = *(const bf16x4*)(zb + (i * NSEQ + sq) * ZL + PAD + t4 * 4);
#pragma unroll
    for (int tt = 0; tt < 4; ++tt) { const bf16x8 gv = lgv[tt]; float of[8];
#pragma unroll
      for (int i = 0; i < 8; ++i) of[i] = ex[tt][i] * bfs(yz[i][tt]) * siluf(bfs(gv[i]));
      *(bf16x8*)(MIX + (rowb + t4 * 4 + tt) * DMIX + 512 + c0) = pk8(of[0], of[1], of[2], of[3], of[4], of[5], of[6], of[7]); } }
  __syncthreads();
}

template <int NTL>
__device__ void lru_item(const P& p, int layer, int lat, int sb, int n, int qd, char* smem) {
  const int L = lat ? 1024 : 256; const int m0 = lat ? MCTX + sb * 1024 : sb * 256;
  const int tid = otid(), w = tid >> 6, lane = tid & 63, lr = lane & 15, g = lane >> 4;
  u16* sW = (u16*)smem;
  float* sCw = (float*)(smem + 18432);
  constexpr bool XC = (NTL == 4);
  float* sX = (float*)(smem + 18432 + 1280);
  u16* sXc = (u16*)(smem + 18432 + 1280);
  float* sTot = (float*)(smem + 18432 + 1280 + (XC ? 36864 : 33280));
  float* sCar = sTot + 2048;
  float* sYf = sCar + 128;
  constexpr int YS = NTL * 16 + 1;
  const u16* U = (const u16*)(p.ws + WS_U);
  u16* MIX = (u16*)(p.ws + WS_MIX);
  const u16* WGT = (const u16*)(p.ws + WS_WGT);
  const int chb = n * 64; const int cq = qd * 16;
  if (tid < 320) sCw[tid] = tid < 256 ? p.in[23][layer * 4 * 512 + (tid >> 6) * 512 + chb + (tid & 63)] : p.in[24][layer * 512 + chb + tid - 256];
  const int nch = L >> 7;
#pragma unroll 1
  for (int dir = 0; dir < 2; ++dir) {
    __syncthreads();
    for (int e = tid; e < 1024; e += NT) { const int gate = e >> 9, d = (e >> 3) & 63, part = e & 7;
      *(bf16x8*)(sW + (gate * 64 + d) * 72 + part * 8) = *(const bf16x8*)(WGT + ((size_t)((((layer * 2 + dir) * 2 + gate) * 8 + n) * 64 + d)) * 64 + part * 8); }
    if (tid < 16 * NTL) sCar[tid] = lat ? p.in[4][((sb * 2 + layer) * 2 + dir) * 512 + chb + cq + tid] : 0.f;
    float ba[NTL], bx[NTL], sp[NTL];
#pragma unroll
    for (int nt = 0; nt < NTL; ++nt) { const int dch = (layer * 2 + dir) * 512 + chb + cq + nt * 16 + lr; ba[nt] = p.in[26][dch]; bx[nt] = p.in[28][dch]; sp[nt] = -8.f * log1pf(expf(-p.in[29][dch])); }
    __syncthreads();
    bf16x8 xin[2][4];
    if (!(XC && dir == 1)) { const int pA = w * 16 + lr; const int tA = dir ? L - 1 - pA : pA;
#pragma unroll
      for (int ks = 0; ks < 2; ++ks)
#pragma unroll
        for (int j = 0; j < 4; ++j) { const int tt = min(max(tA + j - 1, 0), L - 1); xin[ks][j] = *(const bf16x8*)(U + (size_t)(m0 + tt) * DP + 1280 + chb + ks * 32 + g * 8); } }
#pragma unroll 1
    for (int ci = 0; ci < nch; ++ci) {
      const int par = ci & 1; const int pbase = ci * 128 + w * 16;
      const int pA = pbase + lr; const int tA = dir ? L - 1 - pA : pA;
      bf16x8 af[2];
      if (XC && dir == 1) {
#pragma unroll
        for (int ks = 0; ks < 2; ++ks) af[ks] = *(const bf16x8*)(sXc + tA * 72 + ks * 32 + g * 8);
      } else
#pragma unroll
      for (int ks = 0; ks < 2; ++ks) {
        const int cb = ks * 32 + g * 8; float a8[8];
#pragma unroll
        for (int i = 0; i < 8; ++i) a8[i] = sCw[256 + cb + i];
#pragma unroll
        for (int j = 0; j < 4; ++j) { const int tt = tA + j - 1; const float msk = (tt >= 0 && tt < L) ? 1.f : 0.f;
#pragma unroll
          for (int i = 0; i < 8; ++i) a8[i] += msk * bfs(xin[ks][j][i]) * sCw[j * 64 + cb + i]; }
        af[ks] = pk8(a8[0], a8[1], a8[2], a8[3], a8[4], a8[5], a8[6], a8[7]);
        if (XC) *(bf16x8*)(sXc + tA * 72 + cb) = af[ks];
        else {
#pragma unroll
          for (int i = 0; i < 8; ++i) sX[(w * 16 + lr) * 65 + cb + i] = a8[i]; }
      }
      if (ci + 1 < nch && !(XC && dir == 1)) { const int pN = pA + 128; const int tN = dir ? L - 1 - pN : pN;
#pragma unroll
        for (int ks = 0; ks < 2; ++ks)
#pragma unroll
          for (int j = 0; j < 4; ++j) { const int tt = min(max(tN + j - 1, 0), L - 1); xin[ks][j] = *(const bf16x8*)(U + (size_t)(m0 + tt) * DP + 1280 + chb + ks * 32 + g * 8); } }
      float Ap[NTL][4], Bp[NTL][4];
#pragma unroll
      for (int nt = 0; nt < NTL; ++nt) {
        f32x4 pr = (f32x4){0.f, 0.f, 0.f, 0.f}, pi = (f32x4){0.f, 0.f, 0.f, 0.f};
#pragma unroll
        for (int ks = 0; ks < 2; ++ks) { const bf16x8 wr_ = *(const bf16x8*)(sW + (cq + nt * 16 + lr) * 72 + ks * 32 + g * 8), wi_ = *(const bf16x8*)(sW + (64 + cq + nt * 16 + lr) * 72 + ks * 32 + g * 8);
          pr = mfma16(af[ks], wr_, pr); pi = mfma16(af[ks], wi_, pi); }
#pragma unroll
        for (int r = 0; r < 4; ++r) {
          float x;
          if (XC) { const int pq = pbase + 4 * g + r; const int tq = dir ? L - 1 - pq : pq; x = bf2f(sXc[tq * 72 + cq + nt * 16 + lr]); }
          else x = sX[(w * 16 + 4 * g + r) * 65 + cq + nt * 16 + lr];
          const float rr_ = sigm(pr[r] + ba[nt]), ii = sigm(pi[r] + bx[nt]);
          const float la = rr_ * sp[nt]; const float a = fexp(la); const float om = 1.f - a * a; const float b = __builtin_amdgcn_sqrtf(fmaxf(om, 0.f)) * ii * x;
          if (r == 0) { Ap[nt][0] = a; Bp[nt][0] = b; } else { Ap[nt][r] = a * Ap[nt][r - 1]; Bp[nt][r] = a * Bp[nt][r - 1] + b; }
        }
      }
      float EA[NTL], EB[NTL], TA[NTL], TB[NTL];
#pragma unroll
      for (int nt = 0; nt < NTL; ++nt) { EA[nt] = 1.f; EB[nt] = 0.f; TA[nt] = 1.f; TB[nt] = 0.f;
#pragma unroll
        for (int k = 0; k < 4; ++k) { const float ak = __int_as_float(__builtin_amdgcn_ds_bpermute((lr + 16 * k) * 4, __float_as_int(Ap[nt][3]))), bk = __int_as_float(__builtin_amdgcn_ds_bpermute((lr + 16 * k) * 4, __float_as_int(Bp[nt][3])));
          if (k < g) { EB[nt] = ak * EB[nt] + bk; EA[nt] = ak * EA[nt]; }
          TB[nt] = ak * TB[nt] + bk; TA[nt] = ak * TA[nt]; }
        if (g == 0) { sTot[((par * 8 + w) * 2 + 0) * 64 + nt * 16 + lr] = TA[nt]; sTot[((par * 8 + w) * 2 + 1) * 64 + nt * 16 + lr] = TB[nt]; } }
      float yv[NTL][4]; u16 gl[NTL][4];
      if (dir == 1) {
#pragma unroll
        for (int nt = 0; nt < NTL; ++nt)
#pragma unroll
          for (int r = 0; r < 4; ++r) { const int pp = pbase + 4 * g + r; const int t = L - 1 - pp;
            yv[nt][r] = sYf[t * YS + nt * 16 + lr]; gl[nt][r] = U[(size_t)(m0 + t) * DP + 1792 + chb + cq + nt * 16 + lr]; } }
      __syncthreads();
#pragma unroll
      for (int nt = 0; nt < NTL; ++nt) {
        float hin = sCar[par * 64 + nt * 16 + lr];
        float ak7[7], bk7[7];
#pragma unroll
        for (int k = 0; k < 7; ++k) { ak7[k] = sTot[((par * 8 + k) * 2 + 0) * 64 + nt * 16 + lr]; bk7[k] = sTot[((par * 8 + k) * 2 + 1) * 64 + nt * 16 + lr]; }
#pragma unroll
        for (int k = 0; k < 7; ++k) { const float tnew = ak7[k] * hin + bk7[k]; hin = (k < w) ? tnew : hin; }
        if (w == 7 && g == 0) sCar[(par ^ 1) * 64 + nt * 16 + lr] = TA[nt] * hin + TB[nt];
        const float hg = EA[nt] * hin + EB[nt];
        const int dch = chb + cq + nt * 16 + lr;
#pragma unroll
        for (int r = 0; r < 4; ++r) {
          const float hv = Ap[nt][r] * hg + Bp[nt][r];
          const int pp = pbase + 4 * g + r; const int t = dir ? L - 1 - pp : pp;
          if (dir == 0) sYf[t * YS + nt * 16 + lr] = hv;
          else MIX[(size_t)(m0 + t) * DMIX + 1024 + dch] = f2bf((yv[nt][r] + hv) * siluf(bf2f(gl[nt][r])));
          if (!lat && pp == L - 1) p.out[(size_t)OUT_LRU + ((sb * 2 + layer) * 2 + dir) * 512 + dch] = hv;
        }
      }
    }
  }
  __syncthreads();
}

__device__ void mixers_phase(const P& p, int layer, char* smem, int rep = 0) {
  __shared__ int s_item;
  int* cnt = (int*)(p.ws + WS_CNT) + layer + 2 * rep;
  if (otid() == 0) s_item = atomicAdd(cnt, 1);
  __syncthreads();
  int it = s_item;
  __syncthreads();
  while (it < 1024) {
    int nxt = 0;
    if (otid() == 0) nxt = atomicAdd(cnt, 1);
    if (it < 64) { for (int r = 0; r < REP_LRU; ++r) lru_item<1>(p, layer, 1, it >> 5, (it >> 2) & 7, it & 3, smem); }
    else if (it < 128) { const int i = it - 64; for (int r = 0; r < REP_HY; ++r) hyena_item<1024, 2, 1>(p, layer, MCTX, i * 8, smem); }
    else if (it < 256) { const int i = it - 128; for (int r = 0; r < REP_AT; ++r) attn_item(p, layer, 1, i >> 6, (i >> 3) & 7, i & 7, smem); }
    else if (it < 512) { const int i = it - 256; for (int r = 0; r < REP_HY; ++r) hyena_item<256, 8, 2>(p, layer, (i >> 6) * 2048, (i & 63) * 8, smem); }
    else if (it < 768) { const int i = it - 512; for (int r = 0; r < REP_LRU; ++r) lru_item<4>(p, layer, 0, i >> 3, i & 7, 0, smem); }
    else { const int i = it - 768; for (int r = 0; r < REP_AT; ++r) attn_ctx_item(p, layer, i >> 3, (i >> 2) & 1, i & 3, smem); }
    if (otid() == 0) s_item = nxt;
    __syncthreads();
    it = s_item;
    __syncthreads();
  }
}

#define XB_TMO      128
#define XB_XCNT(j)  (256  + 64 * (j))
#define XB_XSUB(j)  (1280 + 64 * (j))
#define XB_XGEN(j)  (2304 + 64 * (j))
#define XB_TOP      3328
#define XB_TOPGEN   3392
#define XCD_BAR_WORDS 3456
#define XB_SPIN_CAP (1u << 18)
#define LAS __attribute__((address_space(3)))

__device__ __forceinline__ unsigned xb_ld(unsigned* p)              { return __hip_atomic_load(p, __ATOMIC_RELAXED, __HIP_MEMORY_SCOPE_AGENT); }
__device__ __forceinline__ unsigned xb_add(unsigned* p, unsigned v) { return __hip_atomic_fetch_add(p, v, __ATOMIC_RELAXED, __HIP_MEMORY_SCOPE_AGENT); }
__device__ __forceinline__ unsigned xb_xcc_id() { return (unsigned)__builtin_amdgcn_s_getreg((3 << 11) | 20) & 0xFu; }
#define XB_SPIN(cond, bar) do { unsigned _sp = 0; while (cond) { __builtin_amdgcn_s_sleep(1); \
    if ((++_sp & 255u) == 0u) { if (xb_ld(&(bar)[XB_TMO])) break; if (_sp > XB_SPIN_CAP) { atomicAdd(&(bar)[XB_TMO], 1u); break; } } } } while (0)

struct XcdBarrier {
    unsigned* bar; unsigned x;
    volatile LAS unsigned* st;
};

__device__ __forceinline__ XcdBarrier xcd_barrier_post(unsigned* bar, volatile LAS unsigned* st) {
    XcdBarrier b; b.bar = bar; b.x = xb_xcc_id(); b.st = st;
    if (threadIdx.x == 0) (void)xb_add(&bar[XB_XCNT(b.x)], 1u);
    return b;
}
__device__ __forceinline__ void xcd_barrier_complete(unsigned* bar, unsigned x, unsigned& nloc, unsigned& nx) {
    const unsigned G = gridDim.x * gridDim.y * gridDim.z;
    unsigned sum, cnt, mine, sp = 0u;
    for (;;) {
        sum = 0u; cnt = 0u; mine = 0u;
#pragma unroll
        for (unsigned j = 0; j < 16; ++j) { const unsigned c = xb_ld(&bar[XB_XCNT(j)]); sum += c; cnt += (c > 0u) ? 1u : 0u; mine = (j == x) ? c : mine; }
        if (sum == G) break;
        __builtin_amdgcn_s_sleep(1);
        if ((++sp & 255u) == 0u) { if (xb_ld(&bar[XB_TMO])) break; if (sp > XB_SPIN_CAP) { atomicAdd(&bar[XB_TMO], 1u); break; } }
    }
    nloc = mine > 0u ? mine : 1u; nx = cnt > 0u ? cnt : 1u;
}

__device__ __forceinline__ void xcd_barrier(const XcdBarrier& b) {
    asm volatile("s_waitcnt vmcnt(0)" ::: "memory");
    __syncthreads();
    if (threadIdx.x == 0) {
        unsigned* bar = b.bar;
        __builtin_amdgcn_s_waitcnt(0);
        unsigned nloc = b.st[0], nx = b.st[1];
        if (nloc == 0u) { xcd_barrier_complete(bar, b.x, nloc, nx); b.st[0] = nloc; b.st[1] = nx; }
        const unsigned old = xb_add(&bar[XB_XSUB(b.x)], 1u);
        const unsigned gen = old / nloc;
        if (old + 1u == (gen + 1u) * nloc) {
            __builtin_amdgcn_fence(__ATOMIC_RELEASE, "agent");
            asm volatile("s_waitcnt vmcnt(0)" ::: "memory");
            const unsigned og = xb_add(&bar[XB_TOP], 1u);
            const unsigned tg = og / nx;
            if (og + 1u == (tg + 1u) * nx) xb_add(&bar[XB_TOPGEN], 1u);
            else XB_SPIN(xb_ld(&bar[XB_TOPGEN]) == tg, bar);
            __builtin_amdgcn_fence(__ATOMIC_ACQUIRE, "agent");
            xb_add(&bar[XB_XGEN(b.x)], 1u);
            asm volatile("s_waitcnt vmcnt(0)" ::: "memory");
        } else {
            XB_SPIN(xb_ld(&bar[XB_XGEN(b.x)]) == gen, bar);
            __builtin_amdgcn_fence(__ATOMIC_ACQUIRE, "agent");
            asm volatile("s_waitcnt vmcnt(0)" ::: "memory");
        }
    }
    __syncthreads();
}


#ifndef MULTI
#define MULTI 0
#endif
#ifndef REP_NORM
#define REP_NORM 1
#endif
#ifndef REP_G0
#define REP_G0 1
#endif
#ifndef REP_MIX
#define REP_MIX 1
#endif
#ifndef REP_P0
#define REP_P0 1
#endif
#if MULTI
#ifndef XK
#define XK -1
#endif
#ifndef XN
#define XN 0
#endif
__global__ void __launch_bounds__(NT) k_phase0(P p) { extern __shared__ __attribute__((aligned(16))) char smem[]; phase0(p, smem); }
__global__ void __launch_bounds__(NT) k_prep1(P p) { extern __shared__ __attribute__((aligned(16))) char smem[]; phase0_items<1, 2>(p, smem); }
__global__ void __launch_bounds__(NT) k_norm(P p, int layer) { norm_phase(p, layer); }
__global__ void __launch_bounds__(NT) k_gemm0(P p, int layer) { extern __shared__ __attribute__((aligned(16))) char smem[]; gemm_phase<0>(p, layer, smem); }
__global__ void __launch_bounds__(NT) k_gemm1(P p, int layer) { extern __shared__ __attribute__((aligned(16))) char smem[]; gemm_phase<1>(p, layer, smem); }
__global__ void __launch_bounds__(NT) k_hy_lat(P p, int layer) { extern __shared__ __attribute__((aligned(16))) char smem[];
  for (int it = blockIdx.x; it < 64; it += gridDim.x) hyena_item<1024, 2, 1>(p, layer, MCTX, it * 8, smem); }
__global__ void __launch_bounds__(NT) k_hy_ctx(P p, int layer) { extern __shared__ __attribute__((aligned(16))) char smem[];
  for (int i = blockIdx.x; i < 256; i += gridDim.x) hyena_item<256, 8, 2>(p, layer, (i >> 6) * 2048, (i & 63) * 8, smem); }
__global__ void __launch_bounds__(NT) k_attn_lat(P p, int layer) { extern __shared__ __attribute__((aligned(16))) char smem[];
  for (int it = blockIdx.x; it < 128; it += gridDim.x) attn_item(p, layer, 1, it >> 6, (it >> 3) & 7, it & 7, smem); }
__global__ void __launch_bounds__(NT) k_attn_ctx(P p, int layer) { extern __shared__ __attribute__((aligned(16))) char smem[];
  for (int i = blockIdx.x; i < 256; i += gridDim.x) attn_ctx_item(p, layer, i >> 3, (i >> 2) & 1, i & 3, smem); }
__global__ void __launch_bounds__(NT) k_lru_lat(P p, int layer) { extern __shared__ __attribute__((aligned(16))) char smem[];
  for (int it = blockIdx.x; it < 64; it += gridDim.x) lru_item<1>(p, layer, 1, it >> 5, (it >> 2) & 7, it & 3, smem); }
__global__ void __launch_bounds__(NT) k_lru_ctx(P p, int layer) { extern __shared__ __attribute__((aligned(16))) char smem[];
  for (int i = blockIdx.x; i < 256; i += gridDim.x) lru_item<4>(p, layer, 0, i >> 3, i & 7, 0, smem); }
#else
__global__ void __launch_bounds__(NT) mega(P p) {
  extern __shared__ __attribute__((aligned(16))) char smem[];
  __shared__ uint4 xb_words;
  cg::grid_group grid = cg::this_grid();
  if (threadIdx.x == 0) xb_words = make_uint4(0u, 0u, 0u, 0u);
  __syncthreads();
  (void)xcd_barrier_post((unsigned*)(p.ws + WS_BAR), (volatile LAS unsigned*)&xb_words);
#define GRID_BAR() do { XcdBarrier xb_; xb_.bar = (unsigned*)(p.ws + WS_BAR); xb_.x = xb_xcc_id(); xb_.st = (volatile LAS unsigned*)&xb_words; xcd_barrier(xb_); } while (0)
  phase0(p, smem);
  if (p.ws == nullptr) grid.sync();
  GRID_BAR();
#pragma unroll 1
  for (int layer_ = 0; layer_ < 2; ++layer_) {
    const int layer = osgpr(layer_);
#pragma unroll 1
    for (int rep = 0; rep < REP_NORM; ++rep) { norm_phase(p, osgpr(layer)); GRID_BAR(); }
    gemm_phase<0>(p, osgpr(layer), smem);
    if (layer == 0 && ((int)gridDim.x <= 168 || (int)blockIdx.x >= 168)) phase0_items<0, 1>(p, smem);
    GRID_BAR();
#pragma unroll 1
    for (int rep = 0; rep < REP_MIX; ++rep) { mixers_phase(p, osgpr(layer), smem, osgpr(rep)); GRID_BAR(); }
    gemm_phase<1>(p, osgpr(layer), smem);
    if (layer == 0 && ((int)gridDim.x <= 160 || (int)blockIdx.x >= 160)) phase0_items<1, 2>(p, smem);
    GRID_BAR();
  }
  norm_phase(p, 2);
}
#endif

extern "C" void kernel_launch(void* const* d_in, const int* in_sizes, int n_in, void* d_out, int out_size, void* d_ws, size_t ws_size, hipStream_t stream) {
  static int grid = 0;
  if (grid == 0) {
    if (n_in != 32 || ws_size < WS_END) { fprintf(stderr, "kernel_launch: unexpected n_in %d / ws %zu (need %zu)\n", n_in, ws_size, (size_t)WS_END); grid = -1; return; }
    int dev = 0, cus = 0, per_cu = 0;
    (void)hipGetDevice(&dev);
    (void)hipDeviceGetAttribute(&cus, hipDeviceAttributeMultiprocessorCount, dev);
#if MULTI
    const void* ks[] = {(const void*)k_phase0, (const void*)k_prep1, (const void*)k_gemm0, (const void*)k_gemm1, (const void*)k_hy_lat, (const void*)k_hy_ctx, (const void*)k_attn_lat, (const void*)k_attn_ctx, (const void*)k_lru_lat, (const void*)k_lru_ctx};
    for (int i = 0; i < 10; ++i) if (hipFuncSetAttribute(ks[i], hipFuncAttributeMaxDynamicSharedMemorySize, LDS_BYTES) != hipSuccess) { fprintf(stderr, "hipFuncSetAttribute failed\n"); grid = -1; return; }
    (void)per_cu;
#else
    if (hipFuncSetAttribute((const void*)mega, hipFuncAttributeMaxDynamicSharedMemorySize, LDS_BYTES) != hipSuccess) { fprintf(stderr, "hipFuncSetAttribute failed\n"); grid = -1; return; }
    if (hipOccupancyMaxActiveBlocksPerMultiprocessor(&per_cu, (const void*)mega, NT, LDS_BYTES) != hipSuccess || per_cu < 1) { fprintf(stderr, "occupancy query failed (%d)\n", per_cu); grid = -1; return; }
#endif
    grid = cus;
  }
  if (grid < 0) return;
  (void)hipMemsetAsync((char*)d_ws + WS_CNT, 0, 256 + 13824, stream);
  P prm{};
  for (int i = 0; i < 32; ++i) prm.in[i] = (const float*)d_in[i];
  prm.out = (float*)d_out; prm.ws = (char*)d_ws;
#if MULTI
  k_phase0<<<grid, NT, LDS_BYTES, stream>>>(prm);
  k_prep1<<<grid, NT, LDS_BYTES, stream>>>(prm);
  for (int layer = 0; layer < 2; ++layer) {
    for (int x = 0; x < 1 + (XK == 0 ? XN : 0); ++x) k_norm<<<grid, NT, 0, stream>>>(prm, layer);
    for (int x = 0; x < 1 + (XK == 1 ? XN : 0); ++x) k_gemm0<<<grid, NT, LDS_BYTES, stream>>>(prm, layer);
    for (int x = 0; x < 1 + (XK == 2 ? XN : 0); ++x) k_hy_lat<<<64, NT, LDS_BYTES, stream>>>(prm, layer);
    for (int x = 0; x < 1 + (XK == 3 ? XN : 0); ++x) k_hy_ctx<<<grid, NT, LDS_BYTES, stream>>>(prm, layer);
    for (int x = 0; x < 1 + (XK == 4 ? XN : 0); ++x) k_attn_lat<<<grid, NT, LDS_BYTES, stream>>>(prm, layer);
    for (int x = 0; x < 1 + (XK == 5 ? XN : 0); ++x) k_attn_ctx<<<grid, NT, LDS_BYTES, stream>>>(prm, layer);
    for (int x = 0; x < 1 + (XK == 6 ? XN : 0); ++x) k_lru_lat<<<64, NT, LDS_BYTES, stream>>>(prm, layer);
    for (int x = 0; x < 1 + (XK == 7 ? XN : 0); ++x) k_lru_ctx<<<grid, NT, LDS_BYTES, stream>>>(prm, layer);
    k_gemm1<<<grid, NT, LDS_BYTES, stream>>>(prm, layer);
  }
  k_norm<<<grid, NT, 0, stream>>>(prm, 2);
#else
  void* args[] = {&prm};
  hipError_t e = hipLaunchCooperativeKernel((const void*)mega, dim3(grid), dim3(NT), args, LDS_BYTES, stream);
  if (e != hipSuccess) fprintf(stderr, "cooperative launch failed: %s (grid %d)\n", hipGetErrorString(e), grid);
#endif
}
```

```cpp
#include <hip/hip_runtime.h>
#include <hip/hip_bf16.h>
#include <hip/hip_cooperative_groups.h>
#include <cstdio>
namespace cg = cooperative_groups;

#ifndef REP_HY
#define REP_HY 1
#endif
#ifndef REP_AT
#define REP_AT 1
#endif
#ifndef REP_LRU
#define REP_LRU 1
#endif
typedef unsigned short u16;
using bf16x8 = __attribute__((ext_vector_type(8))) short;
using bf16x4 = __attribute__((ext_vector_type(4))) short;
using f32x4 = __attribute__((ext_vector_type(4))) float;

#define NT 512
constexpr int MROWS = 10240, MCTX = 8192, DM = 1024, DP = 2336  , DMIX = 1536;
constexpr int LDS_BYTES = 131072 + 8192;
constexpr int OUT_YS = 8388608, OUT_K = 10485760, OUT_V = 12582912, OUT_LRU = 14680064;

constexpr size_t WS_WTIN = 0;
constexpr size_t WS_WTOUT = WS_WTIN + (size_t)2 * 4352 * 1024 * 2;
constexpr size_t WS_WGT = WS_WTOUT + (size_t)2 * 1024 * 1536 * 2;
constexpr size_t WS_MOD = WS_WGT + (size_t)2 * 2 * 2 * 8 * 64 * 64 * 2;
constexpr size_t WS_ROPE = WS_MOD + (size_t)2 * 3 * 3072 * 4;
constexpr size_t WS_HF = WS_ROPE + 8192;
constexpr int HFS = 1040;
constexpr size_t HF_LSTRIDE = (size_t)1280 * HFS;
constexpr size_t WS_NP = WS_HF + 2 * HF_LSTRIDE * 4;
constexpr size_t WS_CNT = WS_NP + (size_t)2 * 2 * 32 * 1024 * 4;
constexpr size_t WS_BAR = WS_CNT + 256;
constexpr size_t WS_H = WS_BAR + 13824;
constexpr size_t WS_U = WS_H + (size_t)MROWS * 1024 * 2;
constexpr size_t WS_UH = WS_U + (size_t)MROWS * DP * 2;
constexpr size_t WS_KC = WS_UH + (size_t)256 * MROWS * 8 * 2;
constexpr size_t WS_VC = WS_KC + (size_t)32 * 2 * 256 * 64 * 2;
constexpr size_t WS_KL = WS_VC + (size_t)32 * 2 * 256 * 64 * 2;
constexpr size_t WS_VL = WS_KL + (size_t)2 * 2 * 2 * 1536 * 64 * 2;
constexpr size_t WS_MIX = WS_VL + (size_t)2 * 2 * 2 * 1536 * 64 * 2;
constexpr size_t WS_X = WS_MIX + (size_t)MROWS * DMIX * 2;
constexpr size_t WS_END = WS_X + (size_t)MROWS * 1024 * 4;

struct P { const float* in[32]; float* out; char* ws; };

__device__ __forceinline__ u16 f2bf(float f) { unsigned u = __float_as_uint(f); u += 0x7fffu + ((u >> 16) & 1u); return (u16)(u >> 16); }
__device__ __forceinline__ unsigned cvtpk(float lo, float hi) { unsigned r; asm("v_cvt_pk_bf16_f32 %0, %1, %2" : "=v"(r) : "v"(lo), "v"(hi)); return r; }
__device__ __forceinline__ bf16x4 pk4(float a, float b, float c, float d) { typedef unsigned u32x2 __attribute__((ext_vector_type(2))); u32x2 t; t.x = cvtpk(a, b); t.y = cvtpk(c, d); return __builtin_bit_cast(bf16x4, t); }
__device__ __forceinline__ bf16x8 pk8(float a, float b, float c, float d, float e, float f, float g, float h) { typedef unsigned u32x4_ __attribute__((ext_vector_type(4))); u32x4_ t; t.x = cvtpk(a, b); t.y = cvtpk(c, d); t.z = cvtpk(e, f); t.w = cvtpk(g, h); return __builtin_bit_cast(bf16x8, t); }
__device__ __forceinline__ float bf2f(u16 h) { return __uint_as_float(((unsigned)h) << 16); }
__device__ __forceinline__ float bfs(short h) { return __uint_as_float(((unsigned)(u16)h) << 16); }
__device__ __forceinline__ float fexp(float x) { return __expf(x); }
__device__ __forceinline__ float siluf(float x) { return x * __builtin_amdgcn_rcpf(1.f + fexp(-x)); }
__device__ __forceinline__ float sigm(float x) { return __builtin_amdgcn_rcpf(1.f + fexp(-x)); }

__device__ __forceinline__ int otid() { int t; asm volatile("v_mov_b32 %0, %1" : "=v"(t) : "v"((int)threadIdx.x)); return t; }
__device__ __forceinline__ int osgpr(int x) { asm volatile("" : "+s"(x)); return x; }
__device__ void p0_filter(const P& p, char* smem, int it) {
  const int l = it / 40, r = it % 40; const int sel = r >= 8; const int chunk = sel ? r - 8 : r;
  const int L = sel ? 1024 : 256;
  float* feats = (float*)smem;
  float* h1 = feats + 32 * 36;
  float* h2 = h1 + 32 * 64;
  const int tid = otid();
  const float* w1 = p.in[15] + l * 33 * 64; const float* b1 = p.in[16] + l * 64;
  const float* w2 = p.in[17] + l * 64 * 64; const float* b2 = p.in[18] + l * 64;
  const float* w3 = p.in[19] + l * 64 * 1024; const float* fq = p.in[20] + l * 128; const float* dec = p.in[21] + l * 1024;
  const int c0 = tid;
  float wq[2][64];
#pragma unroll
  for (int j = 0; j < 64; ++j) { wq[0][j] = w3[j * 1024 + c0]; wq[1][j] = w3[j * 1024 + 512 + c0]; }
  for (int e = tid; e < 32 * 33; e += NT) {
    int tt = e / 33, j = e % 33; int t = chunk * 32 + tt; float v;
    if (j == 0) v = (float)t / (float)(L - 1);
    else { int i = (j - 1) & 15; float f = 1e-4f + (float)i * ((15.0f - 1e-4f) / 15.0f);
      float w = 6.283185307179586f * (float)t / (float)L; float a = f * w; v = (j <= 16) ? __cosf(a) : -__sinf(a); }
    feats[tt * 36 + j] = v;
  }
  __syncthreads();
  { const int j = tid & 63, tq = tid >> 6; float acc[4];
#pragma unroll
    for (int i = 0; i < 4; ++i) acc[i] = b1[j];
    float wcol[33];
#pragma unroll
    for (int e = 0; e < 33; ++e) wcol[e] = w1[e * 64 + j];
#pragma unroll
    for (int e = 0; e < 33; ++e) {
#pragma unroll
      for (int i = 0; i < 4; ++i) acc[i] += feats[(tq * 4 + i) * 36 + e] * wcol[e]; }
    float f0 = fq[j];
#pragma unroll
    for (int i = 0; i < 4; ++i) h1[(tq * 4 + i) * 64 + j] = __sinf(f0 * acc[i]); }
  __syncthreads();
  { const int j = tid & 63, tq = tid >> 6; float acc[4];
#pragma unroll
    for (int i = 0; i < 4; ++i) acc[i] = b2[j];
    float wcol[64];
#pragma unroll
    for (int e = 0; e < 64; ++e) wcol[e] = w2[e * 64 + j];
#pragma unroll
    for (int e = 0; e < 64; ++e) {
#pragma unroll
      for (int i = 0; i < 4; ++i) acc[i] += h1[(tq * 4 + i) * 64 + e] * wcol[e]; }
    float f1 = fq[64 + j];
#pragma unroll
    for (int i = 0; i < 4; ++i) h2[(tq * 4 + i) * 64 + j] = __sinf(f1 * acc[i]); }
  __syncthreads();
  float* HF = (float*)(p.ws + WS_HF) + (size_t)l * HF_LSTRIDE + (sel ? 256 * HFS : 0);
  float* NP = (float*)(p.ws + WS_NP) + ((l * 2 + sel) * 32 + chunk) * 1024;
  { const float d0 = dec[c0], d1 = dec[512 + c0]; float as0 = 0.f, as1 = 0.f;
#pragma unroll 1
    for (int tt = 0; tt < 32; ++tt) {
      float a0 = 0.f, a1 = 0.f;
#pragma unroll
      for (int j4 = 0; j4 < 16; ++j4) { const float4 hv = *(const float4*)(h2 + tt * 64 + j4 * 4);
        a0 += hv.x * wq[0][j4 * 4] + hv.y * wq[0][j4 * 4 + 1] + hv.z * wq[0][j4 * 4 + 2] + hv.w * wq[0][j4 * 4 + 3];
        a1 += hv.x * wq[1][j4 * 4] + hv.y * wq[1][j4 * 4 + 1] + hv.z * wq[1][j4 * 4 + 2] + hv.w * wq[1][j4 * 4 + 3]; }
      const int t = chunk * 32 + tt; const float tv = (float)t / (float)(L - 1);
      const float v0 = a0 * expf(-tv * d0), v1 = a1 * expf(-tv * d1);
      HF[(size_t)t * HFS + c0] = v0; HF[(size_t)t * HFS + 512 + c0] = v1;
      as0 += fabsf(v0); if (t != 0) as1 += fabsf(v1);
    }
    NP[c0] = as0; NP[512 + c0] = as1;
  }
  __syncthreads();
}

__device__ void p0_adaln(const P& p, char* smem, int it) {
  const int l = it / 96, j0 = (it % 96) * 32; const int tid = otid();
  float* ss = (float*)smem;
  float* red = ss + 3072;
  for (int e = tid; e < 3072; e += NT) { int cv = e >> 10, k = e & 1023; float x = cv == 0 ? p.in[6][k] : p.in[5][(cv - 1) * 1024 + k]; ss[e] = x / (1.f + expf(-x)); }
  __syncthreads();
  const int c = tid & 31, kg = tid >> 5;
  const float* W = p.in[8] + (size_t)l * 1024 * 3072 + j0 + c;
  float a0 = 0.f, a1 = 0.f, a2 = 0.f;
#pragma unroll 32
  for (int k = kg * 64; k < kg * 64 + 64; ++k) { float w = W[(size_t)k * 3072]; a0 += ss[k] * w; a1 += ss[1024 + k] * w; a2 += ss[2048 + k] * w; }
  red[(kg * 3 + 0) * 32 + c] = a0; red[(kg * 3 + 1) * 32 + c] = a1; red[(kg * 3 + 2) * 32 + c] = a2;
  __syncthreads();
  if (tid < 96) { int cv = tid >> 5, cc = tid & 31; float s = p.in[9][l * 3072 + j0 + cc];
    for (int k = 0; k < 16; ++k) s += red[(k * 3 + cv) * 32 + cc];
    ((float*)(p.ws + WS_MOD))[(l * 3 + cv) * 3072 + j0 + cc] = s; }
  __syncthreads();
}

__device__ void p0_transpose(const float* src, u16* dst, int K, int N, int kt, int nt, char* smem) {
  float* T = (float*)smem;
  const int tid = otid(); const int r = tid >> 6, c4 = (tid & 63) * 4;
  float4 v[8];
#pragma unroll
  for (int h = 0; h < 8; ++h) v[h] = *(const float4*)(src + (size_t)(kt * 64 + r + h * 8) * N + nt * 256 + c4);
#pragma unroll
  for (int h = 0; h < 8; ++h) { float* tp = T + (r + h * 8) * 257 + c4; tp[0] = v[h].x; tp[1] = v[h].y; tp[2] = v[h].z; tp[3] = v[h].w; }
  __syncthreads();
  const int n = tid >> 1, kh = (tid & 1) * 32;
#pragma unroll
  for (int q = 0; q < 4; ++q) { bf16x8 o;
#pragma unroll
    for (int i = 0; i < 8; ++i) o[i] = (short)f2bf(T[(kh + q * 8 + i) * 257 + n]);
    *(bf16x8*)(dst + (size_t)(nt * 256 + n) * K + kt * 64 + kh + q * 8) = o; }
  __syncthreads();
}

template <int l, int part>
__device__ void phase0_items(const P& p, char* smem) {
  __shared__ int s_it0;
  int* cnt = (int*)(p.ws + WS_CNT) + 8 + l * 4 + part;
  const int n_fil = part == 0 ? 0 : 40, n_ada = part == 1 ? 0 : 96, n_win = part == 1 ? 0 : 272, n_wout = part == 0 ? 0 : 96;
  for (;;) {
    if (otid() == 0) s_it0 = atomicAdd(cnt, 1);
    __syncthreads();
    int it = s_it0;
    __syncthreads();
    if (it >= n_fil + n_ada + n_win + n_wout) break;
    if (n_fil > 0 && it < n_fil) { p0_filter(p, smem, l * 40 + it); continue; }
    it -= n_fil;
    if (n_ada > 0 && it < n_ada) { p0_adaln(p, smem, l * 96 + it); continue; }
    it -= n_ada;
    if (n_win > 0 && it < n_win) { const int nt = it / 16, kt = it % 16;
      p0_transpose(p.in[10] + (size_t)l * 1024 * 4352, (u16*)(p.ws + WS_WTIN) + (size_t)l * 4352 * 1024, 1024, 4352, kt, nt, smem); continue; }
    it -= n_win;
    if (n_wout > 0) { const int nt = it / 24, kt = it % 24;
      p0_transpose(p.in[30] + (size_t)l * 1536 * 1024, (u16*)(p.ws + WS_WTOUT) + (size_t)l * 1024 * 1536, 1536, 1024, kt, nt, smem); }
  }
}

__device__ void phase0(const P& p, char* smem) {
  const int G = gridDim.x;
  phase0_items<0, 0>(p, smem);
  const int gt = blockIdx.x * NT + otid(), gn = G * NT;
  u16* KL = (u16*)(p.ws + WS_KL); u16* VL = (u16*)(p.ws + WS_VL);
  for (int idx = gt; idx < 2 * 2 * 2 * 512 * 64; idx += gn) {
    int d = idx & 63, pp = (idx >> 6) & 511, kvh = (idx >> 15) & 1, b = (idx >> 16) & 1, l = idx >> 17;
    size_t src = ((((size_t)b * 2 + l) * 512 + pp) * 2 + kvh) * 64 + d;
    KL[((size_t)((l * 2 + b) * 2 + kvh) * 1536 + pp) * 64 + d] = f2bf(p.in[2][src]);
    VL[((size_t)((l * 2 + b) * 2 + kvh) * 64 + d) * 1536 + pp] = f2bf(p.in[3][src]);
  }
  float* rope = (float*)(p.ws + WS_ROPE);
  for (int idx = gt; idx < 1024; idx += gn) { int pos = idx >> 4, fi = idx & 15; float inv = powf(10000.0f, -(float)fi / 16.0f); float a = (float)pos * inv;
    rope[idx * 2] = cosf(a); rope[idx * 2 + 1] = sinf(a); }
  u16* WGT = (u16*)(p.ws + WS_WGT);
  for (int idx = gt; idx < 2 * 2 * 2 * 8 * 64 * 64; idx += gn) {
    int c = idx & 63, d = (idx >> 6) & 63, n = (idx >> 12) & 7, gate = (idx >> 15) & 1, dir = (idx >> 16) & 1, l = idx >> 17;
    const float* src = gate ? p.in[27] : p.in[25];
    WGT[idx] = f2bf(src[((size_t)((l * 2 + dir) * 8 + n) * 64 + c) * 64 + d]);
  }
}

__device__ void norm_phase(const P& p, int layer) {
  const int wave = otid() >> 6, lane = otid() & 63;
  const float* X = (const float*)(p.ws + WS_X);
  u16* H = (u16*)(p.ws + WS_H);
  const int stride = gridDim.x * 8;
  int row = blockIdx.x * 8 + wave;
  float4 vn[4];
  if (row < MROWS) { const float* x = layer == 0 ? (row < MCTX ? p.in[0] + (size_t)row * 1024 : p.in[1] + (size_t)(row - MCTX) * 1024) : X + (size_t)row * 1024;
#pragma unroll
    for (int i = 0; i < 4; ++i) vn[i] = *(const float4*)(x + i * 256 + lane * 4); }
  for (; row < MROWS; row += stride) {
    float4 v[4]; float ss = 0.f;
#pragma unroll
    for (int i = 0; i < 4; ++i) { v[i] = vn[i]; ss += v[i].x * v[i].x + v[i].y * v[i].y + v[i].z * v[i].z + v[i].w * v[i].w; }
    { const int rn = row + stride;
      if (rn < MROWS) { const float* x = layer == 0 ? (rn < MCTX ? p.in[0] + (size_t)rn * 1024 : p.in[1] + (size_t)(rn - MCTX) * 1024) : X + (size_t)rn * 1024;
#pragma unroll
        for (int i = 0; i < 4; ++i) vn[i] = *(const float4*)(x + i * 256 + lane * 4); } }
#pragma unroll
    for (int o = 32; o >= 1; o >>= 1) ss += __shfl_xor(ss, o);
    const float rstd = rsqrtf(ss * (1.f / 1024.f) + 1e-6f);
    if (layer < 2) {
      const int cv = row < MCTX ? 0 : 1 + ((row - MCTX) >> 10);
      const float* md = (const float*)(p.ws + WS_MOD) + (layer * 3 + cv) * 3072;
      const float* g = p.in[7] + layer * 1024;
#pragma unroll
      for (int i = 0; i < 4; ++i) { const int k = i * 256 + lane * 4;
        float4 g4 = *(const float4*)(g + k), sh = *(const float4*)(md + k), sc = *(const float4*)(md + 1024 + k);
        *(bf16x4*)(H + (size_t)row * 1024 + k) = pk4(v[i].x * rstd * g4.x * (1.f + sc.x) + sh.x, v[i].y * rstd * g4.y * (1.f + sc.y) + sh.y,
                                                     v[i].z * rstd * g4.z * (1.f + sc.z) + sh.z, v[i].w * rstd * g4.w * (1.f + sc.w) + sh.w); }
    } else {
      float* o = p.out + (row < MCTX ? (size_t)row * 1024 : (size_t)OUT_YS + (size_t)(row - MCTX) * 1024);
      const float* g = p.in[31];
#pragma unroll
      for (int i = 0; i < 4; ++i) { const int k = i * 256 + lane * 4; float4 g4 = *(const float4*)(g + k); float4 r;
        r.x = v[i].x * rstd * g4.x; r.y = v[i].y * rstd * g4.y; r.z = v[i].z * rstd * g4.z; r.w = v[i].w * rstd * g4.w;
        *(float4*)(o + k) = r; }
    }
  }
}

namespace pg8 {
#define PG8_LAS __attribute__((address_space(3)))
typedef unsigned short bf16_t;
typedef short bf16x8 __attribute__((ext_vector_type(8)));
typedef float f32x4 __attribute__((ext_vector_type(4)));
typedef unsigned u32x4 __attribute__((ext_vector_type(4)));
constexpr int BM = 256, BK = 64, HALF = 128, HTB = HALF * BK * 2  , STAGE_BYTES = 8 * HTB, NXCD = 8, WGM = 8;

__host__ __device__ __forceinline__ int lds_byte(int r, int c) { const int st = (r >> 4) * 2 + (c >> 5), rr = r & 15, cc = c & 31, ob = rr * 64 + cc * 2; return st * 1024 + (ob ^ (((ob >> 9) & 1) << 5)); }
__host__ __device__ __forceinline__ void stage_rc(int b, int& R, int& C) { const int st = b / 1024, sb = b % 1024, swz = sb ^ (((sb >> 9) & 1) << 5); R = (st >> 1) * 16 + swz / 64; C = (st & 1) * 32 + (swz % 64) / 2; }
__host__ __device__ __forceinline__ int perm32(int rho) { const int n = rho >> 4, i = rho & 15; return 8 * (i >> 2) + 4 * n + (i & 3); }

struct Unit { int pm, pn; };
struct Gemm { const bf16_t* A; const bf16_t* Bt; int M, N, K; };

struct StaticOrder {
    int nM, nN, nwg, G, c;
    __host__ __device__ void init(int M, int N, int G_, int c_) { nM = M / BM; nN = N / BM; nwg = nM * nN; G = G_; c = c_; }
    __host__ __device__ bool next(int i, Unit& u) const {
        const long L = (long)i * G + c; if (L >= nwg) return false;
        int wgid = (int)L; { const int q = nwg / NXCD, r = nwg % NXCD, xcd = wgid % NXCD, off = wgid / NXCD; wgid = (xcd < r ? xcd * (q + 1) : r * (q + 1) + (xcd - r) * q) + off; }
        const int nig = WGM * nN, gid = wgid / nig, fm = gid * WGM, gsz = (nM - fm) < WGM ? (nM - fm) : WGM;
        u.pm = fm + ((wgid % nig) % gsz); u.pn = (wgid % nig) / gsz; return true;
    }
    __device__ __forceinline__ void a_ready(const Unit&) const {}
    __device__ __forceinline__ void done(const Unit&) const {}
};
__device__ __forceinline__ unsigned cvt_pk_bf16(float lo, float hi) { unsigned r; asm volatile("v_cvt_pk_bf16_f32 %0, %1, %2" : "=v"(r) : "v"(lo), "v"(hi)); return r; }
template <class Epi, class Sched, bool STAMP = false>
__device__ __forceinline__ void gemm_phase(PG8_LAS unsigned char* lds, const Gemm g, const Sched& S, const Epi& E, unsigned long long* stamps) {
    const int tid = otid(), wid = __builtin_amdgcn_readfirstlane(tid >> 6), lane = tid & 63, wr = wid >> 2, wc = wid & 3, fr = lane & 15, fq = lane >> 4;
    const int K = g.K, nt = K / BK;
    int ts_lo = 0, ts_hi = 0, nts = 0; const unsigned long long rt_entry = STAMP ? (unsigned long long)wall_clock64() : 0ull;
#define PG8_STAMP() do { if (STAMP && wid == 0 && nts < 64) { const unsigned long long _c = (unsigned long long)clock64(); \
        ts_lo = (lane == nts) ? (int)(unsigned)_c : ts_lo; ts_hi = (lane == nts) ? (int)(unsigned)(_c >> 32) : ts_hi; ++nts; } } while (0)
    PG8_STAMP();
    unsigned voffA[2], voffB[2];
#pragma unroll
    for (int i = 0; i < 2; ++i) { int R, C; stage_rc(tid * 16 + i * 8192, R, C); const int Rb = Epi::PERM ? ((R & ~31) + perm32(R & 31)) : R;
        voffA[i] = (unsigned)(R * K + C) * 2u; voffB[i] = (unsigned)(Rb * K + C) * 2u; }
    const size_t kstep = (size_t)(BK * 2);
    const size_t hstep = (size_t)HALF * K * 2;
    const size_t tstep = 2 * hstep;
    const unsigned ldsw = (unsigned)wid * 1024u;
    const int aoff = lds_byte(wr * 64 + fr, fq * 8), boff = lds_byte(wc * 32 + fr, fq * 8);
#define PG8_SA(b, h) (((b) * 2 + (h)) * HTB)
#define PG8_SB(b, h) ((4 + (b) * 2 + (h)) * HTB)
#define PG8_STAGE(bufoff, gbase, voff) do { _Pragma("unroll") for (int _i = 0; _i < 2; ++_i) \
        __builtin_amdgcn_global_load_lds((const unsigned*)((const char*)(gbase) + (voff)[_i]), (PG8_LAS unsigned*)(lds + (bufoff) + ldsw + _i * 8192), 16, 0, 0); } while (0)
#define PG8_LDA(dst, b, h) do { _Pragma("unroll") for (int m = 0; m < 4; ++m) _Pragma("unroll") for (int k = 0; k < 2; ++k) dst[m][k] = *(const PG8_LAS bf16x8*)(lds + PG8_SA(b, h) + aoff + m * 2048 + k * 1024); } while (0)
#define PG8_LDB(dst, b, h) do { _Pragma("unroll") for (int n = 0; n < 2; ++n) _Pragma("unroll") for (int k = 0; k < 2; ++k) dst[n][k] = *(const PG8_LAS bf16x8*)(lds + PG8_SB(b, h) + boff + n * 2048 + k * 1024); } while (0)
#define PG8_MMA(ai, bj, At, Bt) do { __builtin_amdgcn_s_setprio(1); _Pragma("unroll") for (int m = 0; m < 4; ++m) _Pragma("unroll") for (int n = 0; n < 2; ++n) _Pragma("unroll") for (int k = 0; k < 2; ++k) \
        acc[ai][bj][m][n] = __builtin_amdgcn_mfma_f32_16x16x32_bf16(Bt[n][k], At[m][k], acc[ai][bj][m][n], 0, 0, 0); __builtin_amdgcn_s_setprio(0); } while (0)
#define PG8_WAIT_V(n) asm volatile("s_waitcnt vmcnt(" #n ")" ::: "memory")
#define PG8_WAIT_L(n) asm volatile("s_waitcnt lgkmcnt(" #n ")" ::: "memory")
#define PG8_BAR __builtin_amdgcn_s_barrier()
#define PG8_SCHED __builtin_amdgcn_sched_barrier(0)
    Unit cur, nxt; int ui = 0;
    if (!S.next(0, cur)) return;
    f32x4 acc[2][2][4][2];
#pragma unroll
    for (int a = 0; a < 2; ++a)
#pragma unroll
        for (int b = 0; b < 2; ++b)
#pragma unroll
            for (int m = 0; m < 4; ++m)
#pragma unroll
                for (int n = 0; n < 2; ++n) acc[a][b][m][n] = (f32x4){0.f, 0.f, 0.f, 0.f};
    bf16x8 At[4][2], B0[2][2], B1[2][2];
    const char* cA = (const char*)g.A + (size_t)cur.pm * tstep; const char* cB = (const char*)g.Bt + (size_t)cur.pn * tstep;
    S.a_ready(cur);
    PG8_STAGE(PG8_SB(0, 0), cB, voffB); PG8_STAGE(PG8_SA(0, 0), cA, voffA); PG8_STAGE(PG8_SB(0, 1), cB + hstep, voffB); PG8_STAGE(PG8_SA(0, 1), cA + hstep, voffA);
    if (wr == 1) PG8_BAR;
    PG8_WAIT_V(4); PG8_BAR;
    PG8_STAGE(PG8_SB(1, 0), cB + kstep, voffB); PG8_STAGE(PG8_SA(1, 0), cA + kstep, voffA); PG8_STAGE(PG8_SB(1, 1), cB + hstep + kstep, voffB);
    PG8_WAIT_V(6); PG8_BAR;
    PG8_STAMP();
    for (;;) {
        const bool has_next = S.next(ui + 1, nxt);
        const char* nA = has_next ? (const char*)g.A + (size_t)nxt.pm * tstep : cA; const char* nB = has_next ? (const char*)g.Bt + (size_t)nxt.pn * tstep : cB;
        for (int t = 0; t < nt; t += 2) {
            const bool last = (t == nt - 2);
            const char* a1 = cA + (size_t)(t + 1) * kstep;
            const char* a2 = last ? nA : cA + (size_t)(t + 2) * kstep; const char* b2 = last ? nB : cB + (size_t)(t + 2) * kstep;
            const char* a3 = a2 + kstep; const char* b3 = b2 + kstep;
            if (last && has_next) S.a_ready(nxt);
            PG8_LDB(B0, 0, 0); PG8_SCHED; PG8_LDA(At, 0, 0); PG8_STAGE(PG8_SA(1, 1), a1 + hstep, voffA);
            PG8_WAIT_L(8); PG8_BAR; PG8_WAIT_L(0); PG8_MMA(0, 0, At, B0); PG8_BAR; PG8_SCHED;
            PG8_LDB(B1, 0, 1); PG8_STAGE(PG8_SB(0, 0), b2, voffB);
            PG8_BAR; PG8_WAIT_L(0); PG8_MMA(0, 1, At, B1); PG8_BAR;
            PG8_LDA(At, 0, 1); PG8_STAGE(PG8_SA(0, 0), a2, voffA);
            PG8_BAR; PG8_WAIT_L(0); PG8_MMA(1, 0, At, B0); PG8_BAR; PG8_SCHED;
            PG8_STAGE(PG8_SB(0, 1), b2 + hstep, voffB);
            PG8_WAIT_V(6); PG8_BAR; PG8_MMA(1, 1, At, B1); PG8_BAR;
            PG8_LDB(B0, 1, 0); PG8_SCHED; PG8_LDA(At, 1, 0); PG8_STAGE(PG8_SA(0, 1), a2 + hstep, voffA);
            PG8_WAIT_L(8); PG8_BAR; PG8_WAIT_L(0); PG8_MMA(0, 0, At, B0); PG8_BAR; PG8_SCHED;
            PG8_LDB(B1, 1, 1); PG8_STAGE(PG8_SB(1, 0), b3, voffB);
            PG8_BAR; PG8_WAIT_L(0); PG8_MMA(0, 1, At, B1); PG8_BAR;
            PG8_LDA(At, 1, 1); PG8_STAGE(PG8_SA(1, 0), a3, voffA);
            PG8_BAR; PG8_WAIT_L(0); PG8_MMA(1, 0, At, B0); PG8_BAR; PG8_SCHED;
            PG8_STAGE(PG8_SB(1, 1), b3 + hstep, voffB);
            PG8_WAIT_V(6); PG8_BAR; PG8_MMA(1, 1, At, B1); PG8_BAR;
        }
        PG8_STAMP();
        if constexpr (!Epi::AFTER_DRAIN) { E(acc, cur, wr, wc, fr, fq); S.done(cur); }
        PG8_STAMP();
        if (!has_next) break;
#pragma unroll
        for (int a = 0; a < 2; ++a)
#pragma unroll
            for (int b = 0; b < 2; ++b)
#pragma unroll
                for (int m = 0; m < 4; ++m)
#pragma unroll
                    for (int n = 0; n < 2; ++n) acc[a][b][m][n] = (f32x4){0.f, 0.f, 0.f, 0.f};
        cur = nxt; cA = nA; cB = nB; ++ui;
    }
    PG8_WAIT_V(0);
    if (wr == 0) PG8_BAR;
    PG8_BAR;
    if constexpr (Epi::AFTER_DRAIN) { E.fused(acc, cur, wr, wc, fr, fq, lds, wid, lane); S.done(cur); }
    PG8_STAMP();
    if (STAMP && wid == 0) { stamps[lane] = lane < nts ? (((unsigned long long)(unsigned)ts_hi << 32) | (unsigned)ts_lo) : 0ull;
        if (lane == 62) stamps[62] = rt_entry; if (lane == 63) stamps[63] = (unsigned long long)wall_clock64(); }
#undef PG8_STAMP
#undef PG8_SA
#undef PG8_SB
#undef PG8_STAGE
#undef PG8_LDA
#undef PG8_LDB
#undef PG8_MMA
#undef PG8_WAIT_V
#undef PG8_WAIT_L
#undef PG8_BAR
#undef PG8_SCHED
}
}

struct EpiOut {
  static constexpr bool PERM = false, AFTER_DRAIN = false;
  const float* in0; const float* in1; char* ws; int layer;
  __device__ __forceinline__ void operator()(const f32x4 (&acc)[2][2][4][2], const pg8::Unit& u, int wr, int wc, int fr, int fq) const {
    const int brow = u.pm * 256; const int row0 = brow + wr * 64 + fr, col0 = u.pn * 256 + wc * 32 + 4 * fq;
    float* X = (float*)(ws + WS_X);
    const int cv = brow < MCTX ? 0 : 1 + ((brow - MCTX) >> 10);
    const float* gate = (const float*)(ws + WS_MOD) + (layer * 3 + cv) * 3072 + 2048;
    const float* xin = layer == 0 ? (brow < MCTX ? in0 : in1 - (size_t)MCTX * 1024) : X;
    f32x4 gv[2][2];
#pragma unroll
    for (int bj = 0; bj < 2; ++bj)
#pragma unroll
      for (int n = 0; n < 2; ++n) gv[bj][n] = *(const f32x4*)(gate + col0 + bj * 128 + n * 16);
#pragma unroll
    for (int ai = 0; ai < 2; ++ai)
#pragma unroll
      for (int m = 0; m < 4; ++m) { const size_t ro = (size_t)(row0 + ai * 128 + m * 16) * 1024 + col0;
#pragma unroll
        for (int bj = 0; bj < 2; ++bj)
#pragma unroll
          for (int n = 0; n < 2; ++n) { const f32x4 xv = *(const f32x4*)(xin + ro + bj * 128 + n * 16);
            *(f32x4*)(X + ro + bj * 128 + n * 16) = xv + gv[bj][n] * acc[ai][bj][m][n]; } }
  }
};

struct EpiIn {
  static constexpr bool PERM = true, AFTER_DRAIN = false;
  const float* qg; const float* kg; float* out; char* ws; float* sSS; int layer;
  template <int KIND>
  __device__ __forceinline__ void half(const f32x4 (&acc)[2][2][4][2], const int bj, const int brow, const int pn, const bool lat, int wr, int wc, int fr, int fq) const {
    u16* U = (u16*)(ws + WS_U);
    const float* rope = (const float*)(ws + WS_ROPE);
    const int dh = (wc & 1) * 32 + 8 * fq;
    const int hd = wc >> 1;
    float gn[8];
    if (KIND <= 1) { const float* gp = (KIND == 0 ? qg : kg) + layer * 64 + dh;
      const f32x4 g0 = *(const f32x4*)gp, g1 = *(const f32x4*)(gp + 4);
      gn[0] = g0[0]; gn[1] = g0[1]; gn[2] = g0[2]; gn[3] = g0[3]; gn[4] = g1[0]; gn[5] = g1[1]; gn[6] = g1[2]; gn[7] = g1[3]; }
#pragma unroll
    for (int ai = 0; ai < 2; ++ai)
#pragma unroll
      for (int m = 0; m < 4; ++m) {
        const int rl = ai * 128 + wr * 64 + m * 16 + fr; const int row = brow + rl;
        const f32x4 v0 = acc[ai][bj][m][0], v1 = acc[ai][bj][m][1];
        float v[8] = {v0[0], v0[1], v0[2], v0[3], v1[0], v1[1], v1[2], v1[3]};
        if (KIND <= 1) {
          const float tot = sSS[(bj * 256 + rl) * 4 + wc] + sSS[(bj * 256 + rl) * 4 + (wc ^ 1)];
          const float rstd = rsqrtf(tot * (1.f / 64.f) + 1e-6f);
#pragma unroll
          for (int i = 0; i < 8; ++i) v[i] = v[i] * rstd * gn[i];
          if (KIND == 1 && !lat) { const int b = row >> 8, t = row & 255; float* op = out + (size_t)OUT_K + ((size_t)((b * 2 + layer) * 256 + t)) * 128 + hd * 64 + dh;
            *(f32x4*)op = (f32x4){v[0], v[1], v[2], v[3]}; *(f32x4*)(op + 4) = (f32x4){v[4], v[5], v[6], v[7]}; }
          if (lat) {
            const int t = (row - MCTX) & 1023; const int posv = (wc & 1) ? (t & 63) : (t >> 6);
            const float* rp = rope + (posv * 16 + 4 * fq) * 2;
            const f32x4 r0 = *(const f32x4*)rp, r1 = *(const f32x4*)(rp + 4);
            float x1, x2;
            x1 = v[0]; x2 = v[1]; v[0] = x1 * r0[0] - x2 * r0[1]; v[1] = x1 * r0[1] + x2 * r0[0];
            x1 = v[2]; x2 = v[3]; v[2] = x1 * r0[2] - x2 * r0[3]; v[3] = x1 * r0[3] + x2 * r0[2];
            x1 = v[4]; x2 = v[5]; v[4] = x1 * r1[0] - x2 * r1[1]; v[5] = x1 * r1[1] + x2 * r1[0];
            x1 = v[6]; x2 = v[7]; v[6] = x1 * r1[2] - x2 * r1[3]; v[7] = x1 * r1[3] + x2 * r1[2];
          }
          pg8::u32x4 w;
          if (KIND == 0) { w.x = pg8::cvt_pk_bf16(v[0] * 0.125f, v[1] * 0.125f); w.y = pg8::cvt_pk_bf16(v[2] * 0.125f, v[3] * 0.125f); w.z = pg8::cvt_pk_bf16(v[4] * 0.125f, v[5] * 0.125f); w.w = pg8::cvt_pk_bf16(v[6] * 0.125f, v[7] * 0.125f);
            *(pg8::u32x4*)(U + (size_t)row * DP + pn * 256 + bj * 128 + wc * 32 + 8 * fq) = w; }
          else { w.x = pg8::cvt_pk_bf16(v[0], v[1]); w.y = pg8::cvt_pk_bf16(v[2], v[3]); w.z = pg8::cvt_pk_bf16(v[4], v[5]); w.w = pg8::cvt_pk_bf16(v[6], v[7]);
            if (!lat) { const int b = row >> 8, t = row & 255; *(pg8::u32x4*)((u16*)(ws + WS_KC) + ((size_t)((b * 2 + hd) * 256 + t)) * 64 + dh) = w; }
            else { const int sb = (row - MCTX) >> 10, t = (row - MCTX) & 1023; *(pg8::u32x4*)((u16*)(ws + WS_KL) + ((size_t)(((layer * 2 + sb) * 2 + hd) * 1536 + 512 + t)) * 64 + dh) = w; } }
        } else {
          if (!lat) { const int b = row >> 8, t = row & 255; float* op = out + (size_t)OUT_V + ((size_t)((b * 2 + layer) * 256 + t)) * 128 + hd * 64 + dh;
            *(f32x4*)op = (f32x4){v[0], v[1], v[2], v[3]}; *(f32x4*)(op + 4) = (f32x4){v[4], v[5], v[6], v[7]};
            u16* vp = (u16*)(ws + WS_VC) + ((size_t)((b * 2 + hd) * 64 + dh)) * 256 + t;
#pragma unroll
            for (int i = 0; i < 8; ++i) vp[i * 256] = f2bf(v[i]); }
          else { const int sb = (row - MCTX) >> 10, t = (row - MCTX) & 1023;
            u16* vp = (u16*)(ws + WS_VL) + ((size_t)(((layer * 2 + sb) * 2 + hd) * 64 + dh)) * 1536 + 512 + t;
#pragma unroll
            for (int i = 0; i < 8; ++i) vp[i * 1536] = f2bf(v[i]); }
        }
      }
  }
  __device__ __forceinline__ void operator()(const f32x4 (&acc)[2][2][4][2], const pg8::Unit& u, int wr_, int wc_, int fr_, int fq_) const {
    int tid2; asm volatile("v_mov_b32 %0, %1" : "=v"(tid2) : "v"((int)threadIdx.x));
    const int wid = tid2 >> 6, lane = tid2 & 63, wr = wid >> 2, wc = wid & 3, fr = lane & 15, fq = lane >> 4;
    const int brow = u.pm * 256, pn = u.pn; const bool lat = brow >= MCTX;
    u16* U = (u16*)(ws + WS_U);
    if (pn >= 3) {
      const bool hy = pn >= 5 && pn < 13;
      u16* UH = (u16*)(ws + WS_UH);
      const int cg0 = (pn * 256 + wc * 32 + 8 * fq - 1280) >> 3;
      const int ucol = pn * 256 - (pn >= 13 ? 2048 : 0) + wc * 32 + 8 * fq;
#pragma unroll
      for (int ai = 0; ai < 2; ++ai)
#pragma unroll
        for (int m = 0; m < 4; ++m) { const int row = brow + ai * 128 + wr * 64 + m * 16 + fr;
#pragma unroll
          for (int bj = 0; bj < 2; ++bj) { const f32x4 v0 = acc[ai][bj][m][0], v1 = acc[ai][bj][m][1]; pg8::u32x4 w;
            w.x = pg8::cvt_pk_bf16(v0[0], v0[1]); w.y = pg8::cvt_pk_bf16(v0[2], v0[3]); w.z = pg8::cvt_pk_bf16(v1[0], v1[1]); w.w = pg8::cvt_pk_bf16(v1[2], v1[3]);
            u16* dst = hy ? UH + ((size_t)(cg0 + bj * 16) * MROWS + row) * 8 : U + (size_t)row * DP + ucol + bj * 128;
            *(pg8::u32x4*)dst = w; } }
      return;
    }
    const bool kvtile = pn == 2;
#pragma unroll
    for (int ai = 0; ai < 2; ++ai)
#pragma unroll
      for (int m = 0; m < 4; ++m)
#pragma unroll
        for (int bj = 0; bj < 2; ++bj) {
          const f32x4 v0 = acc[ai][bj][m][0], v1 = acc[ai][bj][m][1];
          float s = v0[0] * v0[0] + v0[1] * v0[1] + v0[2] * v0[2] + v0[3] * v0[3] + v1[0] * v1[0] + v1[1] * v1[1] + v1[2] * v1[2] + v1[3] * v1[3];
          s += __shfl_xor(s, 16); s += __shfl_xor(s, 32);
          if (fq == 0) sSS[(bj * 256 + ai * 128 + wr * 64 + m * 16 + fr) * 4 + wc] = s;
        }
    asm volatile("s_waitcnt lgkmcnt(0)" ::: "memory");
    __builtin_amdgcn_s_barrier();
    asm volatile("" ::: "memory");
    if (kvtile) { half<1>(acc, 0, brow, pn, lat, wr, wc, fr, fq); half<2>(acc, 1, brow, pn, lat, wr, wc, fr, fq); }
    else { half<0>(acc, 0, brow, pn, lat, wr, wc, fr, fq); half<0>(acc, 1, brow, pn, lat, wr, wc, fr, fq); }
  }
};

template <int EPI>
__device__ void gemm_phase(const P& p, const int layer, char* smem) {
  pg8::Gemm g;
  g.M = MROWS;
  if (EPI == 0) { g.A = (const u16*)(p.ws + WS_H); g.Bt = (const u16*)(p.ws + WS_WTIN) + (size_t)layer * 4352 * 1024; g.N = 4352; g.K = 1024; }
  else { g.A = (const u16*)(p.ws + WS_MIX); g.Bt = (const u16*)(p.ws + WS_WTOUT) + (size_t)layer * 1024 * 1536; g.N = 1024; g.K = 1536; }
  pg8::StaticOrder S; S.init(g.M, g.N, (int)gridDim.x, (int)blockIdx.x);
  if (EPI == 0) { EpiIn E{p.in[11], p.in[12], p.out, p.ws, (float*)(smem + 131072), layer};
    pg8::gemm_phase<EpiIn, pg8::StaticOrder, false>((PG8_LAS unsigned char*)smem, g, S, E, nullptr); }
  else { EpiOut E{p.in[0], p.in[1], p.ws, layer};
    pg8::gemm_phase<EpiOut, pg8::StaticOrder, false>((PG8_LAS unsigned char*)smem, g, S, E, nullptr); }
  __syncthreads();
}

__device__ __forceinline__ f32x4 mfma16(bf16x8 a, bf16x8 b, f32x4 c) { return __builtin_amdgcn_mfma_f32_16x16x32_bf16(a, b, c, 0, 0, 0); }

__device__ __forceinline__ void attn_softmax(f32x4 (&s)[4], f32x4 (&o)[4], float& mrun, float& lsum) {
  float mx = -1e30f;
#pragma unroll
  for (int mt = 0; mt < 4; ++mt)
#pragma unroll
    for (int r = 0; r < 4; ++r) mx = fmaxf(mx, s[mt][r]);
  mx = fmaxf(mx, __shfl_xor(mx, 16)); mx = fmaxf(mx, __shfl_xor(mx, 32));
  const float mnew = fmaxf(mrun, mx); const float alpha = __expf(mrun - mnew); mrun = mnew;
  float ps = 0.f;
#pragma unroll
  for (int mt = 0; mt < 4; ++mt)
#pragma unroll
    for (int r = 0; r < 4; ++r) { float pv = __expf(s[mt][r] - mnew); s[mt][r] = pv; ps += pv; }
  lsum = lsum * alpha + ps;
#pragma unroll
  for (int dt = 0; dt < 4; ++dt) { o[dt][0] *= alpha; o[dt][1] *= alpha; o[dt][2] *= alpha; o[dt][3] *= alpha; }
}
__device__ __forceinline__ void attn_sub2(const u16* sK, const u16* sV, const int kb, const int lr, const int g,
                                          const bf16x8 qa0, const bf16x8 qa1, const bf16x8 qb0, const bf16x8 qb1,
                                          f32x4 (&oa)[4], f32x4 (&ob)[4], float& ma, float& la, float& mb, float& lb) {
  f32x4 sa[4], sb[4];
#pragma unroll
  for (int mt = 0; mt < 4; ++mt) {
    const bf16x8 a0 = *(const bf16x8*)(sK + (kb + mt * 16 + lr) * 72 + g * 8), a1 = *(const bf16x8*)(sK + (kb + mt * 16 + lr) * 72 + 32 + g * 8);
    sa[mt] = mfma16(a0, qa0, (f32x4){0.f, 0.f, 0.f, 0.f}); sb[mt] = mfma16(a0, qb0, (f32x4){0.f, 0.f, 0.f, 0.f});
    sa[mt] = mfma16(a1, qa1, sa[mt]); sb[mt] = mfma16(a1, qb1, sb[mt]); }
  attn_softmax(sa, oa, ma, la);
  attn_softmax(sb, ob, mb, lb);
#pragma unroll
  for (int j = 0; j < 2; ++j) {
    const bf16x8 pfa = pk8(sa[2 * j][0], sa[2 * j][1], sa[2 * j][2], sa[2 * j][3], sa[2 * j + 1][0], sa[2 * j + 1][1], sa[2 * j + 1][2], sa[2 * j + 1][3]);
    const bf16x8 pfb = pk8(sb[2 * j][0], sb[2 * j][1], sb[2 * j][2], sb[2 * j][3], sb[2 * j + 1][0], sb[2 * j + 1][1], sb[2 * j + 1][2], sb[2 * j + 1][3]);
#pragma unroll
    for (int dt = 0; dt < 4; ++dt) {
      const u16* vp = sV + (dt * 16 + lr) * 272 + kb + j * 32 + g * 4;
      bf16x4 v0 = *(const bf16x4*)vp, v1 = *(const bf16x4*)(vp + 16);
      bf16x8 a; a[0] = v0[0]; a[1] = v0[1]; a[2] = v0[2]; a[3] = v0[3]; a[4] = v1[0]; a[5] = v1[1]; a[6] = v1[2]; a[7] = v1[3];
      oa[dt] = mfma16(a, pfa, oa[dt]); ob[dt] = mfma16(a, pfb, ob[dt]);
    }
  }
}
__device__ __forceinline__ void attn_sub(const u16* sK, const u16* sV, const int kb, const int lr, const int g, const bf16x8 q0, const bf16x8 q1, f32x4 (&o)[4], float& mrun, float& lsum) {
  f32x4 s[4];
#pragma unroll
  for (int mt = 0; mt < 4; ++mt) { s[mt] = (f32x4){0.f, 0.f, 0.f, 0.f};
    const bf16x8 a0 = *(const bf16x8*)(sK + (kb + mt * 16 + lr) * 72 + g * 8), a1 = *(const bf16x8*)(sK + (kb + mt * 16 + lr) * 72 + 32 + g * 8);
    s[mt] = mfma16(a0, q0, s[mt]); s[mt] = mfma16(a1, q1, s[mt]); }
  float mx = -1e30f;
#pragma unroll
  for (int mt = 0; mt < 4; ++mt)
#pragma unroll
    for (int r = 0; r < 4; ++r) mx = fmaxf(mx, s[mt][r]);
  mx = fmaxf(mx, __shfl_xor(mx, 16)); mx = fmaxf(mx, __shfl_xor(mx, 32));
  const float mnew = fmaxf(mrun, mx); const float alpha = __expf(mrun - mnew); mrun = mnew;
  float ps = 0.f;
#pragma unroll
  for (int mt = 0; mt < 4; ++mt)
#pragma unroll
    for (int r = 0; r < 4; ++r) { float pv = __expf(s[mt][r] - mnew); s[mt][r] = pv; ps += pv; }
  lsum = lsum * alpha + ps;
#pragma unroll
  for (int dt = 0; dt < 4; ++dt) { o[dt][0] *= alpha; o[dt][1] *= alpha; o[dt][2] *= alpha; o[dt][3] *= alpha; }
#pragma unroll
  for (int j = 0; j < 2; ++j) {
    const bf16x8 pf = pk8(s[2 * j][0], s[2 * j][1], s[2 * j][2], s[2 * j][3], s[2 * j + 1][0], s[2 * j + 1][1], s[2 * j + 1][2], s[2 * j + 1][3]);
#pragma unroll
    for (int dt = 0; dt < 4; ++dt) {
      const u16* vp = sV + (dt * 16 + lr) * 272 + kb + j * 32 + g * 4;
      bf16x4 v0 = *(const bf16x4*)vp, v1 = *(const bf16x4*)(vp + 16);
      bf16x8 a; a[0] = v0[0]; a[1] = v0[1]; a[2] = v0[2]; a[3] = v0[3]; a[4] = v1[0]; a[5] = v1[1]; a[6] = v1[2]; a[7] = v1[3];
      o[dt] = mfma16(a, pf, o[dt]);
    }
  }
}
__device__ __forceinline__ void attn_store(const P& p, const f32x4 (&o)[4], float lsum, const int qrow, const int h, const int g) {
  lsum += __shfl_xor(lsum, 16); lsum += __shfl_xor(lsum, 32);
  const float inv = 1.f / lsum;
  const u16* U = (const u16*)(p.ws + WS_U); u16* MIX = (u16*)(p.ws + WS_MIX);
#pragma unroll
  for (int dt = 0; dt < 4; ++dt) {
    const bf16x4 gv = *(const bf16x4*)(U + (size_t)qrow * DP + 768 + h * 64 + dt * 16 + g * 4);
    *(bf16x4*)(MIX + (size_t)qrow * DMIX + h * 64 + dt * 16 + g * 4) =
      pk4(o[dt][0] * inv * siluf(bfs(gv[0])), o[dt][1] * inv * siluf(bfs(gv[1])), o[dt][2] * inv * siluf(bfs(gv[2])), o[dt][3] * inv * siluf(bfs(gv[3])));
  }
}

__device__ void attn_item(const P& p, int layer, int lat, int sb, int h, int qt, char* smem) {
  const int tid = otid(), w = tid >> 6, lane = tid & 63, lr = lane & 15, g = lane >> 4;
  const int kvh = h >> 2;
  const int nkeys = 1536;
  const int m0 = MCTX + sb * 1024 + qt * 128;
  const u16* U = (const u16*)(p.ws + WS_U);
  const u16* Kb = (const u16*)(p.ws + WS_KL) + (size_t)((layer * 2 + sb) * 2 + kvh) * 1536 * 64;
  const u16* Vt = (const u16*)(p.ws + WS_VL) + (size_t)((layer * 2 + sb) * 2 + kvh) * 64 * 1536;
  u16* sK = (u16*)smem;
  u16* sV = sK + 256 * 72;
  const int qrow = m0 + w * 16 + lr;
  bf16x8 kr[4], vr[4];
#pragma unroll
  for (int i = 0; i < 4; ++i) { const int id = tid + i * 512; kr[i] = *(const bf16x8*)(Kb + (size_t)(id >> 3) * 64 + (id & 7) * 8); vr[i] = *(const bf16x8*)(Vt + (size_t)(id >> 5) * nkeys + (id & 31) * 8); }
  const bf16x8 q0 = *(const bf16x8*)(U + (size_t)qrow * DP + h * 64 + g * 8), q1 = *(const bf16x8*)(U + (size_t)qrow * DP + h * 64 + 32 + g * 8);
  f32x4 o[4];
#pragma unroll
  for (int i = 0; i < 4; ++i) o[i] = (f32x4){0.f, 0.f, 0.f, 0.f};
  float mrun = -1e30f, lsum = 0.f;
#pragma unroll 1
  for (int step = 0; step < 6; ++step) {
    __syncthreads();
#pragma unroll
    for (int i = 0; i < 4; ++i) { const int id = tid + i * 512; *(bf16x8*)(sK + (id >> 3) * 72 + (id & 7) * 8) = kr[i]; *(bf16x8*)(sV + (id >> 5) * 272 + (id & 31) * 8) = vr[i]; }
    if (step + 1 < 6) { const int k0 = (step + 1) * 256;
#pragma unroll
      for (int i = 0; i < 4; ++i) { const int id = tid + i * 512; kr[i] = *(const bf16x8*)(Kb + (size_t)(k0 + (id >> 3)) * 64 + (id & 7) * 8); vr[i] = *(const bf16x8*)(Vt + (size_t)(id >> 5) * nkeys + k0 + (id & 31) * 8); } }
    __syncthreads();
#pragma unroll
    for (int sub = 0; sub < 4; ++sub) attn_sub(sK, sV, sub * 64, lr, g, q0, q1, o, mrun, lsum);
  }
  attn_store(p, o, lsum, qrow, h, g);
  __syncthreads();
}

__device__ void attn_ctx_item(const P& p, int layer, int b, int kvh, int qt, char* smem) {
  const int tid = otid(), w = tid >> 6, lane = tid & 63, lr = lane & 15, g = lane >> 4;
  const int qg = w & 3, hp = w >> 2;
  const int m0 = b * 256 + qt * 64;
  const u16* U = (const u16*)(p.ws + WS_U);
  const u16* Kb = (const u16*)(p.ws + WS_KC) + (size_t)(b * 2 + kvh) * 256 * 64;
  const u16* Vt = (const u16*)(p.ws + WS_VC) + (size_t)(b * 2 + kvh) * 64 * 256;
  u16* sK = (u16*)smem;
  u16* sV = sK + 256 * 72;
  const int qrow = m0 + qg * 16 + lr;
  bf16x8 kr[4], vr[4];
#pragma unroll
  for (int i = 0; i < 4; ++i) { const int id = tid + i * 512; kr[i] = *(const bf16x8*)(Kb + (size_t)(id >> 3) * 64 + (id & 7) * 8); vr[i] = *(const bf16x8*)(Vt + (size_t)(id >> 5) * 256 + (id & 31) * 8); }
  const int h0 = kvh * 4 + hp * 2;
  const bf16x8 qa0 = *(const bf16x8*)(U + (size_t)qrow * DP + h0 * 64 + g * 8), qa1 = *(const bf16x8*)(U + (size_t)qrow * DP + h0 * 64 + 32 + g * 8);
  const bf16x8 qb0 = *(const bf16x8*)(U + (size_t)qrow * DP + (h0 + 1) * 64 + g * 8), qb1 = *(const bf16x8*)(U + (size_t)qrow * DP + (h0 + 1) * 64 + 32 + g * 8);
  __syncthreads();
#pragma unroll
  for (int i = 0; i < 4; ++i) { const int id = tid + i * 512; *(bf16x8*)(sK + (id >> 3) * 72 + (id & 7) * 8) = kr[i]; *(bf16x8*)(sV + (id >> 5) * 272 + (id & 31) * 8) = vr[i]; }
  __syncthreads();
  f32x4 oa[4], ob[4];
#pragma unroll
  for (int i = 0; i < 4; ++i) { oa[i] = (f32x4){0.f, 0.f, 0.f, 0.f}; ob[i] = (f32x4){0.f, 0.f, 0.f, 0.f}; }
  float ma = -1e30f, la = 0.f, mb = -1e30f, lb = 0.f;
#pragma unroll 2
  for (int sub = 0; sub < 4; ++sub) attn_sub2(sK, sV, sub * 64, lr, g, qa0, qa1, qb0, qb1, oa, ob, ma, la, mb, lb);
  attn_store(p, oa, la, qrow, h0, g);
  attn_store(p, ob, lb, qrow, h0 + 1, g);
  __syncthreads();
}

template <int L, int NSEQ, int CPI>
__device__ void hyena_item(const P& p, int layer, int m0, int c0, char* smem) {
  constexpr int SEL = (L == 1024) ? 1 : 0, NB = L / 16, KS = (NB + 16) / 2, PAD = 256, ZL = L + 2 * PAD, RO = L + 32, CL = 2 * L + 32, CLS = 2 * L + 48, RRL = 2 * L + 48;
  u16* zb = (u16*)smem;
  u16* cp = zb + 8 * NSEQ * ZL;
  u16* rr = cp + CPI * 8 * CLS;
  float* sInv = (float*)(rr + 8 * RRL);
  const int tid = otid(), w = tid >> 6, lane = tid & 63, lr = lane & 15, g = lane >> 4;
  const float* HF = (const float*)(p.ws + WS_HF) + (size_t)layer * HF_LSTRIDE + (SEL ? 256 * HFS : 0);
  const float* NP = (const float*)(p.ws + WS_NP) + (layer * 2 + SEL) * 32 * 1024;
  const u16* UH = (const u16*)(p.ws + WS_UH);
  u16* MIX = (u16*)(p.ws + WS_MIX);
  const float* sw = p.in[13] + layer * 3 * 1536; const float* sbias = p.in[14] + layer * 1536;
  const int sq = tid / (L / 4), t4 = tid % (L / 4);
  const size_t rowb = (size_t)(m0 + sq * L);
  bf16x8 lx1[6], lhv[6], lx0[6], lgv[4];
#pragma unroll
  for (int r6 = 0; r6 < 6; ++r6) { const int t = min(max(t4 * 4 + r6 - 1, 0), L - 1);
    lx1[r6] = *(const bf16x8*)(UH + ((size_t)((512 + c0) >> 3) * MROWS + rowb + t) * 8); lhv[r6] = *(const bf16x8*)(UH + ((size_t)((1024 + c0) >> 3) * MROWS + rowb + t) * 8); lx0[r6] = *(const bf16x8*)(UH + ((size_t)(c0 >> 3) * MROWS + rowb + t) * 8); }
#pragma unroll
  for (int tt = 0; tt < 4; ++tt) lgv[tt] = *(const bf16x8*)(UH + ((size_t)((1536 + c0) >> 3) * MROWS + rowb + t4 * 4 + tt) * 8);
  asm volatile("" ::: "memory");
  if (tid < 8) { float s = 0.f; for (int ch = 0; ch < L / 32; ++ch) s += NP[ch * 1024 + c0 + tid] + NP[ch * 1024 + 512 + c0 + tid]; sInv[tid] = 1.f / s; sInv[8 + tid] = p.in[22][layer * 512 + c0 + tid]; }
  for (int e = tid; e < 8 * NSEQ * 64; e += NT) { const int cs = e >> 6, q = e & 63; const int off = q < 32 ? q * 8 : PAD + L + (q - 32) * 8;
    *(bf16x8*)(zb + cs * ZL + off) = (bf16x8){0, 0, 0, 0, 0, 0, 0, 0}; }
  for (int y = tid; y < RRL; y += NT) { const int d = RO - y; float v[8];
    if (d > -L && d < L) { const float* src = HF + (size_t)(d >= 0 ? d : -d) * HFS + (d >= 0 ? 0 : 512) + c0; const float4 a = *(const float4*)src, b = *(const float4*)(src + 4);
      v[0] = a.x; v[1] = a.y; v[2] = a.z; v[3] = a.w; v[4] = b.x; v[5] = b.y; v[6] = b.z; v[7] = b.w; }
    else {
#pragma unroll
      for (int i = 0; i < 8; ++i) v[i] = 0.f; }
#pragma unroll
    for (int i = 0; i < 8; ++i) rr[i * RRL + y] = f2bf(v[i]); }
  { float wx[3][8], wv[3][8], bx8[8], bv8[8];
#pragma unroll
    for (int j = 0; j < 3; ++j) { const float4 a = *(const float4*)(sw + j * 1536 + 512 + c0), b = *(const float4*)(sw + j * 1536 + 512 + c0 + 4), c = *(const float4*)(sw + j * 1536 + 1024 + c0), d = *(const float4*)(sw + j * 1536 + 1024 + c0 + 4);
      wx[j][0] = a.x; wx[j][1] = a.y; wx[j][2] = a.z; wx[j][3] = a.w; wx[j][4] = b.x; wx[j][5] = b.y; wx[j][6] = b.z; wx[j][7] = b.w;
      wv[j][0] = c.x; wv[j][1] = c.y; wv[j][2] = c.z; wv[j][3] = c.w; wv[j][4] = d.x; wv[j][5] = d.y; wv[j][6] = d.z; wv[j][7] = d.w; }
    { const float4 a = *(const float4*)(sbias + 512 + c0), b = *(const float4*)(sbias + 512 + c0 + 4), c = *(const float4*)(sbias + 1024 + c0), d = *(const float4*)(sbias + 1024 + c0 + 4);
      bx8[0] = a.x; bx8[1] = a.y; bx8[2] = a.z; bx8[3] = a.w; bx8[4] = b.x; bx8[5] = b.y; bx8[6] = b.z; bx8[7] = b.w;
      bv8[0] = c.x; bv8[1] = c.y; bv8[2] = c.z; bv8[3] = c.w; bv8[4] = d.x; bv8[5] = d.y; bv8[6] = d.z; bv8[7] = d.w; }
    float ax[4][8], av[4][8];
#pragma unroll
    for (int tt = 0; tt < 4; ++tt)
#pragma unroll
      for (int i = 0; i < 8; ++i) { ax[tt][i] = bx8[i]; av[tt][i] = bv8[i]; }
#pragma unroll
    for (int rr6 = 0; rr6 < 6; ++rr6) { const int t = t4 * 4 + rr6 - 1;
      if (t >= 0 && t < L) { const bf16x8 x1 = lx1[rr6], hv = lhv[rr6];
#pragma unroll
        for (int tt = 0; tt < 4; ++tt) { const int j = rr6 - tt;
          if (j >= 0 && j < 3) {
#pragma unroll
            for (int i = 0; i < 8; ++i) { ax[tt][i] += bfs(x1[i]) * wx[j][i]; av[tt][i] += bfs(hv[i]) * wv[j][i]; } } } } }
#pragma unroll
    for (int i = 0; i < 8; ++i)
      *(bf16x4*)(zb + (i * NSEQ + sq) * ZL + PAD + t4 * 4) = pk4(ax[0][i] * av[0][i], ax[1][i] * av[1][i], ax[2][i] * av[2][i], ax[3][i] * av[3][i]); }
  float ex[4][8];
  { float w0[3][8], b08[8];
#pragma unroll
    for (int j = 0; j < 3; ++j) { const float4 a = *(const float4*)(sw + j * 1536 + c0), b = *(const float4*)(sw + j * 1536 + c0 + 4);
      w0[j][0] = a.x; w0[j][1] = a.y; w0[j][2] = a.z; w0[j][3] = a.w; w0[j][4] = b.x; w0[j][5] = b.y; w0[j][6] = b.z; w0[j][7] = b.w; }
    { const float4 a = *(const float4*)(sbias + c0), b = *(const float4*)(sbias + c0 + 4); b08[0] = a.x; b08[1] = a.y; b08[2] = a.z; b08[3] = a.w; b08[4] = b.x; b08[5] = b.y; b08[6] = b.z; b08[7] = b.w; }
#pragma unroll
    for (int tt = 0; tt < 4; ++tt)
#pragma unroll
      for (int i = 0; i < 8; ++i) ex[tt][i] = b08[i];
#pragma unroll
    for (int rr6 = 0; rr6 < 6; ++rr6) { const int t = t4 * 4 + rr6 - 1;
      if (t >= 0 && t < L) { const bf16x8 x0 = lx0[rr6];
#pragma unroll
        for (int tt = 0; tt < 4; ++tt) { const int j = rr6 - tt;
          if (j >= 0 && j < 3) {
#pragma unroll
            for (int i = 0; i < 8; ++i) ex[tt][i] += bfs(x0[i]) * w0[j][i]; } } } } }
  __syncthreads();
  const int seq = NSEQ == 2 ? (w >> 2) : w, nt = NSEQ == 2 ? (w & 3) : 0;
  const int Dlo = 16 * nt - NB + 1; const int sh = (-lr) & 7;
  const int a0 = sh * CLS + 8 * (g & 1) - lr - sh - 16 * (Dlo + (g >> 1)) + RO;
  const int b0 = PAD + 16 * (16 * nt + lr - Dlo - (g >> 1)) + 8 * (g & 1);
  f32x4 acc[CPI];
#pragma unroll
  for (int c = 0; c < CPI; ++c) acc[c] = (f32x4){0.f, 0.f, 0.f, 0.f};
  for (int itc = 0; itc <= 8 / CPI; ++itc) {
    if (itc < 8 / CPI) {
#pragma unroll
      for (int c = 0; c < CPI; ++c) { const u16* rc = rr + (itc * CPI + c) * RRL; u16* cpc = cp + c * 8 * CLS;
        for (int chunk = tid; chunk < CL; chunk += NT) { const int k = chunk / (CL / 8), q8 = chunk % (CL / 8); bf16x8 o;
#pragma unroll
          for (int i = 0; i < 8; ++i) o[i] = (short)rc[8 * q8 + k + i];
          *(bf16x8*)(cpc + k * CLS + 8 * q8) = o; } } }
    if (itc > 0) {
#pragma unroll
      for (int c = 0; c < CPI; ++c) { const int chp = (itc - 1) * CPI + (CPI == 2 ? (w >> 2) : c); const int sq_ = CPI == 2 ? 2 * (w & 3) + c : seq;
        u16* zp = zb + (chp * NSEQ + sq_) * ZL + PAD + 16 * (16 * nt + lr) + 4 * g; const float bs = sInv[8 + chp];
        const bf16x4 zv = *(const bf16x4*)zp;
        const float iv = sInv[chp];
        *(bf16x4*)zp = pk4(acc[c][0] * iv + bs * bfs(zv[0]), acc[c][1] * iv + bs * bfs(zv[1]), acc[c][2] * iv + bs * bfs(zv[2]), acc[c][3] * iv + bs * bfs(zv[3])); } }
    __syncthreads();
    if (itc == 8 / CPI) break;
    if (CPI == 1) {
      const u16* zc = zb + (itc * NSEQ + seq) * ZL;
      f32x4 accA = (f32x4){0.f, 0.f, 0.f, 0.f}, accB = (f32x4){0.f, 0.f, 0.f, 0.f};
#pragma unroll 4
      for (int ks = 0; ks < KS; ks += 2) { const bf16x8 a = *(const bf16x8*)(cp + a0 - 32 * ks), b = *(const bf16x8*)(zc + b0 - 32 * ks);
        const bf16x8 a2 = *(const bf16x8*)(cp + a0 - 32 * ks - 32), b2 = *(const bf16x8*)(zc + b0 - 32 * ks - 32);
        accA = mfma16(a, b, accA); accB = mfma16(a2, b2, accB); }
      acc[0] = accA + accB;
    } else {
      const int cw = w >> 2, sp2 = w & 3;
      const u16* zc0 = zb + ((itc * CPI + cw) * NSEQ + 2 * sp2) * ZL; const u16* zc1 = zc0 + ZL; const u16* cpw = cp + cw * 8 * CLS;
      f32x4 accA = (f32x4){0.f, 0.f, 0.f, 0.f}, accB = (f32x4){0.f, 0.f, 0.f, 0.f};
#pragma unroll 4
      for (int ks = 0; ks < KS; ++ks) { const bf16x8 a = *(const bf16x8*)(cpw + a0 - 32 * ks), b = *(const bf16x8*)(zc0 + b0 - 32 * ks), b2 = *(const bf16x8*)(zc1 + b0 - 32 * ks);
        accA = mfma16(a, b, accA); accB = mfma16(a, b2, accB); }
      acc[0] = accA; acc[CPI - 1] = accB;
    }
    __syncthreads();
  }
  { bf16x4 yz[8];
#pragma unroll
    for (int i = 0; i < 8; ++i) yz[i] = *(const bf16x4*)(zb + (i * NSEQ + sq) * ZL + PAD + t4 * 4);
#pragma unroll
    for (int tt = 0; tt < 4; ++tt) { const bf16x8 gv = lgv[tt]; float of[8];
#pragma unroll
      for (int i = 0; i < 8; ++i) of[i] = ex[tt][i] * bfs(yz[i][tt]) * siluf(bfs(gv[i]));
      *(bf16x8*)(MIX + (rowb + t4 * 4 + tt) * DMIX + 512 + c0) = pk8(of[0], of[1], of[2], of[3], of[4], of[5], of[6], of[7]); } }
  __syncthreads();
}

template <int NTL>
__device__ void lru_item(const P& p, int layer, int lat, int sb, int n, int qd, char* smem) {
  const int L = lat ? 1024 : 256; const int m0 = lat ? MCTX + sb * 1024 : sb * 256;
  const int tid = otid(), w = tid >> 6, lane = tid & 63, lr = lane & 15, g = lane >> 4;
  u16* sW = (u16*)smem;
  float* sCw = (float*)(smem + 18432);
  constexpr bool XC = (NTL == 4);
  float* sX = (float*)(smem + 18432 + 1280);
  u16* sXc = (u16*)(smem + 18432 + 1280);
  float* sTot = (float*)(smem + 18432 + 1280 + (XC ? 36864 : 33280));
  float* sCar = sTot + 2048;
  float* sYf = sCar + 128;
  constexpr int YS = NTL * 16 + 1;
  const u16* U = (const u16*)(p.ws + WS_U);
  u16* MIX = (u16*)(p.ws + WS_MIX);
  const u16* WGT = (const u16*)(p.ws + WS_WGT);
  const int chb = n * 64; const int cq = qd * 16;
  if (tid < 320) sCw[tid] = tid < 256 ? p.in[23][layer * 4 * 512 + (tid >> 6) * 512 + chb + (tid & 63)] : p.in[24][layer * 512 + chb + tid - 256];
  const int nch = L >> 7;
#pragma unroll 1
  for (int dir = 0; dir < 2; ++dir) {
    __syncthreads();
    for (int e = tid; e < 1024; e += NT) { const int gate = e >> 9, d = (e >> 3) & 63, part = e & 7;
      *(bf16x8*)(sW + (gate * 64 + d) * 72 + part * 8) = *(const bf16x8*)(WGT + ((size_t)((((layer * 2 + dir) * 2 + gate) * 8 + n) * 64 + d)) * 64 + part * 8); }
    if (tid < 16 * NTL) sCar[tid] = lat ? p.in[4][((sb * 2 + layer) * 2 + dir) * 512 + chb + cq + tid] : 0.f;
    float ba[NTL], bx[NTL], sp[NTL];
#pragma unroll
    for (int nt = 0; nt < NTL; ++nt) { const int dch = (layer * 2 + dir) * 512 + chb + cq + nt * 16 + lr; ba[nt] = p.in[26][dch]; bx[nt] = p.in[28][dch]; sp[nt] = -8.f * log1pf(expf(-p.in[29][dch])); }
    __syncthreads();
    bf16x8 xin[2][4];
    if (!(XC && dir == 1)) { const int pA = w * 16 + lr; const int tA = dir ? L - 1 - pA : pA;
#pragma unroll
      for (int ks = 0; ks < 2; ++ks)
#pragma unroll
        for (int j = 0; j < 4; ++j) { const int tt = min(max(tA + j - 1, 0), L - 1); xin[ks][j] = *(const bf16x8*)(U + (size_t)(m0 + tt) * DP + 1280 + chb + ks * 32 + g * 8); } }
#pragma unroll 1
    for (int ci = 0; ci < nch; ++ci) {
      const int par = ci & 1; const int pbase = ci * 128 + w * 16;
      const int pA = pbase + lr; const int tA = dir ? L - 1 - pA : pA;
      bf16x8 af[2];
      if (XC && dir == 1) {
#pragma unroll
        for (int ks = 0; ks < 2; ++ks) af[ks] = *(const bf16x8*)(sXc + tA * 72 + ks * 32 + g * 8);
      } else
#pragma unroll
      for (int ks = 0; ks < 2; ++ks) {
        const int cb = ks * 32 + g * 8; float a8[8];
#pragma unroll
        for (int i = 0; i < 8; ++i) a8[i] = sCw[256 + cb + i];
#pragma unroll
        for (int j = 0; j < 4; ++j) { const int tt = tA + j - 1; const float msk = (tt >= 0 && tt < L) ? 1.f : 0.f;
#pragma unroll
          for (int i = 0; i < 8; ++i) a8[i] += msk * bfs(xin[ks][j][i]) * sCw[j * 64 + cb + i]; }
        af[ks] = pk8(a8[0], a8[1], a8[2], a8[3], a8[4], a8[5], a8[6], a8[7]);
        if (XC) *(bf16x8*)(sXc + tA * 72 + cb) = af[ks];
        else {
#pragma unroll
          for (int i = 0; i < 8; ++i) sX[(w * 16 + lr) * 65 + cb + i] = a8[i]; }
      }
      if (ci + 1 < nch && !(XC && dir == 1)) { const int pN = pA + 128; const int tN = dir ? L - 1 - pN : pN;
#pragma unroll
        for (int ks = 0; ks < 2; ++ks)
#pragma unroll
          for (int j = 0; j < 4; ++j) { const int tt = min(max(tN + j - 1, 0), L - 1); xin[ks][j] = *(const bf16x8*)(U + (size_t)(m0 + tt) * DP + 1280 + chb + ks * 32 + g * 8); } }
      float Ap[NTL][4], Bp[NTL][4];
#pragma unroll
      for (int nt = 0; nt < NTL; ++nt) {
        f32x4 pr = (f32x4){0.f, 0.f, 0.f, 0.f}, pi = (f32x4){0.f, 0.f, 0.f, 0.f};
#pragma unroll
        for (int ks = 0; ks < 2; ++ks) { const bf16x8 wr_ = *(const bf16x8*)(sW + (cq + nt * 16 + lr) * 72 + ks * 32 + g * 8), wi_ = *(const bf16x8*)(sW + (64 + cq + nt * 16 + lr) * 72 + ks * 32 + g * 8);
          pr = mfma16(af[ks], wr_, pr); pi = mfma16(af[ks], wi_, pi); }
#pragma unroll
        for (int r = 0; r < 4; ++r) {
          float x;
          if (XC) { const int pq = pbase + 4 * g + r; const int tq = dir ? L - 1 - pq : pq; x = bf2f(sXc[tq * 72 + cq + nt * 16 + lr]); }
          else x = sX[(w * 16 + 4 * g + r) * 65 + cq + nt * 16 + lr];
          const float rr_ = sigm(pr[r] + ba[nt]), ii = sigm(pi[r] + bx[nt]);
          const float la = rr_ * sp[nt]; const float a = fexp(la); const float om = 1.f - a * a; const float b = __builtin_amdgcn_sqrtf(fmaxf(om, 0.f)) * ii * x;
          if (r == 0) { Ap[nt][0] = a; Bp[nt][0] = b; } else { Ap[nt][r] = a * Ap[nt][r - 1]; Bp[nt][r] = a * Bp[nt][r - 1] + b; }
        }
      }
      float EA[NTL], EB[NTL], TA[NTL], TB[NTL];
#pragma unroll
      for (int nt = 0; nt < NTL; ++nt) { EA[nt] = 1.f; EB[nt] = 0.f; TA[nt] = 1.f; TB[nt] = 0.f;
#pragma unroll
        for (int k = 0; k < 4; ++k) { const float ak = __int_as_float(__builtin_amdgcn_ds_bpermute((lr + 16 * k) * 4, __float_as_int(Ap[nt][3]))), bk = __int_as_float(__builtin_amdgcn_ds_bpermute((lr + 16 * k) * 4, __float_as_int(Bp[nt][3])));
          if (k < g) { EB[nt] = ak * EB[nt] + bk; EA[nt] = ak * EA[nt]; }
          TB[nt] = ak * TB[nt] + bk; TA[nt] = ak * TA[nt]; }
        if (g == 0) { sTot[((par * 8 + w) * 2 + 0) * 64 + nt * 16 + lr] = TA[nt]; sTot[((par * 8 + w) * 2 + 1) * 64 + nt * 16 + lr] = TB[nt]; } }
      float yv[NTL][4]; u16 gl[NTL][4];
      if (dir == 1) {
#pragma unroll
        for (int nt = 0; nt < NTL; ++nt)
#pragma unroll
          for (int r = 0; r < 4; ++r) { const int pp = pbase + 4 * g + r; const int t = L - 1 - pp;
            yv[nt][r] = sYf[t * YS + nt * 16 + lr]; gl[nt][r] = U[(size_t)(m0 + t) * DP + 1792 + chb + cq + nt * 16 + lr]; } }
      __syncthreads();
#pragma unroll
      for (int nt = 0; nt < NTL; ++nt) {
        float hin = sCar[par * 64 + nt * 16 + lr];
        float ak7[7], bk7[7];
#pragma unroll
        for (int k = 0; k < 7; ++k) { ak7[k] = sTot[((par * 8 + k) * 2 + 0) * 64 + nt * 16 + lr]; bk7[k] = sTot[((par * 8 + k) * 2 + 1) * 64 + nt * 16 + lr]; }
#pragma unroll
        for (int k = 0; k < 7; ++k) { const float tnew = ak7[k] * hin + bk7[k]; hin = (k < w) ? tnew : hin; }
        if (w == 7 && g == 0) sCar[(par ^ 1) * 64 + nt * 16 + lr] = TA[nt] * hin + TB[nt];
        const float hg = EA[nt] * hin + EB[nt];
        const int dch = chb + cq + nt * 16 + lr;
#pragma unroll
        for (int r = 0; r < 4; ++r) {
          const float hv = Ap[nt][r] * hg + Bp[nt][r];
          const int pp = pbase + 4 * g + r; const int t = dir ? L - 1 - pp : pp;
          if (dir == 0) sYf[t * YS + nt * 16 + lr] = hv;
          else MIX[(size_t)(m0 + t) * DMIX + 1024 + dch] = f2bf((yv[nt][r] + hv) * siluf(bf2f(gl[nt][r])));
          if (!lat && pp == L - 1) p.out[(size_t)OUT_LRU + ((sb * 2 + layer) * 2 + dir) * 512 + dch] = hv;
        }
      }
    }
  }
  __syncthreads();
}

__device__ void mixers_phase(const P& p, int layer, char* smem, int rep = 0) {
  __shared__ int s_item;
  int* cnt = (int*)(p.ws + WS_CNT) + layer + 2 * rep;
  if (otid() == 0) s_item = atomicAdd(cnt, 1);
  __syncthreads();
  int it = s_item;
  __syncthreads();
  while (it < 1024) {
    int nxt = 0;
    if (otid() == 0) nxt = atomicAdd(cnt, 1);
    if (it < 64) { for (int r = 0; r < REP_LRU; ++r) lru_item<1>(p, layer, 1, it >> 5, (it >> 2) & 7, it & 3, smem); }
    else if (it < 128) { const int i = it - 64; for (int r = 0; r < REP_HY; ++r) hyena_item<1024, 2, 1>(p, layer, MCTX, i * 8, smem); }
    else if (it < 256) { const int i = it - 128; for (int r = 0; r < REP_AT; ++r) attn_item(p, layer, 1, i >> 6, (i >> 3) & 7, i & 7, smem); }
    else if (it < 512) { const int i = it - 256; for (int r = 0; r < REP_HY; ++r) hyena_item<256, 8, 2>(p, layer, (i >> 6) * 2048, (i & 63) * 8, smem); }
    else if (it < 768) { const int i = it - 512; for (int r = 0; r < REP_LRU; ++r) lru_item<4>(p, layer, 0, i >> 3, i & 7, 0, smem); }
    else { const int i = it - 768; for (int r = 0; r < REP_AT; ++r) attn_ctx_item(p, layer, i >> 3, (i >> 2) & 1, i & 3, smem); }
    if (otid() == 0) s_item = nxt;
    __syncthreads();
    it = s_item;
    __syncthreads();
  }
}

#define XB_TMO      128
#define XB_XCNT(j)  (256  + 64 * (j))
#define XB_XSUB(j)  (1280 + 64 * (j))
#define XB_XGEN(j)  (2304 + 64 * (j))
#define XB_TOP      3328
#define XB_TOPGEN   3392
#define XCD_BAR_WORDS 3456
#define XB_SPIN_CAP (1u << 18)
#define LAS __attribute__((address_space(3)))

__device__ __forceinline__ unsigned xb_ld(unsigned* p)              { return __hip_atomic_load(p, __ATOMIC_RELAXED, __HIP_MEMORY_SCOPE_AGENT); }
__device__ __forceinline__ unsigned xb_add(unsigned* p, unsigned v) { return __hip_atomic_fetch_add(p, v, __ATOMIC_RELAXED, __HIP_MEMORY_SCOPE_AGENT); }
__device__ __forceinline__ unsigned xb_xcc_id() { return (unsigned)__builtin_amdgcn_s_getreg((3 << 11) | 20) & 0xFu; }
#define XB_SPIN(cond, bar) do { unsigned _sp = 0; while (cond) { \
    if ((++_sp & 255u) == 0u) { if (xb_ld(&(bar)[XB_TMO])) break; if (_sp > XB_SPIN_CAP) { atomicAdd(&(bar)[XB_TMO], 1u); break; } } } } while (0)

struct XcdBarrier {
    unsigned* bar; unsigned x;
    volatile LAS unsigned* st;
};

__device__ __forceinline__ XcdBarrier xcd_barrier_post(unsigned* bar, volatile LAS unsigned* st) {
    XcdBarrier b; b.bar = bar; b.x = xb_xcc_id(); b.st = st;
    if (threadIdx.x == 0) (void)xb_add(&bar[XB_XCNT(b.x)], 1u);
    return b;
}
__device__ __forceinline__ void xcd_barrier_complete(unsigned* bar, unsigned x, unsigned& nloc, unsigned& nx) {
    const unsigned G = gridDim.x * gridDim.y * gridDim.z;
    unsigned sum, cnt, mine, sp = 0u;
    for (;;) {
        sum = 0u; cnt = 0u; mine = 0u;
#pragma unroll
        for (unsigned j = 0; j < 16; ++j) { const unsigned c = xb_ld(&bar[XB_XCNT(j)]); sum += c; cnt += (c > 0u) ? 1u : 0u; mine = (j == x) ? c : mine; }
        if (sum == G) break;
        __builtin_amdgcn_s_sleep(1);
        if ((++sp & 255u) == 0u) { if (xb_ld(&bar[XB_TMO])) break; if (sp > XB_SPIN_CAP) { atomicAdd(&bar[XB_TMO], 1u); break; } }
    }
    nloc = mine > 0u ? mine : 1u; nx = cnt > 0u ? cnt : 1u;
}

__device__ __forceinline__ void xcd_barrier(const XcdBarrier& b) {
    asm volatile("s_waitcnt vmcnt(0)" ::: "memory");
    __syncthreads();
    if (threadIdx.x == 0) {
        unsigned* bar = b.bar;
        __builtin_amdgcn_s_waitcnt(0);
        unsigned nloc = b.st[0], nx = b.st[1];
        if (nloc == 0u) { xcd_barrier_complete(bar, b.x, nloc, nx); b.st[0] = nloc; b.st[1] = nx; }
        const unsigned old = xb_add(&bar[XB_XSUB(b.x)], 1u);
        const unsigned gen = old / nloc;
        if (old + 1u == (gen + 1u) * nloc) {
            __builtin_amdgcn_fence(__ATOMIC_RELEASE, "agent");
            asm volatile("s_waitcnt vmcnt(0)" ::: "memory");
            const unsigned og = xb_add(&bar[XB_TOP], 1u);
            const unsigned tg = og / nx;
            if (og + 1u == (tg + 1u) * nx) xb_add(&bar[XB_TOPGEN], 1u);
            else XB_SPIN(xb_ld(&bar[XB_TOPGEN]) == tg, bar);
            __builtin_amdgcn_fence(__ATOMIC_ACQUIRE, "agent");
            xb_add(&bar[XB_XGEN(b.x)], 1u);
            asm volatile("s_waitcnt vmcnt(0)" ::: "memory");
        } else {
            XB_SPIN(xb_ld(&bar[XB_XGEN(b.x)]) == gen, bar);
            __builtin_amdgcn_fence(__ATOMIC_ACQUIRE, "agent");
            asm volatile("s_waitcnt vmcnt(0)" ::: "memory");
        }
    }
    __syncthreads();
}


#ifndef MULTI
#define MULTI 0
#endif
#ifndef REP_NORM
#define REP_NORM 1
#endif
#ifndef REP_G0
#define REP_G0 1
#endif
#ifndef REP_MIX
#define REP_MIX 1
#endif
#ifndef REP_P0
#define REP_P0 1
#endif
#if MULTI
#ifndef XK
#define XK -1
#endif
#ifndef XN
#define XN 0
#endif
__global__ void __launch_bounds__(NT) k_phase0(P p) { extern __shared__ __attribute__((aligned(16))) char smem[]; phase0(p, smem); }
__global__ void __launch_bounds__(NT) k_prep1(P p) { extern __shared__ __attribute__((aligned(16))) char smem[]; phase0_items<1, 2>(p, smem); }
__global__ void __launch_bounds__(NT) k_norm(P p, int layer) { norm_phase(p, layer); }
__global__ void __launch_bounds__(NT) k_gemm0(P p, int layer) { extern __shared__ __attribute__((aligned(16))) char smem[]; gemm_phase<0>(p, layer, smem); }
__global__ void __launch_bounds__(NT) k_gemm1(P p, int layer) { extern __shared__ __attribute__((aligned(16))) char smem[]; gemm_phase<1>(p, layer, smem); }
__global__ void __launch_bounds__(NT) k_hy_lat(P p, int layer) { extern __shared__ __attribute__((aligned(16))) char smem[];
  for (int it = blockIdx.x; it < 64; it += gridDim.x) hyena_item<1024, 2, 1>(p, layer, MCTX, it * 8, smem); }
__global__ void __launch_bounds__(NT) k_hy_ctx(P p, int layer) { extern __shared__ __attribute__((aligned(16))) char smem[];
  for (int i = blockIdx.x; i < 256; i += gridDim.x) hyena_item<256, 8, 2>(p, layer, (i >> 6) * 2048, (i & 63) * 8, smem); }
__global__ void __launch_bounds__(NT) k_attn_lat(P p, int layer) { extern __shared__ __attribute__((aligned(16))) char smem[];
  for (int it = blockIdx.x; it < 128; it += gridDim.x) attn_item(p, layer, 1, it >> 6, (it >> 3) & 7, it & 7, smem); }
__global__ void __launch_bounds__(NT) k_attn_ctx(P p, int layer) { extern __shared__ __attribute__((aligned(16))) char smem[];
  for (int i = blockIdx.x; i < 256; i += gridDim.x) attn_ctx_item(p, layer, i >> 3, (i >> 2) & 1, i & 3, smem); }
__global__ void __launch_bounds__(NT) k_lru_lat(P p, int layer) { extern __shared__ __attribute__((aligned(16))) char smem[];
  for (int it = blockIdx.x; it < 64; it += gridDim.x) lru_item<1>(p, layer, 1, it >> 5, (it >> 2) & 7, it & 3, smem); }
__global__ void __launch_bounds__(NT) k_lru_ctx(P p, int layer) { extern __shared__ __attribute__((aligned(16))) char smem[];
  for (int i = blockIdx.x; i < 256; i += gridDim.x) lru_item<4>(p, layer, 0, i >> 3, i & 7, 0, smem); }
#else
__global__ void __launch_bounds__(NT) mega(P p) {
  extern __shared__ __attribute__((aligned(16))) char smem[];
  __shared__ uint4 xb_words;
  cg::grid_group grid = cg::this_grid();
  if (threadIdx.x == 0) xb_words = make_uint4(0u, 0u, 0u, 0u);
  __syncthreads();
  (void)xcd_barrier_post((unsigned*)(p.ws + WS_BAR), (volatile LAS unsigned*)&xb_words);
#define GRID_BAR() do { XcdBarrier xb_; xb_.bar = (unsigned*)(p.ws + WS_BAR); xb_.x = xb_xcc_id(); xb_.st = (volatile LAS unsigned*)&xb_words; xcd_barrier(xb_); } while (0)
  phase0(p, smem);
  if (p.ws == nullptr) grid.sync();
  GRID_BAR();
#pragma unroll 1
  for (int layer_ = 0; layer_ < 2; ++layer_) {
    const int layer = osgpr(layer_);
#pragma unroll 1
    for (int rep = 0; rep < REP_NORM; ++rep) { norm_phase(p, osgpr(layer)); GRID_BAR(); }
    gemm_phase<0>(p, osgpr(layer), smem);
    if (layer == 0 && ((int)gridDim.x <= 168 || (int)blockIdx.x >= 168)) phase0_items<0, 1>(p, smem);
    GRID_BAR();
#pragma unroll 1
    for (int rep = 0; rep < REP_MIX; ++rep) { mixers_phase(p, osgpr(layer), smem, osgpr(rep)); GRID_BAR(); }
    gemm_phase<1>(p, osgpr(layer), smem);
    if (layer == 0 && ((int)gridDim.x <= 160 || (int)blockIdx.x >= 160)) phase0_items<1, 2>(p, smem);
    GRID_BAR();
  }
  norm_phase(p, 2);
}
#endif

extern "C" void kernel_launch(void* const* d_in, const int* in_sizes, int n_in, void* d_out, int out_size, void* d_ws, size_t ws_size, hipStream_t stream) {
  static int grid = 0;
  if (grid == 0) {
    if (n_in != 32 || ws_size < WS_END) { fprintf(stderr, "kernel_launch: unexpected n_in %d / ws %zu (need %zu)\n", n_in, ws_size, (size_t)WS_END); grid = -1; return; }
    int dev = 0, cus = 0, per_cu = 0;
    (void)hipGetDevice(&dev);
    (void)hipDeviceGetAttribute(&cus, hipDeviceAttributeMultiprocessorCount, dev);
#if MULTI
    const void* ks[] = {(const void*)k_phase0, (const void*)k_prep1, (const void*)k_gemm0, (const void*)k_gemm1, (const void*)k_hy_lat, (const void*)k_hy_ctx, (const void*)k_attn_lat, (const void*)k_attn_ctx, (const void*)k_lru_lat, (const void*)k_lru_ctx};
    for (int i = 0; i < 10; ++i) if (hipFuncSetAttribute(ks[i], hipFuncAttributeMaxDynamicSharedMemorySize, LDS_BYTES) != hipSuccess) { fprintf(stderr, "hipFuncSetAttribute failed\n"); grid = -1; return; }
    (void)per_cu;
#else
    if (hipFuncSetAttribute((const void*)mega, hipFuncAttributeMaxDynamicSharedMemorySize, LDS_BYTES) != hipSuccess) { fprintf(stderr, "hipFuncSetAttribute failed\n"); grid = -1; return; }
    if (hipOccupancyMaxActiveBlocksPerMultiprocessor(&per_cu, (const void*)mega, NT, LDS_BYTES) != hipSuccess || per_cu < 1) { fprintf(stderr, "occupancy query failed (%d)\n", per_cu); grid = -1; return; }
#endif
    grid = cus;
  }
  if (grid < 0) return;
  (void)hipMemsetAsync((char*)d_ws + WS_CNT, 0, 256 + 13824, stream);
  P prm{};
  for (int i = 0; i < 32; ++i) prm.in[i] = (const float*)d_in[i];
  prm.out = (float*)d_out; prm.ws = (char*)d_ws;
#if MULTI
  k_phase0<<<grid, NT, LDS_BYTES, stream>>>(prm);
  k_prep1<<<grid, NT, LDS_BYTES, stream>>>(prm);
  for (int layer = 0; layer < 2; ++layer) {
    for (int x = 0; x < 1 + (XK == 0 ? XN : 0); ++x) k_norm<<<grid, NT, 0, stream>>>(prm, layer);
    for (int x = 0; x < 1 + (XK == 1 ? XN : 0); ++x) k_gemm0<<<grid, NT, LDS_BYTES, stream>>>(prm, layer);
    for (int x = 0; x < 1 + (XK == 2 ? XN : 0); ++x) k_hy_lat<<<64, NT, LDS_BYTES, stream>>>(prm, layer);
    for (int x = 0; x < 1 + (XK == 3 ? XN : 0); ++x) k_hy_ctx<<<grid, NT, LDS_BYTES, stream>>>(prm, layer);
    for (int x = 0; x < 1 + (XK == 4 ? XN : 0); ++x) k_attn_lat<<<grid, NT, LDS_BYTES, stream>>>(prm, layer);
    for (int x = 0; x < 1 + (XK == 5 ? XN : 0); ++x) k_attn_ctx<<<grid, NT, LDS_BYTES, stream>>>(prm, layer);
    for (int x = 0; x < 1 + (XK == 6 ? XN : 0); ++x) k_lru_lat<<<64, NT, LDS_BYTES, stream>>>(prm, layer);
    for (int x = 0; x < 1 + (XK == 7 ? XN : 0); ++x) k_lru_ctx<<<grid, NT, LDS_BYTES, stream>>>(prm, layer);
    k_gemm1<<<grid, NT, LDS_BYTES, stream>>>(prm, layer);
  }
  k_norm<<<grid, NT, 0, stream>>>(prm, 2);
#else
  void* args[] = {&prm};
  hipError_t e = hipLaunchCooperativeKernel((const void*)mega, dim3(grid), dim3(NT), args, LDS_BYTES, stream);
  if (e != hipSuccess) fprintf(stderr, "cooperative launch failed: %s (grid %d)\n", hipGetErrorString(e), grid);
#endif
}
```

```cpp
#include <hip/hip_runtime.h>
#include <hip/hip_bf16.h>
#include <hip/hip_cooperative_groups.h>
#include <cstdio>
namespace cg = cooperative_groups;

#ifndef REP_HY
#define REP_HY 1
#endif
#ifndef REP_AT
#define REP_AT 1
#endif
#ifndef REP_LRU
#define REP_LRU 1
#endif
typedef unsigned short u16;
using bf16x8 = __attribute__((ext_vector_type(8))) short;
using bf16x4 = __attribute__((ext_vector_type(4))) short;
using f32x4 = __attribute__((ext_vector_type(4))) float;

#define NT 512
constexpr int MROWS = 10240, MCTX = 8192, DM = 1024, DP = 2336  , DMIX = 1536;
constexpr int LDS_BYTES = 131072 + 8192;
constexpr int OUT_YS = 8388608, OUT_K = 10485760, OUT_V = 12582912, OUT_LRU = 14680064;

constexpr size_t WS_WTIN = 0;
constexpr size_t WS_WTOUT = WS_WTIN + (size_t)2 * 4352 * 1024 * 2;
constexpr size_t WS_WGT = WS_WTOUT + (size_t)2 * 1024 * 1536 * 2;
constexpr size_t WS_MOD = WS_WGT + (size_t)2 * 2 * 2 * 8 * 64 * 64 * 2;
constexpr size_t WS_ROPE = WS_MOD + (size_t)2 * 3 * 3072 * 4;
constexpr size_t WS_HF = WS_ROPE + 8192;
constexpr int HFS = 1040;
constexpr size_t HF_LSTRIDE = (size_t)1280 * HFS;
constexpr size_t WS_NP = WS_HF + 2 * HF_LSTRIDE * 4;
constexpr size_t WS_CNT = WS_NP + (size_t)2 * 2 * 32 * 1024 * 4;
constexpr size_t WS_BAR = WS_CNT + 256;
constexpr size_t WS_H = WS_BAR + 13824;
constexpr size_t WS_U = WS_H + (size_t)MROWS * 1024 * 2;
constexpr size_t WS_UH = WS_U + (size_t)MROWS * DP * 2;
constexpr size_t WS_KC = WS_UH + (size_t)256 * MROWS * 8 * 2;
constexpr size_t WS_VC = WS_KC + (size_t)32 * 2 * 256 * 64 * 2;
constexpr size_t WS_KL = WS_VC + (size_t)32 * 2 * 256 * 64 * 2;
constexpr size_t WS_VL = WS_KL + (size_t)2 * 2 * 2 * 1536 * 64 * 2;
constexpr size_t WS_MIX = WS_VL + (size_t)2 * 2 * 2 * 1536 * 64 * 2;
constexpr size_t WS_X = WS_MIX + (size_t)MROWS * DMIX * 2;
constexpr size_t WS_END = WS_X + (size_t)MROWS * 1024 * 4;

struct P { const float* in[32]; float* out; char* ws; };

__device__ __forceinline__ u16 f2bf(float f) { unsigned u = __float_as_uint(f); u += 0x7fffu + ((u >> 16) & 1u); return (u16)(u >> 16); }
__device__ __forceinline__ unsigned cvtpk(float lo, float hi) { unsigned r; asm("v_cvt_pk_bf16_f32 %0, %1, %2" : "=v"(r) : "v"(lo), "v"(hi)); return r; }
__device__ __forceinline__ bf16x4 pk4(float a, float b, float c, float d) { typedef unsigned u32x2 __attribute__((ext_vector_type(2))); u32x2 t; t.x = cvtpk(a, b); t.y = cvtpk(c, d); return __builtin_bit_cast(bf16x4, t); }
__device__ __forceinline__ bf16x8 pk8(float a, float b, float c, float d, float e, float f, float g, float h) { typedef unsigned u32x4_ __attribute__((ext_vector_type(4))); u32x4_ t; t.x = cvtpk(a, b); t.y = cvtpk(c, d); t.z = cvtpk(e, f); t.w = cvtpk(g, h); return __builtin_bit_cast(bf16x8, t); }
__device__ __forceinline__ float bf2f(u16 h) { return __uint_as_float(((unsigned)h) << 16); }
__device__ __forceinline__ float bfs(short h) { return __uint_as_float(((unsigned)(u16)h) << 16); }
__device__ __forceinline__ float fexp(float x) { return __expf(x); }
__device__ __forceinline__ float siluf(float x) { return x * __builtin_amdgcn_rcpf(1.f + fexp(-x)); }
__device__ __forceinline__ float sigm(float x) { return __builtin_amdgcn_rcpf(1.f + fexp(-x)); }

__device__ __forceinline__ int otid() { int t; asm volatile("v_mov_b32 %0, %1" : "=v"(t) : "v"((int)threadIdx.x)); return t; }
__device__ __forceinline__ int osgpr(int x) { asm volatile("" : "+s"(x)); return x; }
__device__ void p0_filter(const P& p, char* smem, int it) {
  const int l = it / 40, r = it % 40; const int sel = r >= 8; const int chunk = sel ? r - 8 : r;
  const int L = sel ? 1024 : 256;
  float* feats = (float*)smem;
  float* h1 = feats + 32 * 36;
  float* h2 = h1 + 32 * 64;
  const int tid = otid();
  const float* w1 = p.in[15] + l * 33 * 64; const float* b1 = p.in[16] + l * 64;
  const float* w2 = p.in[17] + l * 64 * 64; const float* b2 = p.in[18] + l * 64;
  const float* w3 = p.in[19] + l * 64 * 1024; const float* fq = p.in[20] + l * 128; const float* dec = p.in[21] + l * 1024;
  const int c0 = tid;
  float wq[2][64];
#pragma unroll
  for (int j = 0; j < 64; ++j) { wq[0][j] = w3[j * 1024 + c0]; wq[1][j] = w3[j * 1024 + 512 + c0]; }
  for (int e = tid; e < 32 * 33; e += NT) {
    int tt = e / 33, j = e % 33; int t = chunk * 32 + tt; float v;
    if (j == 0) v = (float)t / (float)(L - 1);
    else { int i = (j - 1) & 15; float f = 1e-4f + (float)i * ((15.0f - 1e-4f) / 15.0f);
      float w = 6.283185307179586f * (float)t / (float)L; float a = f * w; v = (j <= 16) ? __cosf(a) : -__sinf(a); }
    feats[tt * 36 + j] = v;
  }
  __syncthreads();
  { const int j = tid & 63, tq = tid >> 6; float acc[4];
#pragma unroll
    for (int i = 0; i < 4; ++i) acc[i] = b1[j];
    float wcol[33];
#pragma unroll
    for (int e = 0; e < 33; ++e) wcol[e] = w1[e * 64 + j];
#pragma unroll
    for (int e = 0; e < 33; ++e) {
#pragma unroll
      for (int i = 0; i < 4; ++i) acc[i] += feats[(tq * 4 + i) * 36 + e] * wcol[e]; }
    float f0 = fq[j];
#pragma unroll
    for (int i = 0; i < 4; ++i) h1[(tq * 4 + i) * 64 + j] = __sinf(f0 * acc[i]); }
  __syncthreads();
  { const int j = tid & 63, tq = tid >> 6; float acc[4];
#pragma unroll
    for (int i = 0; i < 4; ++i) acc[i] = b2[j];
    float wcol[64];
#pragma unroll
    for (int e = 0; e < 64; ++e) wcol[e] = w2[e * 64 + j];
#pragma unroll
    for (int e = 0; e < 64; ++e) {
#pragma unroll
      for (int i = 0; i < 4; ++i) acc[i] += h1[(tq * 4 + i) * 64 + e] * wcol[e]; }
    float f1 = fq[64 + j];
#pragma unroll
    for (int i = 0; i < 4; ++i) h2[(tq * 4 + i) * 64 + j] = __sinf(f1 * acc[i]); }
  __syncthreads();
  float* HF = (float*)(p.ws + WS_HF) + (size_t)l * HF_LSTRIDE + (sel ? 256 * HFS : 0);
  float* NP = (float*)(p.ws + WS_NP) + ((l * 2 + sel) * 32 + chunk) * 1024;
  { const float d0 = dec[c0], d1 = dec[512 + c0]; float as0 = 0.f, as1 = 0.f;
#pragma unroll 1
    for (int tt = 0; tt < 32; ++tt) {
      float a0 = 0.f, a1 = 0.f;
#pragma unroll
      for (int j4 = 0; j4 < 16; ++j4) { const float4 hv = *(const float4*)(h2 + tt * 64 + j4 * 4);
        a0 += hv.x * wq[0][j4 * 4] + hv.y * wq[0][j4 * 4 + 1] + hv.z * wq[0][j4 * 4 + 2] + hv.w * wq[0][j4 * 4 + 3];
        a1 += hv.x * wq[1][j4 * 4] + hv.y * wq[1][j4 * 4 + 1] + hv.z * wq[1][j4 * 4 + 2] + hv.w * wq[1][j4 * 4 + 3]; }
      const int t = chunk * 32 + tt; const float tv = (float)t / (float)(L - 1);
      const float v0 = a0 * expf(-tv * d0), v1 = a1 * expf(-tv * d1);
      HF[(size_t)t * HFS + c0] = v0; HF[(size_t)t * HFS + 512 + c0] = v1;
      as0 += fabsf(v0); if (t != 0) as1 += fabsf(v1);
    }
    NP[c0] = as0; NP[512 + c0] = as1;
  }
  __syncthreads();
}

__device__ void p0_adaln(const P& p, char* smem, int it) {
  const int l = it / 96, j0 = (it % 96) * 32; const int tid = otid();
  float* ss = (float*)smem;
  float* red = ss + 3072;
  for (int e = tid; e < 3072; e += NT) { int cv = e >> 10, k = e & 1023; float x = cv == 0 ? p.in[6][k] : p.in[5][(cv - 1) * 1024 + k]; ss[e] = x / (1.f + expf(-x)); }
  __syncthreads();
  const int c = tid & 31, kg = tid >> 5;
  const float* W = p.in[8] + (size_t)l * 1024 * 3072 + j0 + c;
  float a0 = 0.f, a1 = 0.f, a2 = 0.f;
#pragma unroll 32
  for (int k = kg * 64; k < kg * 64 + 64; ++k) { float w = __builtin_nontemporal_load(W + (size_t)k * 3072); a0 += ss[k] * w; a1 += ss[1024 + k] * w; a2 += ss[2048 + k] * w; }
  red[(kg * 3 + 0) * 32 + c] = a0; red[(kg * 3 + 1) * 32 + c] = a1; red[(kg * 3 + 2) * 32 + c] = a2;
  __syncthreads();
  if (tid < 96) { int cv = tid >> 5, cc = tid & 31; float s = p.in[9][l * 3072 + j0 + cc];
    for (int k = 0; k < 16; ++k) s += red[(k * 3 + cv) * 32 + cc];
    ((float*)(p.ws + WS_MOD))[(l * 3 + cv) * 3072 + j0 + cc] = s; }
  __syncthreads();
}

__device__ void p0_transpose(const float* src, u16* dst, int K, int N, int kt, int nt, char* smem) {
  float* T = (float*)smem;
  const int tid = otid(); const int r = tid >> 6, c4 = (tid & 63) * 4;
  float4 v[8];
#pragma unroll
  for (int h = 0; h < 8; ++h) { const f32x4 t = __builtin_nontemporal_load((const f32x4*)(src + (size_t)(kt * 64 + r + h * 8) * N + nt * 256 + c4)); v[h] = make_float4(t[0], t[1], t[2], t[3]); }
#pragma unroll
  for (int h = 0; h < 8; ++h) { float* tp = T + (r + h * 8) * 257 + c4; tp[0] = v[h].x; tp[1] = v[h].y; tp[2] = v[h].z; tp[3] = v[h].w; }
  __syncthreads();
  const int n = tid >> 1, kh = (tid & 1) * 32;
#pragma unroll
  for (int q = 0; q < 4; ++q) { bf16x8 o;
#pragma unroll
    for (int i = 0; i < 8; ++i) o[i] = (short)f2bf(T[(kh + q * 8 + i) * 257 + n]);
    *(bf16x8*)(dst + (size_t)(nt * 256 + n) * K + kt * 64 + kh + q * 8) = o; }
  __syncthreads();
}

template <int l, int part>
__device__ void phase0_items(const P& p, char* smem) {
  __shared__ int s_it0;
  int* cnt = (int*)(p.ws + WS_CNT) + 8 + l * 4 + part;
  const int n_fil = part == 0 ? 0 : 40, n_ada = part == 1 ? 0 : 96, n_win = part == 1 ? 0 : 272, n_wout = part == 0 ? 0 : 96;
  for (;;) {
    if (otid() == 0) s_it0 = atomicAdd(cnt, 1);
    __syncthreads();
    int it = s_it0;
    __syncthreads();
    if (it >= n_fil + n_ada + n_win + n_wout) break;
    if (n_fil > 0 && it < n_fil) { p0_filter(p, smem, l * 40 + it); continue; }
    it -= n_fil;
    if (n_ada > 0 && it < n_ada) { p0_adaln(p, smem, l * 96 + it); continue; }
    it -= n_ada;
    if (n_win > 0 && it < n_win) { const int nt = it / 16, kt = it % 16;
      p0_transpose(p.in[10] + (size_t)l * 1024 * 4352, (u16*)(p.ws + WS_WTIN) + (size_t)l * 4352 * 1024, 1024, 4352, kt, nt, smem); continue; }
    it -= n_win;
    if (n_wout > 0) { const int nt = it / 24, kt = it % 24;
      p0_transpose(p.in[30] + (size_t)l * 1536 * 1024, (u16*)(p.ws + WS_WTOUT) + (size_t)l * 1024 * 1536, 1536, 1024, kt, nt, smem); }
  }
}

__device__ void phase0(const P& p, char* smem) {
  const int G = gridDim.x;
  phase0_items<0, 0>(p, smem);
  const int gt = blockIdx.x * NT + otid(), gn = G * NT;
  u16* KL = (u16*)(p.ws + WS_KL); u16* VL = (u16*)(p.ws + WS_VL);
  for (int idx = gt; idx < 2 * 2 * 2 * 512 * 64; idx += gn) {
    int d = idx & 63, pp = (idx >> 6) & 511, kvh = (idx >> 15) & 1, b = (idx >> 16) & 1, l = idx >> 17;
    size_t src = ((((size_t)b * 2 + l) * 512 + pp) * 2 + kvh) * 64 + d;
    KL[((size_t)((l * 2 + b) * 2 + kvh) * 1536 + pp) * 64 + d] = f2bf(p.in[2][src]);
    VL[((size_t)((l * 2 + b) * 2 + kvh) * 64 + d) * 1536 + pp] = f2bf(p.in[3][src]);
  }
  float* rope = (float*)(p.ws + WS_ROPE);
  for (int idx = gt; idx < 1024; idx += gn) { int pos = idx >> 4, fi = idx & 15; float inv = powf(10000.0f, -(float)fi / 16.0f); float a = (float)pos * inv;
    rope[idx * 2] = cosf(a); rope[idx * 2 + 1] = sinf(a); }
  u16* WGT = (u16*)(p.ws + WS_WGT);
  for (int idx = gt; idx < 2 * 2 * 2 * 8 * 64 * 64; idx += gn) {
    int c = idx & 63, d = (idx >> 6) & 63, n = (idx >> 12) & 7, gate = (idx >> 15) & 1, dir = (idx >> 16) & 1, l = idx >> 17;
    const float* src = gate ? p.in[27] : p.in[25];
    WGT[idx] = f2bf(src[((size_t)((l * 2 + dir) * 8 + n) * 64 + c) * 64 + d]);
  }
}

__device__ void norm_phase(const P& p, int layer) {
  const int wave = otid() >> 6, lane = otid() & 63;
  const float* X = (const float*)(p.ws + WS_X);
  u16* H = (u16*)(p.ws + WS_H);
  const int stride = gridDim.x * 8;
  int row = blockIdx.x * 8 + wave;
  float4 vn[4];
  if (row < MROWS) { const float* x = layer == 0 ? (row < MCTX ? p.in[0] + (size_t)row * 1024 : p.in[1] + (size_t)(row - MCTX) * 1024) : X + (size_t)row * 1024;
#pragma unroll
    for (int i = 0; i < 4; ++i) vn[i] = *(const float4*)(x + i * 256 + lane * 4); }
  for (; row < MROWS; row += stride) {
    float4 v[4]; float ss = 0.f;
#pragma unroll
    for (int i = 0; i < 4; ++i) { v[i] = vn[i]; ss += v[i].x * v[i].x + v[i].y * v[i].y + v[i].z * v[i].z + v[i].w * v[i].w; }
    { const int rn = row + stride;
      if (rn < MROWS) { const float* x = layer == 0 ? (rn < MCTX ? p.in[0] + (size_t)rn * 1024 : p.in[1] + (size_t)(rn - MCTX) * 1024) : X + (size_t)rn * 1024;
#pragma unroll
        for (int i = 0; i < 4; ++i) vn[i] = *(const float4*)(x + i * 256 + lane * 4); } }
#pragma unroll
    for (int o = 32; o >= 1; o >>= 1) ss += __shfl_xor(ss, o);
    const float rstd = rsqrtf(ss * (1.f / 1024.f) + 1e-6f);
    if (layer < 2) {
      const int cv = row < MCTX ? 0 : 1 + ((row - MCTX) >> 10);
      const float* md = (const float*)(p.ws + WS_MOD) + (layer * 3 + cv) * 3072;
      const float* g = p.in[7] + layer * 1024;
#pragma unroll
      for (int i = 0; i < 4; ++i) { const int k = i * 256 + lane * 4;
        float4 g4 = *(const float4*)(g + k), sh = *(const float4*)(md + k), sc = *(const float4*)(md + 1024 + k);
        *(bf16x4*)(H + (size_t)row * 1024 + k) = pk4(v[i].x * rstd * g4.x * (1.f + sc.x) + sh.x, v[i].y * rstd * g4.y * (1.f + sc.y) + sh.y,
                                                     v[i].z * rstd * g4.z * (1.f + sc.z) + sh.z, v[i].w * rstd * g4.w * (1.f + sc.w) + sh.w); }
    } else {
      float* o = p.out + (row < MCTX ? (size_t)row * 1024 : (size_t)OUT_YS + (size_t)(row - MCTX) * 1024);
      const float* g = p.in[31];
#pragma unroll
      for (int i = 0; i < 4; ++i) { const int k = i * 256 + lane * 4; float4 g4 = *(const float4*)(g + k); float4 r;
        r.x = v[i].x * rstd * g4.x; r.y = v[i].y * rstd * g4.y; r.z = v[i].z * rstd * g4.z; r.w = v[i].w * rstd * g4.w;
        *(float4*)(o + k) = r; }
    }
  }
}

namespace pg8 {
#define PG8_LAS __attribute__((address_space(3)))
typedef unsigned short bf16_t;
typedef short bf16x8 __attribute__((ext_vector_type(8)));
typedef float f32x4 __attribute__((ext_vector_type(4)));
typedef unsigned u32x4 __attribute__((ext_vector_type(4)));
constexpr int BM = 256, BK = 64, HALF = 128, HTB = HALF * BK * 2  , STAGE_BYTES = 8 * HTB, NXCD = 8, WGM = 8;

__host__ __device__ __forceinline__ int lds_byte(int r, int c) { const int st = (r >> 4) * 2 + (c >> 5), rr = r & 15, cc = c & 31, ob = rr * 64 + cc * 2; return st * 1024 + (ob ^ (((ob >> 9) & 1) << 5)); }
__host__ __device__ __forceinline__ void stage_rc(int b, int& R, int& C) { const int st = b / 1024, sb = b % 1024, swz = sb ^ (((sb >> 9) & 1) << 5); R = (st >> 1) * 16 + swz / 64; C = (st & 1) * 32 + (swz % 64) / 2; }
__host__ __device__ __forceinline__ int perm32(int rho) { const int n = rho >> 4, i = rho & 15; return 8 * (i >> 2) + 4 * n + (i & 3); }

struct Unit { int pm, pn; };
struct Gemm { const bf16_t* A; const bf16_t* Bt; int M, N, K; };

struct StaticOrder {
    int nM, nN, nwg, G, c;
    __host__ __device__ void init(int M, int N, int G_, int c_) { nM = M / BM; nN = N / BM; nwg = nM * nN; G = G_; c = c_; }
    __host__ __device__ bool next(int i, Unit& u) const {
        const long L = (long)i * G + c; if (L >= nwg) return false;
        int wgid = (int)L; { const int q = nwg / NXCD, r = nwg % NXCD, xcd = wgid % NXCD, off = wgid / NXCD; wgid = (xcd < r ? xcd * (q + 1) : r * (q + 1) + (xcd - r) * q) + off; }
        const int nig = WGM * nN, gid = wgid / nig, fm = gid * WGM, gsz = (nM - fm) < WGM ? (nM - fm) : WGM;
        u.pm = fm + ((wgid % nig) % gsz); u.pn = (wgid % nig) / gsz; return true;
    }
    __device__ __forceinline__ void a_ready(const Unit&) const {}
    __device__ __forceinline__ void done(const Unit&) const {}
};
__device__ __forceinline__ unsigned cvt_pk_bf16(float lo, float hi) { unsigned r; asm volatile("v_cvt_pk_bf16_f32 %0, %1, %2" : "=v"(r) : "v"(lo), "v"(hi)); return r; }
template <class Epi, class Sched, bool STAMP = false>
__device__ __forceinline__ void gemm_phase(PG8_LAS unsigned char* lds, const Gemm g, const Sched& S, const Epi& E, unsigned long long* stamps) {
    const int tid = otid(), wid = __builtin_amdgcn_readfirstlane(tid >> 6), lane = tid & 63, wr = wid >> 2, wc = wid & 3, fr = lane & 15, fq = lane >> 4;
    const int K = g.K, nt = K / BK;
    int ts_lo = 0, ts_hi = 0, nts = 0; const unsigned long long rt_entry = STAMP ? (unsigned long long)wall_clock64() : 0ull;
#define PG8_STAMP() do { if (STAMP && wid == 0 && nts < 64) { const unsigned long long _c = (unsigned long long)clock64(); \
        ts_lo = (lane == nts) ? (int)(unsigned)_c : ts_lo; ts_hi = (lane == nts) ? (int)(unsigned)(_c >> 32) : ts_hi; ++nts; } } while (0)
    PG8_STAMP();
    unsigned voffA[2], voffB[2];
#pragma unroll
    for (int i = 0; i < 2; ++i) { int R, C; stage_rc(tid * 16 + i * 8192, R, C); const int Rb = Epi::PERM ? ((R & ~31) + perm32(R & 31)) : R;
        voffA[i] = (unsigned)(R * K + C) * 2u; voffB[i] = (unsigned)(Rb * K + C) * 2u; }
    const size_t kstep = (size_t)(BK * 2);
    const size_t hstep = (size_t)HALF * K * 2;
    const size_t tstep = 2 * hstep;
    const unsigned ldsw = (unsigned)wid * 1024u;
    const int aoff = lds_byte(wr * 64 + fr, fq * 8), boff = lds_byte(wc * 32 + fr, fq * 8);
#define PG8_SA(b, h) (((b) * 2 + (h)) * HTB)
#define PG8_SB(b, h) ((4 + (b) * 2 + (h)) * HTB)
#define PG8_STAGE(bufoff, gbase, voff) do { _Pragma("unroll") for (int _i = 0; _i < 2; ++_i) \
        __builtin_amdgcn_global_load_lds((const unsigned*)((const char*)(gbase) + (voff)[_i]), (PG8_LAS unsigned*)(lds + (bufoff) + ldsw + _i * 8192), 16, 0, 0); } while (0)
#define PG8_LDA(dst, b, h) do { _Pragma("unroll") for (int m = 0; m < 4; ++m) _Pragma("unroll") for (int k = 0; k < 2; ++k) dst[m][k] = *(const PG8_LAS bf16x8*)(lds + PG8_SA(b, h) + aoff + m * 2048 + k * 1024); } while (0)
#define PG8_LDB(dst, b, h) do { _Pragma("unroll") for (int n = 0; n < 2; ++n) _Pragma("unroll") for (int k = 0; k < 2; ++k) dst[n][k] = *(const PG8_LAS bf16x8*)(lds + PG8_SB(b, h) + boff + n * 2048 + k * 1024); } while (0)
#define PG8_MMA(ai, bj, At, Bt) do { __builtin_amdgcn_s_setprio(1); _Pragma("unroll") for (int m = 0; m < 4; ++m) _Pragma("unroll") for (int n = 0; n < 2; ++n) _Pragma("unroll") for (int k = 0; k < 2; ++k) \
        acc[ai][bj][m][n] = __builtin_amdgcn_mfma_f32_16x16x32_bf16(Bt[n][k], At[m][k], acc[ai][bj][m][n], 0, 0, 0); __builtin_amdgcn_s_setprio(0); } while (0)
#define PG8_WAIT_V(n) asm volatile("s_waitcnt vmcnt(" #n ")" ::: "memory")
#define PG8_WAIT_L(n) asm volatile("s_waitcnt lgkmcnt(" #n ")" ::: "memory")
#define PG8_BAR __builtin_amdgcn_s_barrier()
#define PG8_SCHED __builtin_amdgcn_sched_barrier(0)
    Unit cur, nxt; int ui = 0;
    if (!S.next(0, cur)) return;
    f32x4 acc[2][2][4][2];
#pragma unroll
    for (int a = 0; a < 2; ++a)
#pragma unroll
        for (int b = 0; b < 2; ++b)
#pragma unroll
            for (int m = 0; m < 4; ++m)
#pragma unroll
                for (int n = 0; n < 2; ++n) acc[a][b][m][n] = (f32x4){0.f, 0.f, 0.f, 0.f};
    bf16x8 At[4][2], B0[2][2], B1[2][2];
    const char* cA = (const char*)g.A + (size_t)cur.pm * tstep; const char* cB = (const char*)g.Bt + (size_t)cur.pn * tstep;
    S.a_ready(cur);
    PG8_STAGE(PG8_SB(0, 0), cB, voffB); PG8_STAGE(PG8_SA(0, 0), cA, voffA); PG8_STAGE(PG8_SB(0, 1), cB + hstep, voffB); PG8_STAGE(PG8_SA(0, 1), cA + hstep, voffA);
    if (wr == 1) PG8_BAR;
    PG8_WAIT_V(4); PG8_BAR;
    PG8_STAGE(PG8_SB(1, 0), cB + kstep, voffB); PG8_STAGE(PG8_SA(1, 0), cA + kstep, voffA); PG8_STAGE(PG8_SB(1, 1), cB + hstep + kstep, voffB);
    PG8_WAIT_V(6); PG8_BAR;
    PG8_STAMP();
    for (;;) {
        const bool has_next = S.next(ui + 1, nxt);
        const char* nA = has_next ? (const char*)g.A + (size_t)nxt.pm * tstep : cA; const char* nB = has_next ? (const char*)g.Bt + (size_t)nxt.pn * tstep : cB;
        for (int t = 0; t < nt; t += 2) {
            const bool last = (t == nt - 2);
            const char* a1 = cA + (size_t)(t + 1) * kstep;
            const char* a2 = last ? nA : cA + (size_t)(t + 2) * kstep; const char* b2 = last ? nB : cB + (size_t)(t + 2) * kstep;
            const char* a3 = a2 + kstep; const char* b3 = b2 + kstep;
            if (last && has_next) S.a_ready(nxt);
            PG8_LDB(B0, 0, 0); PG8_SCHED; PG8_LDA(At, 0, 0); PG8_STAGE(PG8_SA(1, 1), a1 + hstep, voffA);
            PG8_WAIT_L(8); PG8_BAR; PG8_WAIT_L(0); PG8_MMA(0, 0, At, B0); PG8_BAR; PG8_SCHED;
            PG8_LDB(B1, 0, 1); PG8_STAGE(PG8_SB(0, 0), b2, voffB);
            PG8_BAR; PG8_WAIT_L(0); PG8_MMA(0, 1, At, B1); PG8_BAR;
            PG8_LDA(At, 0, 1); PG8_STAGE(PG8_SA(0, 0), a2, voffA);
            PG8_BAR; PG8_WAIT_L(0); PG8_MMA(1, 0, At, B0); PG8_BAR; PG8_SCHED;
            PG8_STAGE(PG8_SB(0, 1), b2 + hstep, voffB);
            PG8_WAIT_V(6); PG8_BAR; PG8_MMA(1, 1, At, B1); PG8_BAR;
            PG8_LDB(B0, 1, 0); PG8_SCHED; PG8_LDA(At, 1, 0); PG8_STAGE(PG8_SA(0, 1), a2 + hstep, voffA);
            PG8_WAIT_L(8); PG8_BAR; PG8_WAIT_L(0); PG8_MMA(0, 0, At, B0); PG8_BAR; PG8_SCHED;
            PG8_LDB(B1, 1, 1); PG8_STAGE(PG8_SB(1, 0), b3, voffB);
            PG8_BAR; PG8_WAIT_L(0); PG8_MMA(0, 1, At, B1); PG8_BAR;
            PG8_LDA(At, 1, 1); PG8_STAGE(PG8_SA(1, 0), a3, voffA);
            PG8_BAR; PG8_WAIT_L(0); PG8_MMA(1, 0, At, B0); PG8_BAR; PG8_SCHED;
            PG8_STAGE(PG8_SB(1, 1), b3 + hstep, voffB);
            PG8_WAIT_V(6); PG8_BAR; PG8_MMA(1, 1, At, B1); PG8_BAR;
        }
        PG8_STAMP();
        if constexpr (!Epi::AFTER_DRAIN) { E(acc, cur, wr, wc, fr, fq); S.done(cur); }
        PG8_STAMP();
        if (!has_next) break;
#pragma unroll
        for (int a = 0; a < 2; ++a)
#pragma unroll
            for (int b = 0; b < 2; ++b)
#pragma unroll
                for (int m = 0; m < 4; ++m)
#pragma unroll
                    for (int n = 0; n < 2; ++n) acc[a][b][m][n] = (f32x4){0.f, 0.f, 0.f, 0.f};
        cur = nxt; cA = nA; cB = nB; ++ui;
    }
    PG8_WAIT_V(0);
    if (wr == 0) PG8_BAR;
    PG8_BAR;
    if constexpr (Epi::AFTER_DRAIN) { E.fused(acc, cur, wr, wc, fr, fq, lds, wid, lane); S.done(cur); }
    PG8_STAMP();
    if (STAMP && wid == 0) { stamps[lane] = lane < nts ? (((unsigned long long)(unsigned)ts_hi << 32) | (unsigned)ts_lo) : 0ull;
        if (lane == 62) stamps[62] = rt_entry; if (lane == 63) stamps[63] = (unsigned long long)wall_clock64(); }
#undef PG8_STAMP
#undef PG8_SA
#undef PG8_SB
#undef PG8_STAGE
#undef PG8_LDA
#undef PG8_LDB
#undef PG8_MMA
#undef PG8_WAIT_V
#undef PG8_WAIT_L
#undef PG8_BAR
#undef PG8_SCHED
}
}

struct EpiOut {
  static constexpr bool PERM = false, AFTER_DRAIN = false;
  const float* in0; const float* in1; char* ws; int layer;
  __device__ __forceinline__ void operator()(const f32x4 (&acc)[2][2][4][2], const pg8::Unit& u, int wr, int wc, int fr, int fq) const {
    const int brow = u.pm * 256; const int row0 = brow + wr * 64 + fr, col0 = u.pn * 256 + wc * 32 + 4 * fq;
    float* X = (float*)(ws + WS_X);
    const int cv = brow < MCTX ? 0 : 1 + ((brow - MCTX) >> 10);
    const float* gate = (const float*)(ws + WS_MOD) + (layer * 3 + cv) * 3072 + 2048;
    const float* xin = layer == 0 ? (brow < MCTX ? in0 : in1 - (size_t)MCTX * 1024) : X;
    f32x4 gv[2][2];
#pragma unroll
    for (int bj = 0; bj < 2; ++bj)
#pragma unroll
      for (int n = 0; n < 2; ++n) gv[bj][n] = *(const f32x4*)(gate + col0 + bj * 128 + n * 16);
#pragma unroll
    for (int ai = 0; ai < 2; ++ai)
#pragma unroll
      for (int m = 0; m < 4; ++m) { const size_t ro = (size_t)(row0 + ai * 128 + m * 16) * 1024 + col0;
#pragma unroll
        for (int bj = 0; bj < 2; ++bj)
#pragma unroll
          for (int n = 0; n < 2; ++n) { const f32x4 xv = *(const f32x4*)(xin + ro + bj * 128 + n * 16);
            *(f32x4*)(X + ro + bj * 128 + n * 16) = xv + gv[bj][n] * acc[ai][bj][m][n]; } }
  }
};

struct EpiIn {
  static constexpr bool PERM = true, AFTER_DRAIN = false;
  const float* qg; const float* kg; float* out; char* ws; float* sSS; int layer;
  template <int KIND>
  __device__ __forceinline__ void half(const f32x4 (&acc)[2][2][4][2], const int bj, const int brow, const int pn, const bool lat, int wr, int wc, int fr, int fq) const {
    u16* U = (u16*)(ws + WS_U);
    const float* rope = (const float*)(ws + WS_ROPE);
    const int dh = (wc & 1) * 32 + 8 * fq;
    const int hd = wc >> 1;
    float gn[8];
    if (KIND <= 1) { const float* gp = (KIND == 0 ? qg : kg) + layer * 64 + dh;
      const f32x4 g0 = *(const f32x4*)gp, g1 = *(const f32x4*)(gp + 4);
      gn[0] = g0[0]; gn[1] = g0[1]; gn[2] = g0[2]; gn[3] = g0[3]; gn[4] = g1[0]; gn[5] = g1[1]; gn[6] = g1[2]; gn[7] = g1[3]; }
#pragma unroll
    for (int ai = 0; ai < 2; ++ai)
#pragma unroll
      for (int m = 0; m < 4; ++m) {
        const int rl = ai * 128 + wr * 64 + m * 16 + fr; const int row = brow + rl;
        const f32x4 v0 = acc[ai][bj][m][0], v1 = acc[ai][bj][m][1];
        float v[8] = {v0[0], v0[1], v0[2], v0[3], v1[0], v1[1], v1[2], v1[3]};
        if (KIND <= 1) {
          const float tot = sSS[(bj * 256 + rl) * 4 + wc] + sSS[(bj * 256 + rl) * 4 + (wc ^ 1)];
          const float rstd = rsqrtf(tot * (1.f / 64.f) + 1e-6f);
#pragma unroll
          for (int i = 0; i < 8; ++i) v[i] = v[i] * rstd * gn[i];
          if (KIND == 1 && !lat) { const int b = row >> 8, t = row & 255; float* op = out + (size_t)OUT_K + ((size_t)((b * 2 + layer) * 256 + t)) * 128 + hd * 64 + dh;
            *(f32x4*)op = (f32x4){v[0], v[1], v[2], v[3]}; *(f32x4*)(op + 4) = (f32x4){v[4], v[5], v[6], v[7]}; }
          if (lat) {
            const int t = (row - MCTX) & 1023; const int posv = (wc & 1) ? (t & 63) : (t >> 6);
            const float* rp = rope + (posv * 16 + 4 * fq) * 2;
            const f32x4 r0 = *(const f32x4*)rp, r1 = *(const f32x4*)(rp + 4);
            float x1, x2;
            x1 = v[0]; x2 = v[1]; v[0] = x1 * r0[0] - x2 * r0[1]; v[1] = x1 * r0[1] + x2 * r0[0];
            x1 = v[2]; x2 = v[3]; v[2] = x1 * r0[2] - x2 * r0[3]; v[3] = x1 * r0[3] + x2 * r0[2];
            x1 = v[4]; x2 = v[5]; v[4] = x1 * r1[0] - x2 * r1[1]; v[5] = x1 * r1[1] + x2 * r1[0];
            x1 = v[6]; x2 = v[7]; v[6] = x1 * r1[2] - x2 * r1[3]; v[7] = x1 * r1[3] + x2 * r1[2];
          }
          pg8::u32x4 w;
          if (KIND == 0) { w.x = pg8::cvt_pk_bf16(v[0] * 0.125f, v[1] * 0.125f); w.y = pg8::cvt_pk_bf16(v[2] * 0.125f, v[3] * 0.125f); w.z = pg8::cvt_pk_bf16(v[4] * 0.125f, v[5] * 0.125f); w.w = pg8::cvt_pk_bf16(v[6] * 0.125f, v[7] * 0.125f);
            *(pg8::u32x4*)(U + (size_t)row * DP + pn * 256 + bj * 128 + wc * 32 + 8 * fq) = w; }
          else { w.x = pg8::cvt_pk_bf16(v[0], v[1]); w.y = pg8::cvt_pk_bf16(v[2], v[3]); w.z = pg8::cvt_pk_bf16(v[4], v[5]); w.w = pg8::cvt_pk_bf16(v[6], v[7]);
            if (!lat) { const int b = row >> 8, t = row & 255; *(pg8::u32x4*)((u16*)(ws + WS_KC) + ((size_t)((b * 2 + hd) * 256 + t)) * 64 + dh) = w; }
            else { const int sb = (row - MCTX) >> 10, t = (row - MCTX) & 1023; *(pg8::u32x4*)((u16*)(ws + WS_KL) + ((size_t)(((layer * 2 + sb) * 2 + hd) * 1536 + 512 + t)) * 64 + dh) = w; } }
        } else {
          if (!lat) { const int b = row >> 8, t = row & 255; float* op = out + (size_t)OUT_V + ((size_t)((b * 2 + layer) * 256 + t)) * 128 + hd * 64 + dh;
            *(f32x4*)op = (f32x4){v[0], v[1], v[2], v[3]}; *(f32x4*)(op + 4) = (f32x4){v[4], v[5], v[6], v[7]};
            u16* vp = (u16*)(ws + WS_VC) + ((size_t)((b * 2 + hd) * 64 + dh)) * 256 + t;
#pragma unroll
            for (int i = 0; i < 8; ++i) vp[i * 256] = f2bf(v[i]); }
          else { const int sb = (row - MCTX) >> 10, t = (row - MCTX) & 1023;
            u16* vp = (u16*)(ws + WS_VL) + ((size_t)(((layer * 2 + sb) * 2 + hd) * 64 + dh)) * 1536 + 512 + t;
#pragma unroll
            for (int i = 0; i < 8; ++i) vp[i * 1536] = f2bf(v[i]); }
        }
      }
  }
  __device__ __forceinline__ void operator()(const f32x4 (&acc)[2][2][4][2], const pg8::Unit& u, int wr_, int wc_, int fr_, int fq_) const {
    int tid2; asm volatile("v_mov_b32 %0, %1" : "=v"(tid2) : "v"((int)threadIdx.x));
    const int wid = tid2 >> 6, lane = tid2 & 63, wr = wid >> 2, wc = wid & 3, fr = lane & 15, fq = lane >> 4;
    const int brow = u.pm * 256, pn = u.pn; const bool lat = brow >= MCTX;
    u16* U = (u16*)(ws + WS_U);
    if (pn >= 3) {
      const bool hy = pn >= 5 && pn < 13;
      u16* UH = (u16*)(ws + WS_UH);
      const int cg0 = (pn * 256 + wc * 32 + 8 * fq - 1280) >> 3;
      const int ucol = pn * 256 - (pn >= 13 ? 2048 : 0) + wc * 32 + 8 * fq;
#pragma unroll
      for (int ai = 0; ai < 2; ++ai)
#pragma unroll
        for (int m = 0; m < 4; ++m) { const int row = brow + ai * 128 + wr * 64 + m * 16 + fr;
#pragma unroll
          for (int bj = 0; bj < 2; ++bj) { const f32x4 v0 = acc[ai][bj][m][0], v1 = acc[ai][bj][m][1]; pg8::u32x4 w;
            w.x = pg8::cvt_pk_bf16(v0[0], v0[1]); w.y = pg8::cvt_pk_bf16(v0[2], v0[3]); w.z = pg8::cvt_pk_bf16(v1[0], v1[1]); w.w = pg8::cvt_pk_bf16(v1[2], v1[3]);
            u16* dst = hy ? UH + ((size_t)(cg0 + bj * 16) * MROWS + row) * 8 : U + (size_t)row * DP + ucol + bj * 128;
            *(pg8::u32x4*)dst = w; } }
      return;
    }
    const bool kvtile = pn == 2;
#pragma unroll
    for (int ai = 0; ai < 2; ++ai)
#pragma unroll
      for (int m = 0; m < 4; ++m)
#pragma unroll
        for (int bj = 0; bj < 2; ++bj) {
          const f32x4 v0 = acc[ai][bj][m][0], v1 = acc[ai][bj][m][1];
          float s = v0[0] * v0[0] + v0[1] * v0[1] + v0[2] * v0[2] + v0[3] * v0[3] + v1[0] * v1[0] + v1[1] * v1[1] + v1[2] * v1[2] + v1[3] * v1[3];
          s += __shfl_xor(s, 16); s += __shfl_xor(s, 32);
          if (fq == 0) sSS[(bj * 256 + ai * 128 + wr * 64 + m * 16 + fr) * 4 + wc] = s;
        }
    asm volatile("s_waitcnt lgkmcnt(0)" ::: "memory");
    __builtin_amdgcn_s_barrier();
    asm volatile("" ::: "memory");
    if (kvtile) { half<1>(acc, 0, brow, pn, lat, wr, wc, fr, fq); half<2>(acc, 1, brow, pn, lat, wr, wc, fr, fq); }
    else { half<0>(acc, 0, brow, pn, lat, wr, wc, fr, fq); half<0>(acc, 1, brow, pn, lat, wr, wc, fr, fq); }
  }
};

template <int EPI>
__device__ void gemm_phase(const P& p, const int layer, char* smem) {
  pg8::Gemm g;
  g.M = MROWS;
  if (EPI == 0) { g.A = (const u16*)(p.ws + WS_H); g.Bt = (const u16*)(p.ws + WS_WTIN) + (size_t)layer * 4352 * 1024; g.N = 4352; g.K = 1024; }
  else { g.A = (const u16*)(p.ws + WS_MIX); g.Bt = (const u16*)(p.ws + WS_WTOUT) + (size_t)layer * 1024 * 1536; g.N = 1024; g.K = 1536; }
  pg8::StaticOrder S; S.init(g.M, g.N, (int)gridDim.x, (int)blockIdx.x);
  if (EPI == 0) { EpiIn E{p.in[11], p.in[12], p.out, p.ws, (float*)(smem + 131072), layer};
    pg8::gemm_phase<EpiIn, pg8::StaticOrder, false>((PG8_LAS unsigned char*)smem, g, S, E, nullptr); }
  else { EpiOut E{p.in[0], p.in[1], p.ws, layer};
    pg8::gemm_phase<EpiOut, pg8::StaticOrder, false>((PG8_LAS unsigned char*)smem, g, S, E, nullptr); }
  __syncthreads();
}

__device__ __forceinline__ f32x4 mfma16(bf16x8 a, bf16x8 b, f32x4 c) { return __builtin_amdgcn_mfma_f32_16x16x32_bf16(a, b, c, 0, 0, 0); }

__device__ __forceinline__ void attn_softmax(f32x4 (&s)[4], f32x4 (&o)[4], float& mrun, float& lsum) {
  float mx = -1e30f;
#pragma unroll
  for (int mt = 0; mt < 4; ++mt)
#pragma unroll
    for (int r = 0; r < 4; ++r) mx = fmaxf(mx, s[mt][r]);
  mx = fmaxf(mx, __shfl_xor(mx, 16)); mx = fmaxf(mx, __shfl_xor(mx, 32));
  const float mnew = fmaxf(mrun, mx); const float alpha = __expf(mrun - mnew); mrun = mnew;
  float ps = 0.f;
#pragma unroll
  for (int mt = 0; mt < 4; ++mt)
#pragma unroll
    for (int r = 0; r < 4; ++r) { float pv = __expf(s[mt][r] - mnew); s[mt][r] = pv; ps += pv; }
  lsum = lsum * alpha + ps;
#pragma unroll
  for (int dt = 0; dt < 4; ++dt) { o[dt][0] *= alpha; o[dt][1] *= alpha; o[dt][2] *= alpha; o[dt][3] *= alpha; }
}
__device__ __forceinline__ void attn_sub2(const u16* sK, const u16* sV, const int kb, const int lr, const int g,
                                          const bf16x8 qa0, const bf16x8 qa1, const bf16x8 qb0, const bf16x8 qb1,
                                          f32x4 (&oa)[4], f32x4 (&ob)[4], float& ma, float& la, float& mb, float& lb) {
  f32x4 sa[4], sb[4];
#pragma unroll
  for (int mt = 0; mt < 4; ++mt) {
    const bf16x8 a0 = *(const bf16x8*)(sK + (kb + mt * 16 + lr) * 72 + g * 8), a1 = *(const bf16x8*)(sK + (kb + mt * 16 + lr) * 72 + 32 + g * 8);
    sa[mt] = mfma16(a0, qa0, (f32x4){0.f, 0.f, 0.f, 0.f}); sb[mt] = mfma16(a0, qb0, (f32x4){0.f, 0.f, 0.f, 0.f});
    sa[mt] = mfma16(a1, qa1, sa[mt]); sb[mt] = mfma16(a1, qb1, sb[mt]); }
  attn_softmax(sa, oa, ma, la);
  attn_softmax(sb, ob, mb, lb);
#pragma unroll
  for (int j = 0; j < 2; ++j) {
    const bf16x8 pfa = pk8(sa[2 * j][0], sa[2 * j][1], sa[2 * j][2], sa[2 * j][3], sa[2 * j + 1][0], sa[2 * j + 1][1], sa[2 * j + 1][2], sa[2 * j + 1][3]);
    const bf16x8 pfb = pk8(sb[2 * j][0], sb[2 * j][1], sb[2 * j][2], sb[2 * j][3], sb[2 * j + 1][0], sb[2 * j + 1][1], sb[2 * j + 1][2], sb[2 * j + 1][3]);
#pragma unroll
    for (int dt = 0; dt < 4; ++dt) {
      const u16* vp = sV + (dt * 16 + lr) * 272 + kb + j * 32 + g * 4;
      bf16x4 v0 = *(const bf16x4*)vp, v1 = *(const bf16x4*)(vp + 16);
      bf16x8 a; a[0] = v0[0]; a[1] = v0[1]; a[2] = v0[2]; a[3] = v0[3]; a[4] = v1[0]; a[5] = v1[1]; a[6] = v1[2]; a[7] = v1[3];
      oa[dt] = mfma16(a, pfa, oa[dt]); ob[dt] = mfma16(a, pfb, ob[dt]);
    }
  }
}
__device__ __forceinline__ void attn_sub(const u16* sK, const u16* sV, const int kb, const int lr, const int g, const bf16x8 q0, const bf16x8 q1, f32x4 (&o)[4], float& mrun, float& lsum) {
  f32x4 s[4];
#pragma unroll
  for (int mt = 0; mt < 4; ++mt) { s[mt] = (f32x4){0.f, 0.f, 0.f, 0.f};
    const bf16x8 a0 = *(const bf16x8*)(sK + (kb + mt * 16 + lr) * 72 + g * 8), a1 = *(const bf16x8*)(sK + (kb + mt * 16 + lr) * 72 + 32 + g * 8);
    s[mt] = mfma16(a0, q0, s[mt]); s[mt] = mfma16(a1, q1, s[mt]); }
  float mx = -1e30f;
#pragma unroll
  for (int mt = 0; mt < 4; ++mt)
#pragma unroll
    for (int r = 0; r < 4; ++r) mx = fmaxf(mx, s[mt][r]);
  mx = fmaxf(mx, __shfl_xor(mx, 16)); mx = fmaxf(mx, __shfl_xor(mx, 32));
  const float mnew = fmaxf(mrun, mx); const float alpha = __expf(mrun - mnew); mrun = mnew;
  float ps = 0.f;
#pragma unroll
  for (int mt = 0; mt < 4; ++mt)
#pragma unroll
    for (int r = 0; r < 4; ++r) { float pv = __expf(s[mt][r] - mnew); s[mt][r] = pv; ps += pv; }
  lsum = lsum * alpha + ps;
#pragma unroll
  for (int dt = 0; dt < 4; ++dt) { o[dt][0] *= alpha; o[dt][1] *= alpha; o[dt][2] *= alpha; o[dt][3] *= alpha; }
#pragma unroll
  for (int j = 0; j < 2; ++j) {
    const bf16x8 pf = pk8(s[2 * j][0], s[2 * j][1], s[2 * j][2], s[2 * j][3], s[2 * j + 1][0], s[2 * j + 1][1], s[2 * j + 1][2], s[2 * j + 1][3]);
#pragma unroll
    for (int dt = 0; dt < 4; ++dt) {
      const u16* vp = sV + (dt * 16 + lr) * 272 + kb + j * 32 + g * 4;
      bf16x4 v0 = *(const bf16x4*)vp, v1 = *(const bf16x4*)(vp + 16);
      bf16x8 a; a[0] = v0[0]; a[1] = v0[1]; a[2] = v0[2]; a[3] = v0[3]; a[4] = v1[0]; a[5] = v1[1]; a[6] = v1[2]; a[7] = v1[3];
      o[dt] = mfma16(a, pf, o[dt]);
    }
  }
}
__device__ __forceinline__ void attn_store(const P& p, const f32x4 (&o)[4], float lsum, const int qrow, const int h, const int g) {
  lsum += __shfl_xor(lsum, 16); lsum += __shfl_xor(lsum, 32);
  const float inv = 1.f / lsum;
  const u16* U = (const u16*)(p.ws + WS_U); u16* MIX = (u16*)(p.ws + WS_MIX);
#pragma unroll
  for (int dt = 0; dt < 4; ++dt) {
    const bf16x4 gv = *(const bf16x4*)(U + (size_t)qrow * DP + 768 + h * 64 + dt * 16 + g * 4);
    *(bf16x4*)(MIX + (size_t)qrow * DMIX + h * 64 + dt * 16 + g * 4) =
      pk4(o[dt][0] * inv * siluf(bfs(gv[0])), o[dt][1] * inv * siluf(bfs(gv[1])), o[dt][2] * inv * siluf(bfs(gv[2])), o[dt][3] * inv * siluf(bfs(gv[3])));
  }
}

__device__ void attn_item(const P& p, int layer, int lat, int sb, int h, int qt, char* smem) {
  const int tid = otid(), w = tid >> 6, lane = tid & 63, lr = lane & 15, g = lane >> 4;
  const int kvh = h >> 2;
  const int nkeys = 1536;
  const int m0 = MCTX + sb * 1024 + qt * 128;
  const u16* U = (const u16*)(p.ws + WS_U);
  const u16* Kb = (const u16*)(p.ws + WS_KL) + (size_t)((layer * 2 + sb) * 2 + kvh) * 1536 * 64;
  const u16* Vt = (const u16*)(p.ws + WS_VL) + (size_t)((layer * 2 + sb) * 2 + kvh) * 64 * 1536;
  u16* sK = (u16*)smem;
  u16* sV = sK + 256 * 72;
  const int qrow = m0 + w * 16 + lr;
  bf16x8 kr[4], vr[4];
#pragma unroll
  for (int i = 0; i < 4; ++i) { const int id = tid + i * 512; kr[i] = *(const bf16x8*)(Kb + (size_t)(id >> 3) * 64 + (id & 7) * 8); vr[i] = *(const bf16x8*)(Vt + (size_t)(id >> 5) * nkeys + (id & 31) * 8); }
  const bf16x8 q0 = *(const bf16x8*)(U + (size_t)qrow * DP + h * 64 + g * 8), q1 = *(const bf16x8*)(U + (size_t)qrow * DP + h * 64 + 32 + g * 8);
  f32x4 o[4];
#pragma unroll
  for (int i = 0; i < 4; ++i) o[i] = (f32x4){0.f, 0.f, 0.f, 0.f};
  float mrun = -1e30f, lsum = 0.f;
#pragma unroll 1
  for (int step = 0; step < 6; ++step) {
    __syncthreads();
#pragma unroll
    for (int i = 0; i < 4; ++i) { const int id = tid + i * 512; *(bf16x8*)(sK + (id >> 3) * 72 + (id & 7) * 8) = kr[i]; *(bf16x8*)(sV + (id >> 5) * 272 + (id & 31) * 8) = vr[i]; }
    if (step + 1 < 6) { const int k0 = (step + 1) * 256;
#pragma unroll
      for (int i = 0; i < 4; ++i) { const int id = tid + i * 512; kr[i] = *(const bf16x8*)(Kb + (size_t)(k0 + (id >> 3)) * 64 + (id & 7) * 8); vr[i] = *(const bf16x8*)(Vt + (size_t)(id >> 5) * nkeys + k0 + (id & 31) * 8); } }
    __syncthreads();
#pragma unroll
    for (int sub = 0; sub < 4; ++sub) attn_sub(sK, sV, sub * 64, lr, g, q0, q1, o, mrun, lsum);
  }
  attn_store(p, o, lsum, qrow, h, g);
  __syncthreads();
}

__device__ void attn_ctx_item(const P& p, int layer, int b, int kvh, int qt, char* smem) {
  const int tid = otid(), w = tid >> 6, lane = tid & 63, lr = lane & 15, g = lane >> 4;
  const int qg = w & 3, hp = w >> 2;
  const int m0 = b * 256 + qt * 64;
  const u16* U = (const u16*)(p.ws + WS_U);
  const u16* Kb = (const u16*)(p.ws + WS_KC) + (size_t)(b * 2 + kvh) * 256 * 64;
  const u16* Vt = (const u16*)(p.ws + WS_VC) + (size_t)(b * 2 + kvh) * 64 * 256;
  u16* sK = (u16*)smem;
  u16* sV = sK + 256 * 72;
  const int qrow = m0 + qg * 16 + lr;
  bf16x8 kr[4], vr[4];
#pragma unroll
  for (int i = 0; i < 4; ++i) { const int id = tid + i * 512; kr[i] = *(const bf16x8*)(Kb + (size_t)(id >> 3) * 64 + (id & 7) * 8); vr[i] = *(const bf16x8*)(Vt + (size_t)(id >> 5) * 256 + (id & 31) * 8); }
  const int h0 = kvh * 4 + hp * 2;
  const bf16x8 qa0 = *(const bf16x8*)(U + (size_t)qrow * DP + h0 * 64 + g * 8), qa1 = *(const bf16x8*)(U + (size_t)qrow * DP + h0 * 64 + 32 + g * 8);
  const bf16x8 qb0 = *(const bf16x8*)(U + (size_t)qrow * DP + (h0 + 1) * 64 + g * 8), qb1 = *(const bf16x8*)(U + (size_t)qrow * DP + (h0 + 1) * 64 + 32 + g * 8);
  __syncthreads();
#pragma unroll
  for (int i = 0; i < 4; ++i) { const int id = tid + i * 512; *(bf16x8*)(sK + (id >> 3) * 72 + (id & 7) * 8) = kr[i]; *(bf16x8*)(sV + (id >> 5) * 272 + (id & 31) * 8) = vr[i]; }
  __syncthreads();
  f32x4 oa[4], ob[4];
#pragma unroll
  for (int i = 0; i < 4; ++i) { oa[i] = (f32x4){0.f, 0.f, 0.f, 0.f}; ob[i] = (f32x4){0.f, 0.f, 0.f, 0.f}; }
  float ma = -1e30f, la = 0.f, mb = -1e30f, lb = 0.f;
#pragma unroll 2
  for (int sub = 0; sub < 4; ++sub) attn_sub2(sK, sV, sub * 64, lr, g, qa0, qa1, qb0, qb1, oa, ob, ma, la, mb, lb);
  attn_store(p, oa, la, qrow, h0, g);
  attn_store(p, ob, lb, qrow, h0 + 1, g);
  __syncthreads();
}

template <int L, int NSEQ, int CPI>
__device__ void hyena_item(const P& p, int layer, int m0, int c0, char* smem) {
  constexpr int SEL = (L == 1024) ? 1 : 0, NB = L / 16, KS = (NB + 16) / 2, PAD = 256, ZL = L + 2 * PAD, RO = L + 32, CL = 2 * L + 32, CLS = 2 * L + 48, RRL = 2 * L + 48;
  u16* zb = (u16*)smem;
  u16* cp = zb + 8 * NSEQ * ZL;
  u16* rr = cp + CPI * 8 * CLS;
  float* sInv = (float*)(rr + 8 * RRL);
  const int tid = otid(), w = tid >> 6, lane = tid & 63, lr = lane & 15, g = lane >> 4;
  const float* HF = (const float*)(p.ws + WS_HF) + (size_t)layer * HF_LSTRIDE + (SEL ? 256 * HFS : 0);
  const float* NP = (const float*)(p.ws + WS_NP) + (layer * 2 + SEL) * 32 * 1024;
  const u16* UH = (const u16*)(p.ws + WS_UH);
  u16* MIX = (u16*)(p.ws + WS_MIX);
  const float* sw = p.in[13] + layer * 3 * 1536; const float* sbias = p.in[14] + layer * 1536;
  const int sq = tid / (L / 4), t4 = tid % (L / 4);
  const size_t rowb = (size_t)(m0 + sq * L);
  bf16x8 lx1[6], lhv[6], lx0[6], lgv[4];
#pragma unroll
  for (int r6 = 0; r6 < 6; ++r6) { const int t = min(max(t4 * 4 + r6 - 1, 0), L - 1);
    lx1[r6] = *(const bf16x8*)(UH + ((size_t)((512 + c0) >> 3) * MROWS + rowb + t) * 8); lhv[r6] = *(const bf16x8*)(UH + ((size_t)((1024 + c0) >> 3) * MROWS + rowb + t) * 8); lx0[r6] = *(const bf16x8*)(UH + ((size_t)(c0 >> 3) * MROWS + rowb + t) * 8); }
#pragma unroll
  for (int tt = 0; tt < 4; ++tt) lgv[tt] = *(const bf16x8*)(UH + ((size_t)((1536 + c0) >> 3) * MROWS + rowb + t4 * 4 + tt) * 8);
  asm volatile("" ::: "memory");
  if (tid < 8) { float s = 0.f; for (int ch = 0; ch < L / 32; ++ch) s += NP[ch * 1024 + c0 + tid] + NP[ch * 1024 + 512 + c0 + tid]; sInv[tid] = 1.f / s; sInv[8 + tid] = p.in[22][layer * 512 + c0 + tid]; }
  for (int e = tid; e < 8 * NSEQ * 64; e += NT) { const int cs = e >> 6, q = e & 63; const int off = q < 32 ? q * 8 : PAD + L + (q - 32) * 8;
    *(bf16x8*)(zb + cs * ZL + off) = (bf16x8){0, 0, 0, 0, 0, 0, 0, 0}; }
  for (int y = tid; y < RRL; y += NT) { const int d = RO - y; float v[8];
    if (d > -L && d < L) { const float* src = HF + (size_t)(d >= 0 ? d : -d) * HFS + (d >= 0 ? 0 : 512) + c0; const float4 a = *(const float4*)src, b = *(const float4*)(src + 4);
      v[0] = a.x; v[1] = a.y; v[2] = a.z; v[3] = a.w; v[4] = b.x; v[5] = b.y; v[6] = b.z; v[7] = b.w; }
    else {
#pragma unroll
      for (int i = 0; i < 8; ++i) v[i] = 0.f; }
#pragma unroll
    for (int i = 0; i < 8; ++i) rr[i * RRL + y] = f2bf(v[i]); }
  { float wx[3][8], wv[3][8], bx8[8], bv8[8];
#pragma unroll
    for (int j = 0; j < 3; ++j) { const float4 a = *(const float4*)(sw + j * 1536 + 512 + c0), b = *(const float4*)(sw + j * 1536 + 512 + c0 + 4), c = *(const float4*)(sw + j * 1536 + 1024 + c0), d = *(const float4*)(sw + j * 1536 + 1024 + c0 + 4);
      wx[j][0] = a.x; wx[j][1] = a.y; wx[j][2] = a.z; wx[j][3] = a.w; wx[j][4] = b.x; wx[j][5] = b.y; wx[j][6] = b.z; wx[j][7] = b.w;
      wv[j][0] = c.x; wv[j][1] = c.y; wv[j][2] = c.z; wv[j][3] = c.w; wv[j][4] = d.x; wv[j][5] = d.y; wv[j][6] = d.z; wv[j][7] = d.w; }
    { const float4 a = *(const float4*)(sbias + 512 + c0), b = *(const float4*)(sbias + 512 + c0 + 4), c = *(const float4*)(sbias + 1024 + c0), d = *(const float4*)(sbias + 1024 + c0 + 4);
      bx8[0] = a.x; bx8[1] = a.y; bx8[2] = a.z; bx8[3] = a.w; bx8[4] = b.x; bx8[5] = b.y; bx8[6] = b.z; bx8[7] = b.w;
      bv8[0] = c.x; bv8[1] = c.y; bv8[2] = c.z; bv8[3] = c.w; bv8[4] = d.x; bv8[5] = d.y; bv8[6] = d.z; bv8[7] = d.w; }
    float ax[4][8], av[4][8];
#pragma unroll
    for (int tt = 0; tt < 4; ++tt)
#pragma unroll
      for (int i = 0; i < 8; ++i) { ax[tt][i] = bx8[i]; av[tt][i] = bv8[i]; }
#pragma unroll
    for (int rr6 = 0; rr6 < 6; ++rr6) { const int t = t4 * 4 + rr6 - 1;
      if (t >= 0 && t < L) { const bf16x8 x1 = lx1[rr6], hv = lhv[rr6];
#pragma unroll
        for (int tt = 0; tt < 4; ++tt) { const int j = rr6 - tt;
          if (j >= 0 && j < 3) {
#pragma unroll
            for (int i = 0; i < 8; ++i) { ax[tt][i] += bfs(x1[i]) * wx[j][i]; av[tt][i] += bfs(hv[i]) * wv[j][i]; } } } } }
#pragma unroll
    for (int i = 0; i < 8; ++i)
      *(bf16x4*)(zb + (i * NSEQ + sq) * ZL + PAD + t4 * 4) = pk4(ax[0][i] * av[0][i], ax[1][i] * av[1][i], ax[2][i] * av[2][i], ax[3][i] * av[3][i]); }
  float ex[4][8];
  { float w0[3][8], b08[8];
#pragma unroll
    for (int j = 0; j < 3; ++j) { const float4 a = *(const float4*)(sw + j * 1536 + c0), b = *(const float4*)(sw + j * 1536 + c0 + 4);
      w0[j][0] = a.x; w0[j][1] = a.y; w0[j][2] = a.z; w0[j][3] = a.w; w0[j][4] = b.x; w0[j][5] = b.y; w0[j][6] = b.z; w0[j][7] = b.w; }
    { const float4 a = *(const float4*)(sbias + c0), b = *(const float4*)(sbias + c0 + 4); b08[0] = a.x; b08[1] = a.y; b08[2] = a.z; b08[3] = a.w; b08[4] = b.x; b08[5] = b.y; b08[6] = b.z; b08[7] = b.w; }
#pragma unroll
    for (int tt = 0; tt < 4; ++tt)
#pragma unroll
      for (int i = 0; i < 8; ++i) ex[tt][i] = b08[i];
#pragma unroll
    for (int rr6 = 0; rr6 < 6; ++rr6) { const int t = t4 * 4 + rr6 - 1;
      if (t >= 0 && t < L) { const bf16x8 x0 = lx0[rr6];
#pragma unroll
        for (int tt = 0; tt < 4; ++tt) { const int j = rr6 - tt;
          if (j >= 0 && j < 3) {
#pragma unroll
            for (int i = 0; i < 8; ++i) ex[tt][i] += bfs(x0[i]) * w0[j][i]; } } } } }
  __syncthreads();
  const int seq = NSEQ == 2 ? (w >> 2) : w, nt = NSEQ == 2 ? (w & 3) : 0;
  const int Dlo = 16 * nt - NB + 1; const int sh = (-lr) & 7;
  const int a0 = sh * CLS + 8 * (g & 1) - lr - sh - 16 * (Dlo + (g >> 1)) + RO;
  const int b0 = PAD + 16 * (16 * nt + lr - Dlo - (g >> 1)) + 8 * (g & 1);
  f32x4 acc[CPI];
#pragma unroll
  for (int c = 0; c < CPI; ++c) acc[c] = (f32x4){0.f, 0.f, 0.f, 0.f};
  for (int itc = 0; itc <= 8 / CPI; ++itc) {
    if (itc < 8 / CPI) {
#pragma unroll
      for (int c = 0; c < CPI; ++c) { const u16* rc = rr + (itc * CPI + c) * RRL; u16* cpc = cp + c * 8 * CLS;
        for (int chunk = tid; chunk < CL; chunk += NT) { const int k = chunk / (CL / 8), q8 = chunk % (CL / 8); bf16x8 o;
#pragma unroll
          for (int i = 0; i < 8; ++i) o[i] = (short)rc[8 * q8 + k + i];
          *(bf16x8*)(cpc + k * CLS + 8 * q8) = o; } } }
    if (itc > 0) {
#pragma unroll
      for (int c = 0; c < CPI; ++c) { const int chp = (itc - 1) * CPI + (CPI == 2 ? (w >> 2) : c); const int sq_ = CPI == 2 ? 2 * (w & 3) + c : seq;
        u16* zp = zb + (chp * NSEQ + sq_) * ZL + PAD + 16 * (16 * nt + lr) + 4 * g; const float bs = sInv[8 + chp];
        const bf16x4 zv = *(const bf16x4*)zp;
        const float iv = sInv[chp];
        *(bf16x4*)zp = pk4(acc[c][0] * iv + bs * bfs(zv[0]), acc[c][1] * iv + bs * bfs(zv[1]), acc[c][2] * iv + bs * bfs(zv[2]), acc[c][3] * iv + bs * bfs(zv[3])); } }
    __syncthreads();
    if (itc == 8 / CPI) break;
    if (CPI == 1) {
      const u16* zc = zb + (itc * NSEQ + seq) * ZL;
      f32x4 accA = (f32x4){0.f, 0.f, 0.f, 0.f}, accB = (f32x4){0.f, 0.f, 0.f, 0.f};
#pragma unroll 4
      for (int ks = 0; ks < KS; ks += 2) { const bf16x8 a = *(const bf16x8*)(cp + a0 - 32 * ks), b = *(const bf16x8*)(zc + b0 - 32 * ks);
        const bf16x8 a2 = *(const bf16x8*)(cp + a0 - 32 * ks - 32), b2 = *(const bf16x8*)(zc + b0 - 32 * ks - 32);
        accA = mfma16(a, b, accA); accB = mfma16(a2, b2, accB); }
      acc[0] = accA + accB;
    } else {
      const int cw = w >> 2, sp2 = w & 3;
      const u16* zc0 = zb + ((itc * CPI + cw) * NSEQ + 2 * sp2) * ZL; const u16* zc1 = zc0 + ZL; const u16* cpw = cp + cw * 8 * CLS;
      f32x4 accA = (f32x4){0.f, 0.f, 0.f, 0.f}, accB = (f32x4){0.f, 0.f, 0.f, 0.f};
#pragma unroll 4
      for (int ks = 0; ks < KS; ++ks) { const bf16x8 a = *(const bf16x8*)(cpw + a0 - 32 * ks), b = *(const bf16x8*)(zc0 + b0 - 32 * ks), b2 = *(const bf16x8*)(zc1 + b0 - 32 * ks);
        accA = mfma16(a, b, accA); accB = mfma16(a, b2, accB); }
      acc[0] = accA; acc[CPI - 1] = accB;
    }
    __syncthreads();
  }
  { bf16x4 yz[8];
#pragma unroll
    for (int i = 0; i < 8; ++i) yz[i] = *(const bf16x4*)(zb + (i * NSEQ + sq) * ZL + PAD + t4 * 4);
#pragma unroll
    for (int tt = 0; tt < 4; ++tt) { const bf16x8 gv = lgv[tt]; float of[8];
#pragma unroll
      for (int i = 0; i < 8; ++i) of[i] = ex[tt][i] * bfs(yz[i][tt]) * siluf(bfs(gv[i]));
      *(bf16x8*)(MIX + (rowb + t4 * 4 + tt) * DMIX + 512 + c0) = pk8(of[0], of[1], of[2], of[3], of[4], of[5], of[6], of[7]); } }
  __syncthreads();
}

template <int NTL>
__device__ void lru_item(const P& p, int layer, int lat, int sb, int n, int qd, char* smem) {
  const int L = lat ? 1024 : 256; const int m0 = lat ? MCTX + sb * 1024 : sb * 256;
  const int tid = otid(), w = tid >> 6, lane = tid & 63, lr = lane & 15, g = lane >> 4;
  u16* sW = (u16*)smem;
  float* sCw = (float*)(smem + 18432);
  constexpr bool XC = (NTL == 4);
  float* sX = (float*)(smem + 18432 + 1280);
  u16* sXc = (u16*)(smem + 18432 + 1280);
  float* sTot = (float*)(smem + 18432 + 1280 + (XC ? 36864 : 33280));
  float* sCar = sTot + 2048;
  float* sYf = sCar + 128;
  constexpr int YS = NTL * 16 + 1;
  const u16* U = (const u16*)(p.ws + WS_U);
  u16* MIX = (u16*)(p.ws + WS_MIX);
  const u16* WGT = (const u16*)(p.ws + WS_WGT);
  const int chb = n * 64; const int cq = qd * 16;
  if (tid < 320) sCw[tid] = tid < 256 ? p.in[23][layer * 4 * 512 + (tid >> 6) * 512 + chb + (tid & 63)] : p.in[24][layer * 512 + chb + tid - 256];
  const int nch = L >> 7;
#pragma unroll 1
  for (int dir = 0; dir < 2; ++dir) {
    __syncthreads();
    for (int e = tid; e < 1024; e += NT) { const int gate = e >> 9, d = (e >> 3) & 63, part = e & 7;
      *(bf16x8*)(sW + (gate * 64 + d) * 72 + part * 8) = *(const bf16x8*)(WGT + ((size_t)((((layer * 2 + dir) * 2 + gate) * 8 + n) * 64 + d)) * 64 + part * 8); }
    if (tid < 16 * NTL) sCar[tid] = lat ? p.in[4][((sb * 2 + layer) * 2 + dir) * 512 + chb + cq + tid] : 0.f;
    float ba[NTL], bx[NTL], sp[NTL];
#pragma unroll
    for (int nt = 0; nt < NTL; ++nt) { const int dch = (layer * 2 + dir) * 512 + chb + cq + nt * 16 + lr; ba[nt] = p.in[26][dch]; bx[nt] = p.in[28][dch]; sp[nt] = -8.f * log1pf(expf(-p.in[29][dch])); }
    __syncthreads();
    bf16x8 xin[2][4];
    if (!(XC && dir == 1)) { const int pA = w * 16 + lr; const int tA = dir ? L - 1 - pA : pA;
#pragma unroll
      for (int ks = 0; ks < 2; ++ks)
#pragma unroll
        for (int j = 0; j < 4; ++j) { const int tt = min(max(tA + j - 1, 0), L - 1); xin[ks][j] = *(const bf16x8*)(U + (size_t)(m0 + tt) * DP + 1280 + chb + ks * 32 + g * 8); } }
#pragma unroll 1
    for (int ci = 0; ci < nch; ++ci) {
      const int par = ci & 1; const int pbase = ci * 128 + w * 16;
      const int pA = pbase + lr; const int tA = dir ? L - 1 - pA : pA;
      bf16x8 af[2];
      if (XC && dir == 1) {
#pragma unroll
        for (int ks = 0; ks < 2; ++ks) af[ks] = *(const bf16x8*)(sXc + tA * 72 + ks * 32 + g * 8);
      } else
#pragma unroll
      for (int ks = 0; ks < 2; ++ks) {
        const int cb = ks * 32 + g * 8; float a8[8];
#pragma unroll
        for (int i = 0; i < 8; ++i) a8[i] = sCw[256 + cb + i];
#pragma unroll
        for (int j = 0; j < 4; ++j) { const int tt = tA + j - 1; const float msk = (tt >= 0 && tt < L) ? 1.f : 0.f;
#pragma unroll
          for (int i = 0; i < 8; ++i) a8[i] += msk * bfs(xin[ks][j][i]) * sCw[j * 64 + cb + i]; }
        af[ks] = pk8(a8[0], a8[1], a8[2], a8[3], a8[4], a8[5], a8[6], a8[7]);
        if (XC) *(bf16x8*)(sXc + tA * 72 + cb) = af[ks];
        else {
#pragma unroll
          for (int i = 0; i < 8; ++i) sX[(w * 16 + lr) * 65 + cb + i] = a8[i]; }
      }
      if (ci + 1 < nch && !(XC && dir == 1)) { const int pN = pA + 128; const int tN = dir ? L - 1 - pN : pN;
#pragma unroll
        for (int ks = 0; ks < 2; ++ks)
#pragma unroll
          for (int j = 0; j < 4; ++j) { const int tt = min(max(tN + j - 1, 0), L - 1); xin[ks][j] = *(const bf16x8*)(U + (size_t)(m0 + tt) * DP + 1280 + chb + ks * 32 + g * 8); } }
      float Ap[NTL][4], Bp[NTL][4];
#pragma unroll
      for (int nt = 0; nt < NTL; ++nt) {
        f32x4 pr = (f32x4){0.f, 0.f, 0.f, 0.f}, pi = (f32x4){0.f, 0.f, 0.f, 0.f};
#pragma unroll
        for (int ks = 0; ks < 2; ++ks) { const bf16x8 wr_ = *(const bf16x8*)(sW + (cq + nt * 16 + lr) * 72 + ks * 32 + g * 8), wi_ = *(const bf16x8*)(sW + (64 + cq + nt * 16 + lr) * 72 + ks * 32 + g * 8);
          pr = mfma16(af[ks], wr_, pr); pi = mfma16(af[ks], wi_, pi); }
#pragma unroll
        for (int r = 0; r < 4; ++r) {
          float x;
          if (XC) { const int pq = pbase + 4 * g + r; const int tq = dir ? L - 1 - pq : pq; x = bf2f(sXc[tq * 72 + cq + nt * 16 + lr]); }
          else x = sX[(w * 16 + 4 * g + r) * 65 + cq + nt * 16 + lr];
          const float rr_ = sigm(pr[r] + ba[nt]), ii = sigm(pi[r] + bx[nt]);
          const float la = rr_ * sp[nt]; const float a = fexp(la); const float om = 1.f - a * a; const float b = __builtin_amdgcn_sqrtf(fmaxf(om, 0.f)) * ii * x;
          if (r == 0) { Ap[nt][0] = a; Bp[nt][0] = b; } else { Ap[nt][r] = a * Ap[nt][r - 1]; Bp[nt][r] = a * Bp[nt][r - 1] + b; }
        }
      }
      float EA[NTL], EB[NTL], TA[NTL], TB[NTL];
#pragma unroll
      for (int nt = 0; nt < NTL; ++nt) { EA[nt] = 1.f; EB[nt] = 0.f; TA[nt] = 1.f; TB[nt] = 0.f;
#pragma unroll
        for (int k = 0; k < 4; ++k) { const float ak = __int_as_float(__builtin_amdgcn_ds_bpermute((lr + 16 * k) * 4, __float_as_int(Ap[nt][3]))), bk = __int_as_float(__builtin_amdgcn_ds_bpermute((lr + 16 * k) * 4, __float_as_int(Bp[nt][3])));
          if (k < g) { EB[nt] = ak * EB[nt] + bk; EA[nt] = ak * EA[nt]; }
          TB[nt] = ak * TB[nt] + bk; TA[nt] = ak * TA[nt]; }
        if (g == 0) { sTot[((par * 8 + w) * 2 + 0) * 64 + nt * 16 + lr] = TA[nt]; sTot[((par * 8 + w) * 2 + 1) * 64 + nt * 16 + lr] = TB[nt]; } }
      float yv[NTL][4]; u16 gl[NTL][4];
      if (dir == 1) {
#pragma unroll
        for (int nt = 0; nt < NTL; ++nt)
#pragma unroll
          for (int r = 0; r < 4; ++r) { const int pp = pbase + 4 * g + r; const int t = L - 1 - pp;
            yv[nt][r] = sYf[t * YS + nt * 16 + lr]; gl[nt][r] = U[(size_t)(m0 + t) * DP + 1792 + chb + cq + nt * 16 + lr]; } }
      __syncthreads();
#pragma unroll
      for (int nt = 0; nt < NTL; ++nt) {
        float hin = sCar[par * 64 + nt * 16 + lr];
        float ak7[7], bk7[7];
#pragma unroll
        for (int k = 0; k < 7; ++k) { ak7[k] = sTot[((par * 8 + k) * 2 + 0) * 64 + nt * 16 + lr]; bk7[k] = sTot[((par * 8 + k) * 2 + 1) * 64 + nt * 16 + lr]; }
#pragma unroll
        for (int k = 0; k < 7; ++k) { const float tnew = ak7[k] * hin + bk7[k]; hin = (k < w) ? tnew : hin; }
        if (w == 7 && g == 0) sCar[(par ^ 1) * 64 + nt * 16 + lr] = TA[nt] * hin + TB[nt];
        const float hg = EA[nt] * hin + EB[nt];
        const int dch = chb + cq + nt * 16 + lr;
#pragma unroll
        for (int r = 0; r < 4; ++r) {
          const float hv = Ap[nt][r] * hg + Bp[nt][r];
          const int pp = pbase + 4 * g + r; const int t = dir ? L - 1 - pp : pp;
          if (dir == 0) sYf[t * YS + nt * 16 + lr] = hv;
          else MIX[(size_t)(m0 + t) * DMIX + 1024 + dch] = f2bf((yv[nt][r] + hv) * siluf(bf2f(gl[nt][r])));
          if (!lat && pp == L - 1) p.out[(size_t)OUT_LRU + ((sb * 2 + layer) * 2 + dir) * 512 + dch] = hv;
        }
      }
    }
  }
  __syncthreads();
}

__device__ void mixers_phase(const P& p, int layer, char* smem, int rep = 0) {
  __shared__ int s_item;
  int* cnt = (int*)(p.ws + WS_CNT) + layer + 2 * rep;
  if (otid() == 0) s_item = atomicAdd(cnt, 1);
  __syncthreads();
  int it = s_item;
  __syncthreads();
  while (it < 1024) {
    int nxt = 0;
    if (otid() == 0) nxt = atomicAdd(cnt, 1);
    if (it < 64) { for (int r = 0; r < REP_LRU; ++r) lru_item<1>(p, layer, 1, it >> 5, (it >> 2) & 7, it & 3, smem); }
    else if (it < 128) { const int i = it - 64; for (int r = 0; r < REP_HY; ++r) hyena_item<1024, 2, 1>(p, layer, MCTX, i * 8, smem); }
    else if (it < 256) { const int i = it - 128; for (int r = 0; r < REP_AT; ++r) attn_item(p, layer, 1, i >> 6, (i >> 3) & 7, i & 7, smem); }
    else if (it < 512) { const int i = it - 256; for (int r = 0; r < REP_HY; ++r) hyena_item<256, 8, 2>(p, layer, (i >> 6) * 2048, (i & 63) * 8, smem); }
    else if (it < 768) { const int i = it - 512; for (int r = 0; r < REP_LRU; ++r) lru_item<4>(p, layer, 0, i >> 3, i & 7, 0, smem); }
    else { const int i = it - 768; for (int r = 0; r < REP_AT; ++r) attn_ctx_item(p, layer, i >> 3, (i >> 2) & 1, i & 3, smem); }
    if (otid() == 0) s_item = nxt;
    __syncthreads();
    it = s_item;
    __syncthreads();
  }
}

#define XB_TMO      128
#define XB_XCNT(j)  (256  + 64 * (j))
#define XB_XSUB(j)  (1280 + 64 * (j))
#define XB_XGEN(j)  (2304 + 64 * (j))
#define XB_TOP      3328
#define XB_TOPGEN   3392
#define XCD_BAR_WORDS 3456
#define XB_SPIN_CAP (1u << 18)
#define LAS __attribute__((address_space(3)))

__device__ __forceinline__ unsigned xb_ld(unsigned* p)              { return __hip_atomic_load(p, __ATOMIC_RELAXED, __HIP_MEMORY_SCOPE_AGENT); }
__device__ __forceinline__ unsigned xb_add(unsigned* p, unsigned v) { return __hip_atomic_fetch_add(p, v, __ATOMIC_RELAXED, __HIP_MEMORY_SCOPE_AGENT); }
__device__ __forceinline__ unsigned xb_xcc_id() { return (unsigned)__builtin_amdgcn_s_getreg((3 << 11) | 20) & 0xFu; }
#define XB_SPIN(cond, bar) do { unsigned _sp = 0; while (cond) { __builtin_amdgcn_s_sleep(1); \
    if ((++_sp & 255u) == 0u) { if (xb_ld(&(bar)[XB_TMO])) break; if (_sp > XB_SPIN_CAP) { atomicAdd(&(bar)[XB_TMO], 1u); break; } } } } while (0)

struct XcdBarrier {
    unsigned* bar; unsigned x;
    volatile LAS unsigned* st;
};

__device__ __forceinline__ XcdBarrier xcd_barrier_post(unsigned* bar, volatile LAS unsigned* st) {
    XcdBarrier b; b.bar = bar; b.x = xb_xcc_id(); b.st = st;
    if (threadIdx.x == 0) (void)xb_add(&bar[XB_XCNT(b.x)], 1u);
    return b;
}
__device__ __forceinline__ void xcd_barrier_complete(unsigned* bar, unsigned x, unsigned& nloc, unsigned& nx) {
    const unsigned G = gridDim.x * gridDim.y * gridDim.z;
    unsigned sum, cnt, mine, sp = 0u;
    for (;;) {
        sum = 0u; cnt = 0u; mine = 0u;
#pragma unroll
        for (unsigned j = 0; j < 16; ++j) { const unsigned c = xb_ld(&bar[XB_XCNT(j)]); sum += c; cnt += (c > 0u) ? 1u : 0u; mine = (j == x) ? c : mine; }
        if (sum == G) break;
        __builtin_amdgcn_s_sleep(1);
        if ((++sp & 255u) == 0u) { if (xb_ld(&bar[XB_TMO])) break; if (sp > XB_SPIN_CAP) { atomicAdd(&bar[XB_TMO], 1u); break; } }
    }
    nloc = mine > 0u ? mine : 1u; nx = cnt > 0u ? cnt : 1u;
}

__device__ __forceinline__ void xcd_barrier(const XcdBarrier& b) {
    asm volatile("s_waitcnt vmcnt(0)" ::: "memory");
    __syncthreads();
    if (threadIdx.x == 0) {
        unsigned* bar = b.bar;
        __builtin_amdgcn_s_waitcnt(0);
        unsigned nloc = b.st[0], nx = b.st[1];
        if (nloc == 0u) { xcd_barrier_complete(bar, b.x, nloc, nx); b.st[0] = nloc; b.st[1] = nx; }
        const unsigned old = xb_add(&bar[XB_XSUB(b.x)], 1u);
        const unsigned gen = old / nloc;
        if (old + 1u == (gen + 1u) * nloc) {
            __builtin_amdgcn_fence(__ATOMIC_RELEASE, "agent");
            asm volatile("s_waitcnt vmcnt(0)" ::: "memory");
            const unsigned og = xb_add(&bar[XB_TOP], 1u);
            const unsigned tg = og / nx;
            if (og + 1u == (tg + 1u) * nx) xb_add(&bar[XB_TOPGEN], 1u);
            else XB_SPIN(xb_ld(&bar[XB_TOPGEN]) == tg, bar);
            __builtin_amdgcn_fence(__ATOMIC_ACQUIRE, "agent");
            xb_add(&bar[XB_XGEN(b.x)], 1u);
            asm volatile("s_waitcnt vmcnt(0)" ::: "memory");
        } else {
            XB_SPIN(xb_ld(&bar[XB_XGEN(b.x)]) == gen, bar);
            __builtin_amdgcn_fence(__ATOMIC_ACQUIRE, "agent");
            asm volatile("s_waitcnt vmcnt(0)" ::: "memory");
        }
    }
    __syncthreads();
}


#ifndef MULTI
#define MULTI 0
#endif
#ifndef REP_NORM
#define REP_NORM 1
#endif
#ifndef REP_G0
#define REP_G0 1
#endif
#ifndef REP_MIX
#define REP_MIX 1
#endif
#ifndef REP_P0
#define REP_P0 1
#endif
#if MULTI
#ifndef XK
#define XK -1
#endif
#ifndef XN
#define XN 0
#endif
__global__ void __launch_bounds__(NT) k_phase0(P p) { extern __shared__ __attribute__((aligned(16))) char smem[]; phase0(p, smem); }
__global__ void __launch_bounds__(NT) k_prep1(P p) { extern __shared__ __attribute__((aligned(16))) char smem[]; phase0_items<1, 2>(p, smem); }
__global__ void __launch_bounds__(NT) k_norm(P p, int layer) { norm_phase(p, layer); }
__global__ void __launch_bounds__(NT) k_gemm0(P p, int layer) { extern __shared__ __attribute__((aligned(16))) char smem[]; gemm_phase<0>(p, layer, smem); }
__global__ void __launch_bounds__(NT) k_gemm1(P p, int layer) { extern __shared__ __attribute__((aligned(16))) char smem[]; gemm_phase<1>(p, layer, smem); }
__global__ void __launch_bounds__(NT) k_hy_lat(P p, int layer) { extern __shared__ __attribute__((aligned(16))) char smem[];
  for (int it = blockIdx.x; it < 64; it += gridDim.x) hyena_item<1024, 2, 1>(p, layer, MCTX, it * 8, smem); }
__global__ void __launch_bounds__(NT) k_hy_ctx(P p, int layer) { extern __shared__ __attribute__((aligned(16))) char smem[];
  for (int i = blockIdx.x; i < 256; i += gridDim.x) hyena_item<256, 8, 2>(p, layer, (i >> 6) * 2048, (i & 63) * 8, smem); }
__global__ void __launch_bounds__(NT) k_attn_lat(P p, int layer) { extern __shared__ __attribute__((aligned(16))) char smem[];
  for (int it = blockIdx.x; it < 128; it += gridDim.x) attn_item(p, layer, 1, it >> 6, (it >> 3) & 7, it & 7, smem); }
__global__ void __launch_bounds__(NT) k_attn_ctx(P p, int layer) { extern __shared__ __attribute__((aligned(16))) char smem[];
  for (int i = blockIdx.x; i < 256; i += gridDim.x) attn_ctx_item(p, layer, i >> 3, (i >> 2) & 1, i & 3, smem); }
__global__ void __launch_bounds__(NT) k_lru_lat(P p, int layer) { extern __shared__ __attribute__((aligned(16))) char smem[];
  for (int it = blockIdx.x; it < 64; it += gridDim.x) lru_item<1>(p, layer, 1, it >> 5, (it >> 2) & 7, it & 3, smem); }
__global__ void __launch_bounds__(NT) k_lru_ctx(P p, int layer) { extern __shared__ __attribute__((aligned(16))) char smem[];
  for (int i = blockIdx.x; i < 256; i += gridDim.x) lru_item<4>(p, layer, 0, i >> 3, i & 7, 0, smem); }
#else
__global__ void __launch_bounds__(NT) mega(P p) {
  extern __shared__ __attribute__((aligned(16))) char smem[];
  __shared__ uint4 xb_words;
  cg::grid_group grid = cg::this_grid();
  if (threadIdx.x == 0) xb_words = make_uint4(0u, 0u, 0u, 0u);
  __syncthreads();
  (void)xcd_barrier_post((unsigned*)(p.ws + WS_BAR), (volatile LAS unsigned*)&xb_words);
#define GRID_BAR() do { XcdBarrier xb_; xb_.bar = (unsigned*)(p.ws + WS_BAR); xb_.x = xb_xcc_id(); xb_.st = (volatile LAS unsigned*)&xb_words; xcd_barrier(xb_); } while (0)
  phase0(p, smem);
  if (p.ws == nullptr) grid.sync();
  GRID_BAR();
#pragma unroll 1
  for (int layer_ = 0; layer_ < 2; ++layer_) {
    const int layer = osgpr(layer_);
#pragma unroll 1
    for (int rep = 0; rep < REP_NORM; ++rep) { norm_phase(p, osgpr(layer)); GRID_BAR(); }
    gemm_phase<0>(p, osgpr(layer), smem);
    if (layer == 0 && ((int)gridDim.x <= 168 || (int)blockIdx.x >= 168)) phase0_items<0, 1>(p, smem);
    GRID_BAR();
#pragma unroll 1
    for (int rep = 0; rep < REP_MIX; ++rep) { mixers_phase(p, osgpr(layer), smem, osgpr(rep)); GRID_BAR(); }
    gemm_phase<1>(p, osgpr(layer), smem);
    if (layer == 0 && ((int)gridDim.x <= 160 || (int)blockIdx.x >= 160)) phase0_items<1, 2>(p, smem);
    GRID_BAR();
  }
  norm_phase(p, 2);
}
#endif

extern "C" void kernel_launch(void* const* d_in, const int* in_sizes, int n_in, void* d_out, int out_size, void* d_ws, size_t ws_size, hipStream_t stream) {
  static int grid = 0;
  if (grid == 0) {
    if (n_in != 32 || ws_size < WS_END) { fprintf(stderr, "kernel_launch: unexpected n_in %d / ws %zu (need %zu)\n", n_in, ws_size, (size_t)WS_END); grid = -1; return; }
    int dev = 0, cus = 0, per_cu = 0;
    (void)hipGetDevice(&dev);
    (void)hipDeviceGetAttribute(&cus, hipDeviceAttributeMultiprocessorCount, dev);
#if MULTI
    const void* ks[] = {(const void*)k_phase0, (const void*)k_prep1, (const void*)k_gemm0, (const void*)k_gemm1, (const void*)k_hy_lat, (const void*)k_hy_ctx, (const void*)k_attn_lat, (const void*)k_attn_ctx, (const void*)k_lru_lat, (const void*)k_lru_ctx};
    for (int i = 0; i < 10; ++i) if (hipFuncSetAttribute(ks[i], hipFuncAttributeMaxDynamicSharedMemorySize, LDS_BYTES) != hipSuccess) { fprintf(stderr, "hipFuncSetAttribute failed\n"); grid = -1; return; }
    (void)per_cu;
#else
    if (hipFuncSetAttribute((const void*)mega, hipFuncAttributeMaxDynamicSharedMemorySize, LDS_BYTES) != hipSuccess) { fprintf(stderr, "hipFuncSetAttribute failed\n"); grid = -1; return; }
    if (hipOccupancyMaxActiveBlocksPerMultiprocessor(&per_cu, (const void*)mega, NT, LDS_BYTES) != hipSuccess || per_cu < 1) { fprintf(stderr, "occupancy query failed (%d)\n", per_cu); grid = -1; return; }
#endif
    grid = cus;
  }
  if (grid < 0) return;
  (void)hipMemsetAsync((char*)d_ws + WS_CNT, 0, 256 + 13824, stream);
  P prm{};
  for (int i = 0; i < 32; ++i) prm.in[i] = (const float*)d_in[i];
  prm.out = (float*)d_out; prm.ws = (char*)d_ws;
#if MULTI
  k_phase0<<<grid, NT, LDS_BYTES, stream>>>(prm);
  k_prep1<<<grid, NT, LDS_BYTES, stream>>>(prm);
  for (int layer = 0; layer < 2; ++layer) {
    for (int x = 0; x < 1 + (XK == 0 ? XN : 0); ++x) k_norm<<<grid, NT, 0, stream>>>(prm, layer);
    for (int x = 0; x < 1 + (XK == 1 ? XN : 0); ++x) k_gemm0<<<grid, NT, LDS_BYTES, stream>>>(prm, layer);
    for (int x = 0; x < 1 + (XK == 2 ? XN : 0); ++x) k_hy_lat<<<64, NT, LDS_BYTES, stream>>>(prm, layer);
    for (int x = 0; x < 1 + (XK == 3 ? XN : 0); ++x) k_hy_ctx<<<grid, NT, LDS_BYTES, stream>>>(prm, layer);
    for (int x = 0; x < 1 + (XK == 4 ? XN : 0); ++x) k_attn_lat<<<grid, NT, LDS_BYTES, stream>>>(prm, layer);
    for (int x = 0; x < 1 + (XK == 5 ? XN : 0); ++x) k_attn_ctx<<<grid, NT, LDS_BYTES, stream>>>(prm, layer);
    for (int x = 0; x < 1 + (XK == 6 ? XN : 0); ++x) k_lru_lat<<<64, NT, LDS_BYTES, stream>>>(prm, layer);
    for (int x = 0; x < 1 + (XK == 7 ? XN : 0); ++x) k_lru_ctx<<<grid, NT, LDS_BYTES, stream>>>(prm, layer);
    k_gemm1<<<grid, NT, LDS_BYTES, stream>>>(prm, layer);
  }
  k_norm<<<grid, NT, 0, stream>>>(prm, 2);
#else
  void* args[] = {&prm};
  hipError_t e = hipLaunchCooperativeKernel((const void*)mega, dim3(grid), dim3(NT), args, LDS_BYTES, stream);
  if (e != hipSuccess) fprintf(stderr, "cooperative launch failed: %s (grid %d)\n", hipGetErrorString(e), grid);
#endif
}
```

```cpp
#include <hip/hip_runtime.h>
#include <hip/hip_bf16.h>
#include <hip/hip_cooperative_groups.h>
#include <cstdio>
namespace cg = cooperative_groups;

#ifndef REP_HY
#define REP_HY 1
#endif
#ifndef REP_AT
#define REP_AT 1
#endif
#ifndef REP_LRU
#define REP_LRU 1
#endif
typedef unsigned short u16;
using bf16x8 = __attribute__((ext_vector_type(8))) short;
using bf16x4 = __attribute__((ext_vector_type(4))) short;
using f32x4 = __attribute__((ext_vector_type(4))) float;

#define NT 512
constexpr int MROWS = 10240, MCTX = 8192, DM = 1024, DP = 2336  , DMIX = 1536;
constexpr int LDS_BYTES = 131072 + 8192;
constexpr int OUT_YS = 8388608, OUT_K = 10485760, OUT_V = 12582912, OUT_LRU = 14680064;

constexpr size_t WS_WTIN = 0;
constexpr size_t WS_WTOUT = WS_WTIN + (size_t)2 * 4352 * 1024 * 2;
constexpr size_t WS_WGT = WS_WTOUT + (size_t)2 * 1024 * 1536 * 2;
constexpr size_t WS_MOD = WS_WGT + (size_t)2 * 2 * 2 * 8 * 64 * 64 * 2;
constexpr size_t WS_ROPE = WS_MOD + (size_t)2 * 3 * 3072 * 4;
constexpr size_t WS_HF = WS_ROPE + 8192;
constexpr int HFS = 1040;
constexpr size_t HF_LSTRIDE = (size_t)1280 * HFS;
constexpr size_t WS_NP = WS_HF + 2 * HF_LSTRIDE * 4;
constexpr size_t WS_CNT = WS_NP + (size_t)2 * 2 * 32 * 1024 * 4;
constexpr size_t WS_BAR = WS_CNT + 256;
constexpr size_t WS_H = WS_BAR + 13824;
constexpr size_t WS_U = WS_H + (size_t)MROWS * 1024 * 2;
constexpr size_t WS_UH = WS_U + (size_t)MROWS * DP * 2;
constexpr size_t WS_KC = WS_UH + (size_t)256 * MROWS * 8 * 2;
constexpr size_t WS_VC = WS_KC + (size_t)32 * 2 * 256 * 64 * 2;
constexpr size_t WS_KL = WS_VC + (size_t)32 * 2 * 256 * 64 * 2;
constexpr size_t WS_VL = WS_KL + (size_t)2 * 2 * 2 * 1536 * 64 * 2;
constexpr size_t WS_MIX = WS_VL + (size_t)2 * 2 * 2 * 1536 * 64 * 2;
constexpr size_t WS_X = WS_MIX + (size_t)MROWS * DMIX * 2;
constexpr size_t WS_END = WS_X + (size_t)MROWS * 1024 * 4;

struct P { const float* in[32]; float* out; char* ws; };

__device__ __forceinline__ u16 f2bf(float f) { unsigned u = __float_as_uint(f); u += 0x7fffu + ((u >> 16) & 1u); return (u16)(u >> 16); }
__device__ __forceinline__ unsigned cvtpk(float lo, float hi) { unsigned r; asm("v_cvt_pk_bf16_f32 %0, %1, %2" : "=v"(r) : "v"(lo), "v"(hi)); return r; }
__device__ __forceinline__ bf16x4 pk4(float a, float b, float c, float d) { typedef unsigned u32x2 __attribute__((ext_vector_type(2))); u32x2 t; t.x = cvtpk(a, b); t.y = cvtpk(c, d); return __builtin_bit_cast(bf16x4, t); }
__device__ __forceinline__ bf16x8 pk8(float a, float b, float c, float d, float e, float f, float g, float h) { typedef unsigned u32x4_ __attribute__((ext_vector_type(4))); u32x4_ t; t.x = cvtpk(a, b); t.y = cvtpk(c, d); t.z = cvtpk(e, f); t.w = cvtpk(g, h); return __builtin_bit_cast(bf16x8, t); }
__device__ __forceinline__ float bf2f(u16 h) { return __uint_as_float(((unsigned)h) << 16); }
__device__ __forceinline__ float bfs(short h) { return __uint_as_float(((unsigned)(u16)h) << 16); }
__device__ __forceinline__ float fexp(float x) { return __expf(x); }
__device__ __forceinline__ float siluf(float x) { return x * __builtin_amdgcn_rcpf(1.f + fexp(-x)); }
__device__ __forceinline__ float sigm(float x) { return __builtin_amdgcn_rcpf(1.f + fexp(-x)); }

__device__ __forceinline__ int otid() { int t; asm volatile("v_mov_b32 %0, %1" : "=v"(t) : "v"((int)threadIdx.x)); return t; }
__device__ __forceinline__ int osgpr(int x) { asm volatile("" : "+s"(x)); return x; }
__device__ void p0_filter(const P& p, char* smem, int it) {
  const int l = it / 40, r = it % 40; const int sel = r >= 8; const int chunk = sel ? r - 8 : r;
  const int L = sel ? 1024 : 256;
  float* feats = (float*)smem;
  float* h1 = feats + 32 * 36;
  float* h2 = h1 + 32 * 64;
  const int tid = otid();
  const float* w1 = p.in[15] + l * 33 * 64; const float* b1 = p.in[16] + l * 64;
  const float* w2 = p.in[17] + l * 64 * 64; const float* b2 = p.in[18] + l * 64;
  const float* w3 = p.in[19] + l * 64 * 1024; const float* fq = p.in[20] + l * 128; const float* dec = p.in[21] + l * 1024;
  const int c0 = tid;
  float wq[2][64];
#pragma unroll
  for (int j = 0; j < 64; ++j) { wq[0][j] = w3[j * 1024 + c0]; wq[1][j] = w3[j * 1024 + 512 + c0]; }
  for (int e = tid; e < 32 * 33; e += NT) {
    int tt = e / 33, j = e % 33; int t = chunk * 32 + tt; float v;
    if (j == 0) v = (float)t / (float)(L - 1);
    else { int i = (j - 1) & 15; float f = 1e-4f + (float)i * ((15.0f - 1e-4f) / 15.0f);
      float w = 6.283185307179586f * (float)t / (float)L; float a = f * w; v = (j <= 16) ? __cosf(a) : -__sinf(a); }
    feats[tt * 36 + j] = v;
  }
  __syncthreads();
  { const int j = tid & 63, tq = tid >> 6; float acc[4];
#pragma unroll
    for (int i = 0; i < 4; ++i) acc[i] = b1[j];
    float wcol[33];
#pragma unroll
    for (int e = 0; e < 33; ++e) wcol[e] = w1[e * 64 + j];
#pragma unroll
    for (int e = 0; e < 33; ++e) {
#pragma unroll
      for (int i = 0; i < 4; ++i) acc[i] += feats[(tq * 4 + i) * 36 + e] * wcol[e]; }
    float f0 = fq[j];
#pragma unroll
    for (int i = 0; i < 4; ++i) h1[(tq * 4 + i) * 64 + j] = __sinf(f0 * acc[i]); }
  __syncthreads();
  { const int j = tid & 63, tq = tid >> 6; float acc[4];
#pragma unroll
    for (int i = 0; i < 4; ++i) acc[i] = b2[j];
    float wcol[64];
#pragma unroll
    for (int e = 0; e < 64; ++e) wcol[e] = w2[e * 64 + j];
#pragma unroll
    for (int e = 0; e < 64; ++e) {
#pragma unroll
      for (int i = 0; i < 4; ++i) acc[i] += h1[(tq * 4 + i) * 64 + e] * wcol[e]; }
    float f1 = fq[64 + j];
#pragma unroll
    for (int i = 0; i < 4; ++i) h2[(tq * 4 + i) * 64 + j] = __sinf(f1 * acc[i]); }
  __syncthreads();
  float* HF = (float*)(p.ws + WS_HF) + (size_t)l * HF_LSTRIDE + (sel ? 256 * HFS : 0);
  float* NP = (float*)(p.ws + WS_NP) + ((l * 2 + sel) * 32 + chunk) * 1024;
  { const float d0 = dec[c0], d1 = dec[512 + c0]; float as0 = 0.f, as1 = 0.f;
#pragma unroll 1
    for (int tt = 0; tt < 32; ++tt) {
      float a0 = 0.f, a1 = 0.f;
#pragma unroll
      for (int j4 = 0; j4 < 16; ++j4) { const float4 hv = *(const float4*)(h2 + tt * 64 + j4 * 4);
        a0 += hv.x * wq[0][j4 * 4] + hv.y * wq[0][j4 * 4 + 1] + hv.z * wq[0][j4 * 4 + 2] + hv.w * wq[0][j4 * 4 + 3];
        a1 += hv.x * wq[1][j4 * 4] + hv.y * wq[1][j4 * 4 + 1] + hv.z * wq[1][j4 * 4 + 2] + hv.w * wq[1][j4 * 4 + 3]; }
      const int t = chunk * 32 + tt; const float tv = (float)t / (float)(L - 1);
      const float v0 = a0 * expf(-tv * d0), v1 = a1 * expf(-tv * d1);
      HF[(size_t)t * HFS + c0] = v0; HF[(size_t)t * HFS + 512 + c0] = v1;
      as0 += fabsf(v0); if (t != 0) as1 += fabsf(v1);
    }
    NP[c0] = as0; NP[512 + c0] = as1;
  }
  __syncthreads();
}

__device__ void p0_adaln(const P& p, char* smem, int it) {
  const int l = it / 96, j0 = (it % 96) * 32; const int tid = otid();
  float* ss = (float*)smem;
  float* red = ss + 3072;
  for (int e = tid; e < 3072; e += NT) { int cv = e >> 10, k = e & 1023; float x = cv == 0 ? p.in[6][k] : p.in[5][(cv - 1) * 1024 + k]; ss[e] = x / (1.f + expf(-x)); }
  __syncthreads();
  const int c = tid & 31, kg = tid >> 5;
  const float* W = p.in[8] + (size_t)l * 1024 * 3072 + j0 + c;
  float a0 = 0.f, a1 = 0.f, a2 = 0.f;
#pragma unroll 32
  for (int k = kg * 64; k < kg * 64 + 64; ++k) { float w = __builtin_nontemporal_load(W + (size_t)k * 3072); a0 += ss[k] * w; a1 += ss[1024 + k] * w; a2 += ss[2048 + k] * w; }
  red[(kg * 3 + 0) * 32 + c] = a0; red[(kg * 3 + 1) * 32 + c] = a1; red[(kg * 3 + 2) * 32 + c] = a2;
  __syncthreads();
  if (tid < 96) { int cv = tid >> 5, cc = tid & 31; float s = p.in[9][l * 3072 + j0 + cc];
    for (int k = 0; k < 16; ++k) s += red[(k * 3 + cv) * 32 + cc];
    ((float*)(p.ws + WS_MOD))[(l * 3 + cv) * 3072 + j0 + cc] = s; }
  __syncthreads();
}

__device__ void p0_transpose(const float* src, u16* dst, int K, int N, int kt, int nt, char* smem) {
  float* T = (float*)smem;
  const int tid = otid(); const int r = tid >> 6, c4 = (tid & 63) * 4;
  float4 v[8];
#pragma unroll
  for (int h = 0; h < 8; ++h) { const f32x4 t = __builtin_nontemporal_load((const f32x4*)(src + (size_t)(kt * 64 + r + h * 8) * N + nt * 256 + c4)); v[h] = make_float4(t[0], t[1], t[2], t[3]); }
#pragma unroll
  for (int h = 0; h < 8; ++h) { float* tp = T + (r + h * 8) * 257 + c4; tp[0] = v[h].x; tp[1] = v[h].y; tp[2] = v[h].z; tp[3] = v[h].w; }
  __syncthreads();
  const int n = tid >> 1, kh = (tid & 1) * 32;
#pragma unroll
  for (int q = 0; q < 4; ++q) { bf16x8 o;
#pragma unroll
    for (int i = 0; i < 8; ++i) o[i] = (short)f2bf(T[(kh + q * 8 + i) * 257 + n]);
    *(bf16x8*)(dst + (size_t)(nt * 256 + n) * K + kt * 64 + kh + q * 8) = o; }
  __syncthreads();
}

template <int l, int part>
__device__ void phase0_items(const P& p, char* smem) {
  __shared__ int s_it0;
  int* cnt = (int*)(p.ws + WS_CNT) + 8 + l * 4 + part;
  const int n_fil = part == 0 ? 0 : 40, n_ada = part == 1 ? 0 : 96, n_win = part == 1 ? 0 : 272, n_wout = part == 0 ? 0 : 96;
  for (;;) {
    if (otid() == 0) s_it0 = atomicAdd(cnt, 1);
    __syncthreads();
    int it = s_it0;
    __syncthreads();
    if (it >= n_fil + n_ada + n_win + n_wout) break;
    if (n_fil > 0 && it < n_fil) { p0_filter(p, smem, l * 40 + it); continue; }
    it -= n_fil;
    if (n_ada > 0 && it < n_ada) { p0_adaln(p, smem, l * 96 + it); continue; }
    it -= n_ada;
    if (n_win > 0 && it < n_win) { const int nt = it / 16, kt = it % 16;
      p0_transpose(p.in[10] + (size_t)l * 1024 * 4352, (u16*)(p.ws + WS_WTIN) + (size_t)l * 4352 * 1024, 1024, 4352, kt, nt, smem); continue; }
    it -= n_win;
    if (n_wout > 0) { const int nt = it / 24, kt = it % 24;
      p0_transpose(p.in[30] + (size_t)l * 1536 * 1024, (u16*)(p.ws + WS_WTOUT) + (size_t)l * 1024 * 1536, 1536, 1024, kt, nt, smem); }
  }
}

__device__ void phase0(const P& p, char* smem) {
  const int G = gridDim.x;
  phase0_items<0, 0>(p, smem);
  const int gt = blockIdx.x * NT + otid(), gn = G * NT;
  u16* KL = (u16*)(p.ws + WS_KL); u16* VL = (u16*)(p.ws + WS_VL);
  for (int idx = gt; idx < 2 * 2 * 2 * 512 * 64; idx += gn) {
    int d = idx & 63, pp = (idx >> 6) & 511, kvh = (idx >> 15) & 1, b = (idx >> 16) & 1, l = idx >> 17;
    size_t src = ((((size_t)b * 2 + l) * 512 + pp) * 2 + kvh) * 64 + d;
    KL[((size_t)((l * 2 + b) * 2 + kvh) * 1536 + pp) * 64 + d] = f2bf(p.in[2][src]);
    VL[((size_t)((l * 2 + b) * 2 + kvh) * 64 + d) * 1536 + pp] = f2bf(p.in[3][src]);
  }
  float* rope = (float*)(p.ws + WS_ROPE);
  for (int idx = gt; idx < 1024; idx += gn) { int pos = idx >> 4, fi = idx & 15; float inv = powf(10000.0f, -(float)fi / 16.0f); float a = (float)pos * inv;
    rope[idx * 2] = cosf(a); rope[idx * 2 + 1] = sinf(a); }
  u16* WGT = (u16*)(p.ws + WS_WGT);
  for (int idx = gt; idx < 2 * 2 * 2 * 8 * 64 * 64; idx += gn) {
    int c = idx & 63, d = (idx >> 6) & 63, n = (idx >> 12) & 7, gate = (idx >> 15) & 1, dir = (idx >> 16) & 1, l = idx >> 17;
    const float* src = gate ? p.in[27] : p.in[25];
    WGT[idx] = f2bf(src[((size_t)((l * 2 + dir) * 8 + n) * 64 + c) * 64 + d]);
  }
}

__device__ void norm_phase(const P& p, int layer) {
  const int wave = otid() >> 6, lane = otid() & 63;
  const float* X = (const float*)(p.ws + WS_X);
  u16* H = (u16*)(p.ws + WS_H);
  const int stride = gridDim.x * 8;
  int row = blockIdx.x * 8 + wave;
  float4 vn[4];
  if (row < MROWS) { const float* x = layer == 0 ? (row < MCTX ? p.in[0] + (size_t)row * 1024 : p.in[1] + (size_t)(row - MCTX) * 1024) : X + (size_t)row * 1024;
#pragma unroll
    for (int i = 0; i < 4; ++i) vn[i] = *(const float4*)(x + i * 256 + lane * 4); }
  for (; row < MROWS; row += stride) {
    float4 v[4]; float ss = 0.f;
#pragma unroll
    for (int i = 0; i < 4; ++i) { v[i] = vn[i]; ss += v[i].x * v[i].x + v[i].y * v[i].y + v[i].z * v[i].z + v[i].w * v[i].w; }
    { const int rn = row + stride;
      if (rn < MROWS) { const float* x = layer == 0 ? (rn < MCTX ? p.in[0] + (size_t)rn * 1024 : p.in[1] + (size_t)(rn - MCTX) * 1024) : X + (size_t)rn * 1024;
#pragma unroll
        for (int i = 0; i < 4; ++i) vn[i] = *(const float4*)(x + i * 256 + lane * 4); } }
#pragma unroll
    for (int o = 32; o >= 1; o >>= 1) ss += __shfl_xor(ss, o);
    const float rstd = rsqrtf(ss * (1.f / 1024.f) + 1e-6f);
    if (layer < 2) {
      const int cv = row < MCTX ? 0 : 1 + ((row - MCTX) >> 10);
      const float* md = (const float*)(p.ws + WS_MOD) + (layer * 3 + cv) * 3072;
      const float* g = p.in[7] + layer * 1024;
#pragma unroll
      for (int i = 0; i < 4; ++i) { const int k = i * 256 + lane * 4;
        float4 g4 = *(const float4*)(g + k), sh = *(const float4*)(md + k), sc = *(const float4*)(md + 1024 + k);
        *(bf16x4*)(H + (size_t)row * 1024 + k) = pk4(v[i].x * rstd * g4.x * (1.f + sc.x) + sh.x, v[i].y * rstd * g4.y * (1.f + sc.y) + sh.y,
                                                     v[i].z * rstd * g4.z * (1.f + sc.z) + sh.z, v[i].w * rstd * g4.w * (1.f + sc.w) + sh.w); }
    } else {
      float* o = p.out + (row < MCTX ? (size_t)row * 1024 : (size_t)OUT_YS + (size_t)(row - MCTX) * 1024);
      const float* g = p.in[31];
#pragma unroll
      for (int i = 0; i < 4; ++i) { const int k = i * 256 + lane * 4; float4 g4 = *(const float4*)(g + k); float4 r;
        r.x = v[i].x * rstd * g4.x; r.y = v[i].y * rstd * g4.y; r.z = v[i].z * rstd * g4.z; r.w = v[i].w * rstd * g4.w;
        *(float4*)(o + k) = r; }
    }
  }
}

namespace pg8 {
#define PG8_LAS __attribute__((address_space(3)))
typedef unsigned short bf16_t;
typedef short bf16x8 __attribute__((ext_vector_type(8)));
typedef float f32x4 __attribute__((ext_vector_type(4)));
typedef unsigned u32x4 __attribute__((ext_vector_type(4)));
constexpr int BM = 256, BK = 64, HALF = 128, HTB = HALF * BK * 2  , STAGE_BYTES = 8 * HTB, NXCD = 8, WGM = 8;

__host__ __device__ __forceinline__ int lds_byte(int r, int c) { const int st = (r >> 4) * 2 + (c >> 5), rr = r & 15, cc = c & 31, ob = rr * 64 + cc * 2; return st * 1024 + (ob ^ (((ob >> 9) & 1) << 5)); }
__host__ __device__ __forceinline__ void stage_rc(int b, int& R, int& C) { const int st = b / 1024, sb = b % 1024, swz = sb ^ (((sb >> 9) & 1) << 5); R = (st >> 1) * 16 + swz / 64; C = (st & 1) * 32 + (swz % 64) / 2; }
__host__ __device__ __forceinline__ int perm32(int rho) { const int n = rho >> 4, i = rho & 15; return 8 * (i >> 2) + 4 * n + (i & 3); }

struct Unit { int pm, pn; };
struct Gemm { const bf16_t* A; const bf16_t* Bt; int M, N, K; };

struct StaticOrder {
    int nM, nN, nwg, G, c;
    __host__ __device__ void init(int M, int N, int G_, int c_) { nM = M / BM; nN = N / BM; nwg = nM * nN; G = G_; c = c_; }
    __host__ __device__ bool next(int i, Unit& u) const {
        const long L = (long)i * G + c; if (L >= nwg) return false;
        int wgid = (int)L; { const int q = nwg / NXCD, r = nwg % NXCD, xcd = wgid % NXCD, off = wgid / NXCD; wgid = (xcd < r ? xcd * (q + 1) : r * (q + 1) + (xcd - r) * q) + off; }
        const int nig = WGM * nN, gid = wgid / nig, fm = gid * WGM, gsz = (nM - fm) < WGM ? (nM - fm) : WGM;
        u.pm = fm + ((wgid % nig) % gsz); u.pn = (wgid % nig) / gsz; return true;
    }
    __device__ __forceinline__ void a_ready(const Unit&) const {}
    __device__ __forceinline__ void done(const Unit&) const {}
};
__device__ __forceinline__ unsigned cvt_pk_bf16(float lo, float hi) { unsigned r; asm volatile("v_cvt_pk_bf16_f32 %0, %1, %2" : "=v"(r) : "v"(lo), "v"(hi)); return r; }
template <class Epi, class Sched, bool STAMP = false>
__device__ __forceinline__ void gemm_phase(PG8_LAS unsigned char* lds, const Gemm g, const Sched& S, const Epi& E, unsigned long long* stamps) {
    const int tid = otid(), wid = __builtin_amdgcn_readfirstlane(tid >> 6), lane = tid & 63, wr = wid >> 2, wc = wid & 3, fr = lane & 15, fq = lane >> 4;
    const int K = g.K, nt = K / BK;
    int ts_lo = 0, ts_hi = 0, nts = 0; const unsigned long long rt_entry = STAMP ? (unsigned long long)wall_clock64() : 0ull;
#define PG8_STAMP() do { if (STAMP && wid == 0 && nts < 64) { const unsigned long long _c = (unsigned long long)clock64(); \
        ts_lo = (lane == nts) ? (int)(unsigned)_c : ts_lo; ts_hi = (lane == nts) ? (int)(unsigned)(_c >> 32) : ts_hi; ++nts; } } while (0)
    PG8_STAMP();
    unsigned voffA[2], voffB[2];
#pragma unroll
    for (int i = 0; i < 2; ++i) { int R, C; stage_rc(tid * 16 + i * 8192, R, C); const int Rb = Epi::PERM ? ((R & ~31) + perm32(R & 31)) : R;
        voffA[i] = (unsigned)(R * K + C) * 2u; voffB[i] = (unsigned)(Rb * K + C) * 2u; }
    const size_t kstep = (size_t)(BK * 2);
    const size_t hstep = (size_t)HALF * K * 2;
    const size_t tstep = 2 * hstep;
    const unsigned ldsw = (unsigned)wid * 1024u;
    const int aoff = lds_byte(wr * 64 + fr, fq * 8), boff = lds_byte(wc * 32 + fr, fq * 8);
#define PG8_SA(b, h) (((b) * 2 + (h)) * HTB)
#define PG8_SB(b, h) ((4 + (b) * 2 + (h)) * HTB)
#define PG8_STAGE(bufoff, gbase, voff) do { _Pragma("unroll") for (int _i = 0; _i < 2; ++_i) \
        __builtin_amdgcn_global_load_lds((const unsigned*)((const char*)(gbase) + (voff)[_i]), (PG8_LAS unsigned*)(lds + (bufoff) + ldsw + _i * 8192), 16, 0, 0); } while (0)
#define PG8_LDA(dst, b, h) do { _Pragma("unroll") for (int m = 0; m < 4; ++m) _Pragma("unroll") for (int k = 0; k < 2; ++k) dst[m][k] = *(const PG8_LAS bf16x8*)(lds + PG8_SA(b, h) + aoff + m * 2048 + k * 1024); } while (0)
#define PG8_LDB(dst, b, h) do { _Pragma("unroll") for (int n = 0; n < 2; ++n) _Pragma("unroll") for (int k = 0; k < 2; ++k) dst[n][k] = *(const PG8_LAS bf16x8*)(lds + PG8_SB(b, h) + boff + n * 2048 + k * 1024); } while (0)
#define PG8_MMA(ai, bj, At, Bt) do { __builtin_amdgcn_s_setprio(1); _Pragma("unroll") for (int m = 0; m < 4; ++m) _Pragma("unroll") for (int n = 0; n < 2; ++n) _Pragma("unroll") for (int k = 0; k < 2; ++k) \
        acc[ai][bj][m][n] = __builtin_amdgcn_mfma_f32_16x16x32_bf16(Bt[n][k], At[m][k], acc[ai][bj][m][n], 0, 0, 0); __builtin_amdgcn_s_setprio(0); } while (0)
#define PG8_WAIT_V(n) asm volatile("s_waitcnt vmcnt(" #n ")" ::: "memory")
#define PG8_WAIT_L(n) asm volatile("s_waitcnt lgkmcnt(" #n ")" ::: "memory")
#define PG8_BAR __builtin_amdgcn_s_barrier()
#define PG8_SCHED __builtin_amdgcn_sched_barrier(0)
    Unit cur, nxt; int ui = 0;
    if (!S.next(0, cur)) return;
    f32x4 acc[2][2][4][2];
#pragma unroll
    for (int a = 0; a < 2; ++a)
#pragma unroll
        for (int b = 0; b < 2; ++b)
#pragma unroll
            for (int m = 0; m < 4; ++m)
#pragma unroll
                for (int n = 0; n < 2; ++n) acc[a][b][m][n] = (f32x4){0.f, 0.f, 0.f, 0.f};
    bf16x8 At[4][2], B0[2][2], B1[2][2];
    const char* cA = (const char*)g.A + (size_t)cur.pm * tstep; const char* cB = (const char*)g.Bt + (size_t)cur.pn * tstep;
    S.a_ready(cur);
    PG8_STAGE(PG8_SB(0, 0), cB, voffB); PG8_STAGE(PG8_SA(0, 0), cA, voffA); PG8_STAGE(PG8_SB(0, 1), cB + hstep, voffB); PG8_STAGE(PG8_SA(0, 1), cA + hstep, voffA);
    if (wr == 1) PG8_BAR;
    PG8_WAIT_V(4); PG8_BAR;
    PG8_STAGE(PG8_SB(1, 0), cB + kstep, voffB); PG8_STAGE(PG8_SA(1, 0), cA + kstep, voffA); PG8_STAGE(PG8_SB(1, 1), cB + hstep + kstep, voffB);
    PG8_WAIT_V(6); PG8_BAR;
    PG8_STAMP();
    for (;;) {
        const bool has_next = S.next(ui + 1, nxt);
        const char* nA = has_next ? (const char*)g.A + (size_t)nxt.pm * tstep : cA; const char* nB = has_next ? (const char*)g.Bt + (size_t)nxt.pn * tstep : cB;
        for (int t = 0; t < nt; t += 2) {
            const bool last = (t == nt - 2);
            const char* a1 = cA + (size_t)(t + 1) * kstep;
            const char* a2 = last ? nA : cA + (size_t)(t + 2) * kstep; const char* b2 = last ? nB : cB + (size_t)(t + 2) * kstep;
            const char* a3 = a2 + kstep; const char* b3 = b2 + kstep;
            if (last && has_next) S.a_ready(nxt);
            PG8_LDB(B0, 0, 0); PG8_SCHED; PG8_LDA(At, 0, 0); PG8_STAGE(PG8_SA(1, 1), a1 + hstep, voffA);
            PG8_WAIT_L(8); PG8_BAR; PG8_WAIT_L(0); PG8_MMA(0, 0, At, B0); PG8_BAR; PG8_SCHED;
            PG8_LDB(B1, 0, 1); PG8_STAGE(PG8_SB(0, 0), b2, voffB);
            PG8_BAR; PG8_WAIT_L(0); PG8_MMA(0, 1, At, B1); PG8_BAR;
            PG8_LDA(At, 0, 1); PG8_STAGE(PG8_SA(0, 0), a2, voffA);
            PG8_BAR; PG8_WAIT_L(0); PG8_MMA(1, 0, At, B0); PG8_BAR; PG8_SCHED;
            PG8_STAGE(PG8_SB(0, 1), b2 + hstep, voffB);
            PG8_WAIT_V(6); PG8_BAR; PG8_MMA(1, 1, At, B1); PG8_BAR;
            PG8_LDB(B0, 1, 0); PG8_SCHED; PG8_LDA(At, 1, 0); PG8_STAGE(PG8_SA(0, 1), a2 + hstep, voffA);
            PG8_WAIT_L(8); PG8_BAR; PG8_WAIT_L(0); PG8_MMA(0, 0, At, B0); PG8_BAR; PG8_SCHED;
            PG8_LDB(B1, 1, 1); PG8_STAGE(PG8_SB(1, 0), b3, voffB);
            PG8_BAR; PG8_WAIT_L(0); PG8_MMA(0, 1, At, B1); PG8_BAR;
            PG8_LDA(At, 1, 1); PG8_STAGE(PG8_SA(1, 0), a3, voffA);
            PG8_BAR; PG8_WAIT_L(0); PG8_MMA(1, 0, At, B0); PG8_BAR; PG8_SCHED;
            PG8_STAGE(PG8_SB(1, 1), b3 + hstep, voffB);
            PG8_WAIT_V(6); PG8_BAR; PG8_MMA(1, 1, At, B1); PG8_BAR;
        }
        PG8_STAMP();
        if constexpr (!Epi::AFTER_DRAIN) { E(acc, cur, wr, wc, fr, fq); S.done(cur); }
        PG8_STAMP();
        if (!has_next) break;
#pragma unroll
        for (int a = 0; a < 2; ++a)
#pragma unroll
            for (int b = 0; b < 2; ++b)
#pragma unroll
                for (int m = 0; m < 4; ++m)
#pragma unroll
                    for (int n = 0; n < 2; ++n) acc[a][b][m][n] = (f32x4){0.f, 0.f, 0.f, 0.f};
        cur = nxt; cA = nA; cB = nB; ++ui;
    }
    PG8_WAIT_V(0);
    if (wr == 0) PG8_BAR;
    PG8_BAR;
    if constexpr (Epi::AFTER_DRAIN) { E.fused(acc, cur, wr, wc, fr, fq, lds, wid, lane); S.done(cur); }
    PG8_STAMP();
    if (STAMP && wid == 0) { stamps[lane] = lane < nts ? (((unsigned long long)(unsigned)ts_hi << 32) | (unsigned)ts_lo) : 0ull;
        if (lane == 62) stamps[62] = rt_entry; if (lane == 63) stamps[63] = (unsigned long long)wall_clock64(); }
#undef PG8_STAMP
#undef PG8_SA
#undef PG8_SB
#undef PG8_STAGE
#undef PG8_LDA
#undef PG8_LDB
#undef PG8_MMA
#undef PG8_WAIT_V
#undef PG8_WAIT_L
#undef PG8_BAR
#undef PG8_SCHED
}
}

struct EpiOut {
  static constexpr bool PERM = false, AFTER_DRAIN = false;
  const float* in0; const float* in1; char* ws; int layer;
  __device__ __forceinline__ void operator()(const f32x4 (&acc)[2][2][4][2], const pg8::Unit& u, int wr, int wc, int fr, int fq) const {
    const int brow = u.pm * 256; const int row0 = brow + wr * 64 + fr, col0 = u.pn * 256 + wc * 32 + 4 * fq;
    float* X = (float*)(ws + WS_X);
    const int cv = brow < MCTX ? 0 : 1 + ((brow - MCTX) >> 10);
    const float* gate = (const float*)(ws + WS_MOD) + (layer * 3 + cv) * 3072 + 2048;
    const float* xin = layer == 0 ? (brow < MCTX ? in0 : in1 - (size_t)MCTX * 1024) : X;
    f32x4 gv[2][2];
#pragma unroll
    for (int bj = 0; bj < 2; ++bj)
#pragma unroll
      for (int n = 0; n < 2; ++n) gv[bj][n] = *(const f32x4*)(gate + col0 + bj * 128 + n * 16);
#pragma unroll
    for (int ai = 0; ai < 2; ++ai)
#pragma unroll
      for (int m = 0; m < 4; ++m) { const size_t ro = (size_t)(row0 + ai * 128 + m * 16) * 1024 + col0;
#pragma unroll
        for (int bj = 0; bj < 2; ++bj)
#pragma unroll
          for (int n = 0; n < 2; ++n) { const f32x4 xv = *(const f32x4*)(xin + ro + bj * 128 + n * 16);
            *(f32x4*)(X + ro + bj * 128 + n * 16) = xv + gv[bj][n] * acc[ai][bj][m][n]; } }
  }
};

struct EpiIn {
  static constexpr bool PERM = true, AFTER_DRAIN = false;
  const float* qg; const float* kg; float* out; char* ws; float* sSS; int layer;
  template <int KIND>
  __device__ __forceinline__ void half(const f32x4 (&acc)[2][2][4][2], const int bj, const int brow, const int pn, const bool lat, int wr, int wc, int fr, int fq) const {
    u16* U = (u16*)(ws + WS_U);
    const float* rope = (const float*)(ws + WS_ROPE);
    const int dh = (wc & 1) * 32 + 8 * fq;
    const int hd = wc >> 1;
    float gn[8];
    if (KIND <= 1) { const float* gp = (KIND == 0 ? qg : kg) + layer * 64 + dh;
      const f32x4 g0 = *(const f32x4*)gp, g1 = *(const f32x4*)(gp + 4);
      gn[0] = g0[0]; gn[1] = g0[1]; gn[2] = g0[2]; gn[3] = g0[3]; gn[4] = g1[0]; gn[5] = g1[1]; gn[6] = g1[2]; gn[7] = g1[3]; }
#pragma unroll
    for (int ai = 0; ai < 2; ++ai)
#pragma unroll
      for (int m = 0; m < 4; ++m) {
        const int rl = ai * 128 + wr * 64 + m * 16 + fr; const int row = brow + rl;
        const f32x4 v0 = acc[ai][bj][m][0], v1 = acc[ai][bj][m][1];
        float v[8] = {v0[0], v0[1], v0[2], v0[3], v1[0], v1[1], v1[2], v1[3]};
        if (KIND <= 1) {
          const float tot = sSS[(bj * 256 + rl) * 4 + wc] + sSS[(bj * 256 + rl) * 4 + (wc ^ 1)];
          const float rstd = rsqrtf(tot * (1.f / 64.f) + 1e-6f);
#pragma unroll
          for (int i = 0; i < 8; ++i) v[i] = v[i] * rstd * gn[i];
          if (KIND == 1 && !lat) { const int b = row >> 8, t = row & 255; float* op = out + (size_t)OUT_K + ((size_t)((b * 2 + layer) * 256 + t)) * 128 + hd * 64 + dh;
            *(f32x4*)op = (f32x4){v[0], v[1], v[2], v[3]}; *(f32x4*)(op + 4) = (f32x4){v[4], v[5], v[6], v[7]}; }
          if (lat) {
            const int t = (row - MCTX) & 1023; const int posv = (wc & 1) ? (t & 63) : (t >> 6);
            const float* rp = rope + (posv * 16 + 4 * fq) * 2;
            const f32x4 r0 = *(const f32x4*)rp, r1 = *(const f32x4*)(rp + 4);
            float x1, x2;
            x1 = v[0]; x2 = v[1]; v[0] = x1 * r0[0] - x2 * r0[1]; v[1] = x1 * r0[1] + x2 * r0[0];
            x1 = v[2]; x2 = v[3]; v[2] = x1 * r0[2] - x2 * r0[3]; v[3] = x1 * r0[3] + x2 * r0[2];
            x1 = v[4]; x2 = v[5]; v[4] = x1 * r1[0] - x2 * r1[1]; v[5] = x1 * r1[1] + x2 * r1[0];
            x1 = v[6]; x2 = v[7]; v[6] = x1 * r1[2] - x2 * r1[3]; v[7] = x1 * r1[3] + x2 * r1[2];
          }
          pg8::u32x4 w;
          if (KIND == 0) { w.x = pg8::cvt_pk_bf16(v[0] * 0.125f, v[1] * 0.125f); w.y = pg8::cvt_pk_bf16(v[2] * 0.125f, v[3] * 0.125f); w.z = pg8::cvt_pk_bf16(v[4] * 0.125f, v[5] * 0.125f); w.w = pg8::cvt_pk_bf16(v[6] * 0.125f, v[7] * 0.125f);
            *(pg8::u32x4*)(U + (size_t)row * DP + pn * 256 + bj * 128 + wc * 32 + 8 * fq) = w; }
          else { w.x = pg8::cvt_pk_bf16(v[0], v[1]); w.y = pg8::cvt_pk_bf16(v[2], v[3]); w.z = pg8::cvt_pk_bf16(v[4], v[5]); w.w = pg8::cvt_pk_bf16(v[6], v[7]);
            if (!lat) { const int b = row >> 8, t = row & 255; *(pg8::u32x4*)((u16*)(ws + WS_KC) + ((size_t)((b * 2 + hd) * 256 + t)) * 64 + dh) = w; }
            else { const int sb = (row - MCTX) >> 10, t = (row - MCTX) & 1023; *(pg8::u32x4*)((u16*)(ws + WS_KL) + ((size_t)(((layer * 2 + sb) * 2 + hd) * 1536 + 512 + t)) * 64 + dh) = w; } }
        } else {
          if (!lat) { const int b = row >> 8, t = row & 255; float* op = out + (size_t)OUT_V + ((size_t)((b * 2 + layer) * 256 + t)) * 128 + hd * 64 + dh;
            *(f32x4*)op = (f32x4){v[0], v[1], v[2], v[3]}; *(f32x4*)(op + 4) = (f32x4){v[4], v[5], v[6], v[7]};
            u16* vp = (u16*)(ws + WS_VC) + ((size_t)((b * 2 + hd) * 64 + dh)) * 256 + t;
#pragma unroll
            for (int i = 0; i < 8; ++i) vp[i * 256] = f2bf(v[i]); }
          else { const int sb = (row - MCTX) >> 10, t = (row - MCTX) & 1023;
            u16* vp = (u16*)(ws + WS_VL) + ((size_t)(((layer * 2 + sb) * 2 + hd) * 64 + dh)) * 1536 + 512 + t;
#pragma unroll
            for (int i = 0; i < 8; ++i) vp[i * 1536] = f2bf(v[i]); }
        }
      }
  }
  __device__ __forceinline__ void operator()(const f32x4 (&acc)[2][2][4][2], const pg8::Unit& u, int wr_, int wc_, int fr_, int fq_) const {
    int tid2; asm volatile("v_mov_b32 %0, %1" : "=v"(tid2) : "v"((int)threadIdx.x));
    const int wid = tid2 >> 6, lane = tid2 & 63, wr = wid >> 2, wc = wid & 3, fr = lane & 15, fq = lane >> 4;
    const int brow = u.pm * 256, pn = u.pn; const bool lat = brow >= MCTX;
    u16* U = (u16*)(ws + WS_U);
    if (pn >= 3) {
      const bool hy = pn >= 5 && pn < 13;
      u16* UH = (u16*)(ws + WS_UH);
      const int cg0 = (pn * 256 + wc * 32 + 8 * fq - 1280) >> 3;
      const int ucol = pn * 256 - (pn >= 13 ? 2048 : 0) + wc * 32 + 8 * fq;
#pragma unroll
      for (int ai = 0; ai < 2; ++ai)
#pragma unroll
        for (int m = 0; m < 4; ++m) { const int row = brow + ai * 128 + wr * 64 + m * 16 + fr;
#pragma unroll
          for (int bj = 0; bj < 2; ++bj) { const f32x4 v0 = acc[ai][bj][m][0], v1 = acc[ai][bj][m][1]; pg8::u32x4 w;
            w.x = pg8::cvt_pk_bf16(v0[0], v0[1]); w.y = pg8::cvt_pk_bf16(v0[2], v0[3]); w.z = pg8::cvt_pk_bf16(v1[0], v1[1]); w.w = pg8::cvt_pk_bf16(v1[2], v1[3]);
            u16* dst = hy ? UH + ((size_t)(cg0 + bj * 16) * MROWS + row) * 8 : U + (size_t)row * DP + ucol + bj * 128;
            *(pg8::u32x4*)dst = w; } }
      return;
    }
    const bool kvtile = pn == 2;
#pragma unroll
    for (int ai = 0; ai < 2; ++ai)
#pragma unroll
      for (int m = 0; m < 4; ++m)
#pragma unroll
        for (int bj = 0; bj < 2; ++bj) {
          const f32x4 v0 = acc[ai][bj][m][0], v1 = acc[ai][bj][m][1];
          float s = v0[0] * v0[0] + v0[1] * v0[1] + v0[2] * v0[2] + v0[3] * v0[3] + v1[0] * v1[0] + v1[1] * v1[1] + v1[2] * v1[2] + v1[3] * v1[3];
          s += __shfl_xor(s, 16); s += __shfl_xor(s, 32);
          if (fq == 0) sSS[(bj * 256 + ai * 128 + wr * 64 + m * 16 + fr) * 4 + wc] = s;
        }
    asm volatile("s_waitcnt lgkmcnt(0)" ::: "memory");
    __builtin_amdgcn_s_barrier();
    asm volatile("" ::: "memory");
    if (kvtile) { half<1>(acc, 0, brow, pn, lat, wr, wc, fr, fq); half<2>(acc, 1, brow, pn, lat, wr, wc, fr, fq); }
    else { half<0>(acc, 0, brow, pn, lat, wr, wc, fr, fq); half<0>(acc, 1, brow, pn, lat, wr, wc, fr, fq); }
  }
};

template <int EPI>
__device__ void gemm_phase(const P& p, const int layer, char* smem) {
  pg8::Gemm g;
  g.M = MROWS;
  if (EPI == 0) { g.A = (const u16*)(p.ws + WS_H); g.Bt = (const u16*)(p.ws + WS_WTIN) + (size_t)layer * 4352 * 1024; g.N = 4352; g.K = 1024; }
  else { g.A = (const u16*)(p.ws + WS_MIX); g.Bt = (const u16*)(p.ws + WS_WTOUT) + (size_t)layer * 1024 * 1536; g.N = 1024; g.K = 1536; }
  pg8::StaticOrder S; S.init(g.M, g.N, (int)gridDim.x, (int)blockIdx.x);
  if (EPI == 0) { EpiIn E{p.in[11], p.in[12], p.out, p.ws, (float*)(smem + 131072), layer};
    pg8::gemm_phase<EpiIn, pg8::StaticOrder, false>((PG8_LAS unsigned char*)smem, g, S, E, nullptr); }
  else { EpiOut E{p.in[0], p.in[1], p.ws, layer};
    pg8::gemm_phase<EpiOut, pg8::StaticOrder, false>((PG8_LAS unsigned char*)smem, g, S, E, nullptr); }
  __syncthreads();
}

__device__ __forceinline__ f32x4 mfma16(bf16x8 a, bf16x8 b, f32x4 c) { return __builtin_amdgcn_mfma_f32_16x16x32_bf16(a, b, c, 0, 0, 0); }

__device__ __forceinline__ void attn_softmax(f32x4 (&s)[4], f32x4 (&o)[4], float& mrun, float& lsum) {
  float mx = -1e30f;
#pragma unroll
  for (int mt = 0; mt < 4; ++mt)
#pragma unroll
    for (int r = 0; r < 4; ++r) mx = fmaxf(mx, s[mt][r]);
  mx = fmaxf(mx, __shfl_xor(mx, 16)); mx = fmaxf(mx, __shfl_xor(mx, 32));
  const float mnew = fmaxf(mrun, mx); const float alpha = __expf(mrun - mnew); mrun = mnew;
  float ps = 0.f;
#pragma unroll
  for (int mt = 0; mt < 4; ++mt)
#pragma unroll
    for (int r = 0; r < 4; ++r) { float pv = __expf(s[mt][r] - mnew); s[mt][r] = pv; ps += pv; }
  lsum = lsum * alpha + ps;
#pragma unroll
  for (int dt = 0; dt < 4; ++dt) { o[dt][0] *= alpha; o[dt][1] *= alpha; o[dt][2] *= alpha; o[dt][3] *= alpha; }
}
__device__ __forceinline__ void attn_sub2(const u16* sK, const u16* sV, const int kb, const int lr, const int g,
                                          const bf16x8 qa0, const bf16x8 qa1, const bf16x8 qb0, const bf16x8 qb1,
                                          f32x4 (&oa)[4], f32x4 (&ob)[4], float& ma, float& la, float& mb, float& lb) {
  f32x4 sa[4], sb[4];
#pragma unroll
  for (int mt = 0; mt < 4; ++mt) {
    const bf16x8 a0 = *(const bf16x8*)(sK + (kb + mt * 16 + lr) * 72 + g * 8), a1 = *(const bf16x8*)(sK + (kb + mt * 16 + lr) * 72 + 32 + g * 8);
    sa[mt] = mfma16(a0, qa0, (f32x4){0.f, 0.f, 0.f, 0.f}); sb[mt] = mfma16(a0, qb0, (f32x4){0.f, 0.f, 0.f, 0.f});
    sa[mt] = mfma16(a1, qa1, sa[mt]); sb[mt] = mfma16(a1, qb1, sb[mt]); }
  attn_softmax(sa, oa, ma, la);
  attn_softmax(sb, ob, mb, lb);
#pragma unroll
  for (int j = 0; j < 2; ++j) {
    const bf16x8 pfa = pk8(sa[2 * j][0], sa[2 * j][1], sa[2 * j][2], sa[2 * j][3], sa[2 * j + 1][0], sa[2 * j + 1][1], sa[2 * j + 1][2], sa[2 * j + 1][3]);
    const bf16x8 pfb = pk8(sb[2 * j][0], sb[2 * j][1], sb[2 * j][2], sb[2 * j][3], sb[2 * j + 1][0], sb[2 * j + 1][1], sb[2 * j + 1][2], sb[2 * j + 1][3]);
#pragma unroll
    for (int dt = 0; dt < 4; ++dt) {
      const u16* vp = sV + (dt * 16 + lr) * 272 + kb + j * 32 + g * 4;
      bf16x4 v0 = *(const bf16x4*)vp, v1 = *(const bf16x4*)(vp + 16);
      bf16x8 a; a[0] = v0[0]; a[1] = v0[1]; a[2] = v0[2]; a[3] = v0[3]; a[4] = v1[0]; a[5] = v1[1]; a[6] = v1[2]; a[7] = v1[3];
      oa[dt] = mfma16(a, pfa, oa[dt]); ob[dt] = mfma16(a, pfb, ob[dt]);
    }
  }
}
__device__ __forceinline__ void attn_sub(const u16* sK, const u16* sV, const int kb, const int lr, const int g, const bf16x8 q0, const bf16x8 q1, f32x4 (&o)[4], float& mrun, float& lsum) {
  f32x4 s[4];
#pragma unroll
  for (int mt = 0; mt < 4; ++mt) { s[mt] = (f32x4){0.f, 0.f, 0.f, 0.f};
    const bf16x8 a0 = *(const bf16x8*)(sK + (kb + mt * 16 + lr) * 72 + g * 8), a1 = *(const bf16x8*)(sK + (kb + mt * 16 + lr) * 72 + 32 + g * 8);
    s[mt] = mfma16(a0, q0, s[mt]); s[mt] = mfma16(a1, q1, s[mt]); }
  float mx = -1e30f;
#pragma unroll
  for (int mt = 0; mt < 4; ++mt)
#pragma unroll
    for (int r = 0; r < 4; ++r) mx = fmaxf(mx, s[mt][r]);
  mx = fmaxf(mx, __shfl_xor(mx, 16)); mx = fmaxf(mx, __shfl_xor(mx, 32));
  const float mnew = fmaxf(mrun, mx); const float alpha = __expf(mrun - mnew); mrun = mnew;
  float ps = 0.f;
#pragma unroll
  for (int mt = 0; mt < 4; ++mt)
#pragma unroll
    for (int r = 0; r < 4; ++r) { float pv = __expf(s[mt][r] - mnew); s[mt][r] = pv; ps += pv; }
  lsum = lsum * alpha + ps;
#pragma unroll
  for (int dt = 0; dt < 4; ++dt) { o[dt][0] *= alpha; o[dt][1] *= alpha; o[dt][2] *= alpha; o[dt][3] *= alpha; }
#pragma unroll
  for (int j = 0; j < 2; ++j) {
    const bf16x8 pf = pk8(s[2 * j][0], s[2 * j][1], s[2 * j][2], s[2 * j][3], s[2 * j + 1][0], s[2 * j + 1][1], s[2 * j + 1][2], s[2 * j + 1][3]);
#pragma unroll
    for (int dt = 0; dt < 4; ++dt) {
      const u16* vp = sV + (dt * 16 + lr) * 272 + kb + j * 32 + g * 4;
      bf16x4 v0 = *(const bf16x4*)vp, v1 = *(const bf16x4*)(vp + 16);
      bf16x8 a; a[0] = v0[0]; a[1] = v0[1]; a[2] = v0[2]; a[3] = v0[3]; a[4] = v1[0]; a[5] = v1[1]; a[6] = v1[2]; a[7] = v1[3];
      o[dt] = mfma16(a, pf, o[dt]);
    }
  }
}
__device__ __forceinline__ void attn_store(const P& p, const f32x4 (&o)[4], float lsum, const int qrow, const int h, const int g) {
  lsum += __shfl_xor(lsum, 16); lsum += __shfl_xor(lsum, 32);
  const float inv = 1.f / lsum;
  const u16* U = (const u16*)(p.ws + WS_U); u16* MIX = (u16*)(p.ws + WS_MIX);
#pragma unroll
  for (int dt = 0; dt < 4; ++dt) {
    const bf16x4 gv = *(const bf16x4*)(U + (size_t)qrow * DP + 768 + h * 64 + dt * 16 + g * 4);
    *(bf16x4*)(MIX + (size_t)qrow * DMIX + h * 64 + dt * 16 + g * 4) =
      pk4(o[dt][0] * inv * siluf(bfs(gv[0])), o[dt][1] * inv * siluf(bfs(gv[1])), o[dt][2] * inv * siluf(bfs(gv[2])), o[dt][3] * inv * siluf(bfs(gv[3])));
  }
}

__device__ void attn_item(const P& p, int layer, int lat, int sb, int h, int qt, char* smem) {
  const int tid = otid(), w = tid >> 6, lane = tid & 63, lr = lane & 15, g = lane >> 4;
  const int kvh = h >> 2;
  const int nkeys = 1536;
  const int m0 = MCTX + sb * 1024 + qt * 128;
  const u16* U = (const u16*)(p.ws + WS_U);
  const u16* Kb = (const u16*)(p.ws + WS_KL) + (size_t)((layer * 2 + sb) * 2 + kvh) * 1536 * 64;
  const u16* Vt = (const u16*)(p.ws + WS_VL) + (size_t)((layer * 2 + sb) * 2 + kvh) * 64 * 1536;
  u16* sK = (u16*)smem;
  u16* sV = sK + 256 * 72;
  const int qrow = m0 + w * 16 + lr;
  bf16x8 kr[4], vr[4];
#pragma unroll
  for (int i = 0; i < 4; ++i) { const int id = tid + i * 512; kr[i] = *(const bf16x8*)(Kb + (size_t)(id >> 3) * 64 + (id & 7) * 8); vr[i] = *(const bf16x8*)(Vt + (size_t)(id >> 5) * nkeys + (id & 31) * 8); }
  const bf16x8 q0 = *(const bf16x8*)(U + (size_t)qrow * DP + h * 64 + g * 8), q1 = *(const bf16x8*)(U + (size_t)qrow * DP + h * 64 + 32 + g * 8);
  f32x4 o[4];
#pragma unroll
  for (int i = 0; i < 4; ++i) o[i] = (f32x4){0.f, 0.f, 0.f, 0.f};
  float mrun = -1e30f, lsum = 0.f;
#pragma unroll 1
  for (int step = 0; step < 6; ++step) {
    __syncthreads();
#pragma unroll
    for (int i = 0; i < 4; ++i) { const int id = tid + i * 512; *(bf16x8*)(sK + (id >> 3) * 72 + (id & 7) * 8) = kr[i]; *(bf16x8*)(sV + (id >> 5) * 272 + (id & 31) * 8) = vr[i]; }
    if (step + 1 < 6) { const int k0 = (step + 1) * 256;
#pragma unroll
      for (int i = 0; i < 4; ++i) { const int id = tid + i * 512; kr[i] = *(const bf16x8*)(Kb + (size_t)(k0 + (id >> 3)) * 64 + (id & 7) * 8); vr[i] = *(const bf16x8*)(Vt + (size_t)(id >> 5) * nkeys + k0 + (id & 31) * 8); } }
    __syncthreads();
#pragma unroll
    for (int sub = 0; sub < 4; ++sub) attn_sub(sK, sV, sub * 64, lr, g, q0, q1, o, mrun, lsum);
  }
  attn_store(p, o, lsum, qrow, h, g);
  __syncthreads();
}

__device__ void attn_ctx_item(const P& p, int layer, int b, int kvh, int qt, char* smem) {
  const int tid = otid(), w = tid >> 6, lane = tid & 63, lr = lane & 15, g = lane >> 4;
  const int qg = w & 3, hp = w >> 2;
  const int m0 = b * 256 + qt * 64;
  const u16* U = (const u16*)(p.ws + WS_U);
  const u16* Kb = (const u16*)(p.ws + WS_KC) + (size_t)(b * 2 + kvh) * 256 * 64;
  const u16* Vt = (const u16*)(p.ws + WS_VC) + (size_t)(b * 2 + kvh) * 64 * 256;
  u16* sK = (u16*)smem;
  u16* sV = sK + 256 * 72;
  const int qrow = m0 + qg * 16 + lr;
  bf16x8 kr[4], vr[4];
#pragma unroll
  for (int i = 0; i < 4; ++i) { const int id = tid + i * 512; kr[i] = *(const bf16x8*)(Kb + (size_t)(id >> 3) * 64 + (id & 7) * 8); vr[i] = *(const bf16x8*)(Vt + (size_t)(id >> 5) * 256 + (id & 31) * 8); }
  const int h0 = kvh * 4 + hp * 2;
  const bf16x8 qa0 = *(const bf16x8*)(U + (size_t)qrow * DP + h0 * 64 + g * 8), qa1 = *(const bf16x8*)(U + (size_t)qrow * DP + h0 * 64 + 32 + g * 8);
  const bf16x8 qb0 = *(const bf16x8*)(U + (size_t)qrow * DP + (h0 + 1) * 64 + g * 8), qb1 = *(const bf16x8*)(U + (size_t)qrow * DP + (h0 + 1) * 64 + 32 + g * 8);
  __syncthreads();
#pragma unroll
  for (int i = 0; i < 4; ++i) { const int id = tid + i * 512; *(bf16x8*)(sK + (id >> 3) * 72 + (id & 7) * 8) = kr[i]; *(bf16x8*)(sV + (id >> 5) * 272 + (id & 31) * 8) = vr[i]; }
  __syncthreads();
  f32x4 oa[4], ob[4];
#pragma unroll
  for (int i = 0; i < 4; ++i) { oa[i] = (f32x4){0.f, 0.f, 0.f, 0.f}; ob[i] = (f32x4){0.f, 0.f, 0.f, 0.f}; }
  float ma = -1e30f, la = 0.f, mb = -1e30f, lb = 0.f;
#pragma unroll 2
  for (int sub = 0; sub < 4; ++sub) attn_sub2(sK, sV, sub * 64, lr, g, qa0, qa1, qb0, qb1, oa, ob, ma, la, mb, lb);
  attn_store(p, oa, la, qrow, h0, g);
  attn_store(p, ob, lb, qrow, h0 + 1, g);
  __syncthreads();
}

template <int L, int NSEQ, int CPI>
__device__ void hyena_item(const P& p, int layer, int m0, int c0, char* smem) {
  constexpr int SEL = (L == 1024) ? 1 : 0, NB = L / 16, KS = (NB + 16) / 2, PAD = 256, ZL = L + 2 * PAD, RO = L + 32, CL = 2 * L + 32, CLS = 2 * L + 48, RRL = 2 * L + 48;
  u16* zb = (u16*)smem;
  u16* cp = zb + 8 * NSEQ * ZL;
  u16* rr = cp + CPI * 8 * CLS;
  float* sInv = (float*)(rr + 8 * RRL);
  const int tid = otid(), w = tid >> 6, lane = tid & 63, lr = lane & 15, g = lane >> 4;
  const float* HF = (const float*)(p.ws + WS_HF) + (size_t)layer * HF_LSTRIDE + (SEL ? 256 * HFS : 0);
  const float* NP = (const float*)(p.ws + WS_NP) + (layer * 2 + SEL) * 32 * 1024;
  const u16* UH = (const u16*)(p.ws + WS_UH);
  u16* MIX = (u16*)(p.ws + WS_MIX);
  const float* sw = p.in[13] + layer * 3 * 1536; const float* sbias = p.in[14] + layer * 1536;
  const int sq = tid / (L / 4), t4 = tid % (L / 4);
  const size_t rowb = (size_t)(m0 + sq * L);
  bf16x8 lx1[6], lhv[6], lx0[6], lgv[4];
#pragma unroll
  for (int r6 = 0; r6 < 6; ++r6) { const int t = min(max(t4 * 4 + r6 - 1, 0), L - 1);
    lx1[r6] = __builtin_nontemporal_load((const bf16x8*)(UH + ((size_t)((512 + c0) >> 3) * MROWS + rowb + t) * 8)); lhv[r6] = __builtin_nontemporal_load((const bf16x8*)(UH + ((size_t)((1024 + c0) >> 3) * MROWS + rowb + t) * 8)); lx0[r6] = __builtin_nontemporal_load((const bf16x8*)(UH + ((size_t)(c0 >> 3) * MROWS + rowb + t) * 8)); }
#pragma unroll
  for (int tt = 0; tt < 4; ++tt) lgv[tt] = __builtin_nontemporal_load((const bf16x8*)(UH + ((size_t)((1536 + c0) >> 3) * MROWS + rowb + t4 * 4 + tt) * 8));
  asm volatile("" ::: "memory");
  if (tid < 8) { float s = 0.f; for (int ch = 0; ch < L / 32; ++ch) s += NP[ch * 1024 + c0 + tid] + NP[ch * 1024 + 512 + c0 + tid]; sInv[tid] = 1.f / s; sInv[8 + tid] = p.in[22][layer * 512 + c0 + tid]; }
  for (int e = tid; e < 8 * NSEQ * 64; e += NT) { const int cs = e >> 6, q = e & 63; const int off = q < 32 ? q * 8 : PAD + L + (q - 32) * 8;
    *(bf16x8*)(zb + cs * ZL + off) = (bf16x8){0, 0, 0, 0, 0, 0, 0, 0}; }
  for (int y = tid; y < RRL; y += NT) { const int d = RO - y; float v[8];
    if (d > -L && d < L) { const float* src = HF + (size_t)(d >= 0 ? d : -d) * HFS + (d >= 0 ? 0 : 512) + c0; const float4 a = *(const float4*)src, b = *(const float4*)(src + 4);
      v[0] = a.x; v[1] = a.y; v[2] = a.z; v[3] = a.w; v[4] = b.x; v[5] = b.y; v[6] = b.z; v[7] = b.w; }
    else {
#pragma unroll
      for (int i = 0; i < 8; ++i) v[i] = 0.f; }
#pragma unroll
    for (int i = 0; i < 8; ++i) rr[i * RRL + y] = f2bf(v[i]); }
  { float wx[3][8], wv[3][8], bx8[8], bv8[8];
#pragma unroll
    for (int j = 0; j < 3; ++j) { const float4 a = *(const float4*)(sw + j * 1536 + 512 + c0), b = *(const float4*)(sw + j * 1536 + 512 + c0 + 4), c = *(const float4*)(sw + j * 1536 + 1024 + c0), d = *(const float4*)(sw + j * 1536 + 1024 + c0 + 4);
      wx[j][0] = a.x; wx[j][1] = a.y; wx[j][2] = a.z; wx[j][3] = a.w; wx[j][4] = b.x; wx[j][5] = b.y; wx[j][6] = b.z; wx[j][7] = b.w;
      wv[j][0] = c.x; wv[j][1] = c.y; wv[j][2] = c.z; wv[j][3] = c.w; wv[j][4] = d.x; wv[j][5] = d.y; wv[j][6] = d.z; wv[j][7] = d.w; }
    { const float4 a = *(const float4*)(sbias + 512 + c0), b = *(const float4*)(sbias + 512 + c0 + 4), c = *(const float4*)(sbias + 1024 + c0), d = *(const float4*)(sbias + 1024 + c0 + 4);
      bx8[0] = a.x; bx8[1] = a.y; bx8[2] = a.z; bx8[3] = a.w; bx8[4] = b.x; bx8[5] = b.y; bx8[6] = b.z; bx8[7] = b.w;
      bv8[0] = c.x; bv8[1] = c.y; bv8[2] = c.z; bv8[3] = c.w; bv8[4] = d.x; bv8[5] = d.y; bv8[6] = d.z; bv8[7] = d.w; }
    float ax[4][8], av[4][8];
#pragma unroll
    for (int tt = 0; tt < 4; ++tt)
#pragma unroll
      for (int i = 0; i < 8; ++i) { ax[tt][i] = bx8[i]; av[tt][i] = bv8[i]; }
#pragma unroll
    for (int rr6 = 0; rr6 < 6; ++rr6) { const int t = t4 * 4 + rr6 - 1;
      if (t >= 0 && t < L) { const bf16x8 x1 = lx1[rr6], hv = lhv[rr6];
#pragma unroll
        for (int tt = 0; tt < 4; ++tt) { const int j = rr6 - tt;
          if (j >= 0 && j < 3) {
#pragma unroll
            for (int i = 0; i < 8; ++i) { ax[tt][i] += bfs(x1[i]) * wx[j][i]; av[tt][i] += bfs(hv[i]) * wv[j][i]; } } } } }
#pragma unroll
    for (int i = 0; i < 8; ++i)
      *(bf16x4*)(zb + (i * NSEQ + sq) * ZL + PAD + t4 * 4) = pk4(ax[0][i] * av[0][i], ax[1][i] * av[1][i], ax[2][i] * av[2][i], ax[3][i] * av[3][i]); }
  float ex[4][8];
  { float w0[3][8], b08[8];
#pragma unroll
    for (int j = 0; j < 3; ++j) { const float4 a = *(const float4*)(sw + j * 1536 + c0), b = *(const float4*)(sw + j * 1536 + c0 + 4);
      w0[j][0] = a.x; w0[j][1] = a.y; w0[j][2] = a.z; w0[j][3] = a.w; w0[j][4] = b.x; w0[j][5] = b.y; w0[j][6] = b.z; w0[j][7] = b.w; }
    { const float4 a = *(const float4*)(sbias + c0), b = *(const float4*)(sbias + c0 + 4); b08[0] = a.x; b08[1] = a.y; b08[2] = a.z; b08[3] = a.w; b08[4] = b.x; b08[5] = b.y; b08[6] = b.z; b08[7] = b.w; }
#pragma unroll
    for (int tt = 0; tt < 4; ++tt)
#pragma unroll
      for (int i = 0; i < 8; ++i) ex[tt][i] = b08[i];
#pragma unroll
    for (int rr6 = 0; rr6 < 6; ++rr6) { const int t = t4 * 4 + rr6 - 1;
      if (t >= 0 && t < L) { const bf16x8 x0 = lx0[rr6];
#pragma unroll
        for (int tt = 0; tt < 4; ++tt) { const int j = rr6 - tt;
          if (j >= 0 && j < 3) {
#pragma unroll
            for (int i = 0; i < 8; ++i) ex[tt][i] += bfs(x0[i]) * w0[j][i]; } } } } }
  __syncthreads();
  const int seq = NSEQ == 2 ? (w >> 2) : w, nt = NSEQ == 2 ? (w & 3) : 0;
  const int Dlo = 16 * nt - NB + 1; const int sh = (-lr) & 7;
  const int a0 = sh * CLS + 8 * (g & 1) - lr - sh - 16 * (Dlo + (g >> 1)) + RO;
  const int b0 = PAD + 16 * (16 * nt + lr - Dlo - (g >> 1)) + 8 * (g & 1);
  f32x4 acc[CPI];
#pragma unroll
  for (int c = 0; c < CPI; ++c) acc[c] = (f32x4){0.f, 0.f, 0.f, 0.f};
  for (int itc = 0; itc <= 8 / CPI; ++itc) {
    if (itc < 8 / CPI) {
#pragma unroll
      for (int c = 0; c < CPI; ++c) { const u16* rc = rr + (itc * CPI + c) * RRL; u16* cpc = cp + c * 8 * CLS;
        for (int chunk = tid; chunk < CL; chunk += NT) { const int k = chunk / (CL / 8), q8 = chunk % (CL / 8); bf16x8 o;
#pragma unroll
          for (int i = 0; i < 8; ++i) o[i] = (short)rc[8 * q8 + k + i];
          *(bf16x8*)(cpc + k * CLS + 8 * q8) = o; } } }
    if (itc > 0) {
#pragma unroll
      for (int c = 0; c < CPI; ++c) { const int chp = (itc - 1) * CPI + (CPI == 2 ? (w >> 2) : c); const int sq_ = CPI == 2 ? 2 * (w & 3) + c : seq;
        u16* zp = zb + (chp * NSEQ + sq_) * ZL + PAD + 16 * (16 * nt + lr) + 4 * g; const float bs = sInv[8 + chp];
        const bf16x4 zv = *(const bf16x4*)zp;
        const float iv = sInv[chp];
        *(bf16x4*)zp = pk4(acc[c][0] * iv + bs * bfs(zv[0]), acc[c][1] * iv + bs * bfs(zv[1]), acc[c][2] * iv + bs * bfs(zv[2]), acc[c][3] * iv + bs * bfs(zv[3])); } }
    __syncthreads();
    if (itc == 8 / CPI) break;
    if (CPI == 1) {
      const u16* zc = zb + (itc * NSEQ + seq) * ZL;
      f32x4 accA = (f32x4){0.f, 0.f, 0.f, 0.f}, accB = (f32x4){0.f, 0.f, 0.f, 0.f};
#pragma unroll 4
      for (int ks = 0; ks < KS; ks += 2) { const bf16x8 a = *(const bf16x8*)(cp + a0 - 32 * ks), b = *(const bf16x8*)(zc + b0 - 32 * ks);
        const bf16x8 a2 = *(const bf16x8*)(cp + a0 - 32 * ks - 32), b2 = *(const bf16x8*)(zc + b0 - 32 * ks - 32);
        accA = mfma16(a, b, accA); accB = mfma16(a2, b2, accB); }
      acc[0] = accA + accB;
    } else {
      const int cw = w >> 2, sp2 = w & 3;
      const u16* zc0 = zb + ((itc * CPI + cw) * NSEQ + 2 * sp2) * ZL; const u16* zc1 = zc0 + ZL; const u16* cpw = cp + cw * 8 * CLS;
      f32x4 accA = (f32x4){0.f, 0.f, 0.f, 0.f}, accB = (f32x4){0.f, 0.f, 0.f, 0.f};
#pragma unroll 4
      for (int ks = 0; ks < KS; ++ks) { const bf16x8 a = *(const bf16x8*)(cpw + a0 - 32 * ks), b = *(const bf16x8*)(zc0 + b0 - 32 * ks), b2 = *(const bf16x8*)(zc1 + b0 - 32 * ks);
        accA = mfma16(a, b, accA); accB = mfma16(a, b2, accB); }
      acc[0] = accA; acc[CPI - 1] = accB;
    }
    __syncthreads();
  }
  { bf16x4 yz[8];
#pragma unroll
    for (int i = 0; i < 8; ++i) yz[i] = *(const bf16x4*)(zb + (i * NSEQ + sq) * ZL + PAD + t4 * 4);
#pragma unroll
    for (int tt = 0; tt < 4; ++tt) { const bf16x8 gv = lgv[tt]; float of[8];
#pragma unroll
      for (int i = 0; i < 8; ++i) of[i] = ex[tt][i] * bfs(yz[i][tt]) * siluf(bfs(gv[i]));
      *(bf16x8*)(MIX + (rowb + t4 * 4 + tt) * DMIX + 512 + c0) = pk8(of[0], of[1], of[2], of[3], of[4], of[5], of[6], of[7]); } }
  __syncthreads();
}

template <int NTL>
__device__ void lru_item(const P& p, int layer, int lat, int sb, int n, int qd, char* smem) {
  const int L = lat ? 1024 : 256; const int m0 = lat ? MCTX + sb * 1024 : sb * 256;
  const int tid = otid(), w = tid >> 6, lane = tid & 63, lr = lane & 15, g = lane >> 4;
  u16* sW = (u16*)smem;
  float* sCw = (float*)(smem + 18432);
  constexpr bool XC = (NTL == 4);
  float* sX = (float*)(smem + 18432 + 1280);
  u16* sXc = (u16*)(smem + 18432 + 1280);
  float* sTot = (float*)(smem + 18432 + 1280 + (XC ? 36864 : 33280));
  float* sCar = sTot + 2048;
  float* sYf = sCar + 128;
  constexpr int YS = NTL * 16 + 1;
  const u16* U = (const u16*)(p.ws + WS_U);
  u16* MIX = (u16*)(p.ws + WS_MIX);
  const u16* WGT = (const u16*)(p.ws + WS_WGT);
  const int chb = n * 64; const int cq = qd * 16;
  if (tid < 320) sCw[tid] = tid < 256 ? p.in[23][layer * 4 * 512 + (tid >> 6) * 512 + chb + (tid & 63)] : p.in[24][layer * 512 + chb + tid - 256];
  const int nch = L >> 7;
#pragma unroll 1
  for (int dir = 0; dir < 2; ++dir) {
    __syncthreads();
    for (int e = tid; e < 1024; e += NT) { const int gate = e >> 9, d = (e >> 3) & 63, part = e & 7;
      *(bf16x8*)(sW + (gate * 64 + d) * 72 + part * 8) = *(const bf16x8*)(WGT + ((size_t)((((layer * 2 + dir) * 2 + gate) * 8 + n) * 64 + d)) * 64 + part * 8); }
    if (tid < 16 * NTL) sCar[tid] = lat ? p.in[4][((sb * 2 + layer) * 2 + dir) * 512 + chb + cq + tid] : 0.f;
    float ba[NTL], bx[NTL], sp[NTL];
#pragma unroll
    for (int nt = 0; nt < NTL; ++nt) { const int dch = (layer * 2 + dir) * 512 + chb + cq + nt * 16 + lr; ba[nt] = p.in[26][dch]; bx[nt] = p.in[28][dch]; sp[nt] = -8.f * log1pf(expf(-p.in[29][dch])); }
    __syncthreads();
    bf16x8 xin[2][4];
    if (!(XC && dir == 1)) { const int pA = w * 16 + lr; const int tA = dir ? L - 1 - pA : pA;
#pragma unroll
      for (int ks = 0; ks < 2; ++ks)
#pragma unroll
        for (int j = 0; j < 4; ++j) { const int tt = min(max(tA + j - 1, 0), L - 1); xin[ks][j] = *(const bf16x8*)(U + (size_t)(m0 + tt) * DP + 1280 + chb + ks * 32 + g * 8); } }
#pragma unroll 1
    for (int ci = 0; ci < nch; ++ci) {
      const int par = ci & 1; const int pbase = ci * 128 + w * 16;
      const int pA = pbase + lr; const int tA = dir ? L - 1 - pA : pA;
      bf16x8 af[2];
      if (XC && dir == 1) {
#pragma unroll
        for (int ks = 0; ks < 2; ++ks) af[ks] = *(const bf16x8*)(sXc + tA * 72 + ks * 32 + g * 8);
      } else
#pragma unroll
      for (int ks = 0; ks < 2; ++ks) {
        const int cb = ks * 32 + g * 8; float a8[8];
#pragma unroll
        for (int i = 0; i < 8; ++i) a8[i] = sCw[256 + cb + i];
#pragma unroll
        for (int j = 0; j < 4; ++j) { const int tt = tA + j - 1; const float msk = (tt >= 0 && tt < L) ? 1.f : 0.f;
#pragma unroll
          for (int i = 0; i < 8; ++i) a8[i] += msk * bfs(xin[ks][j][i]) * sCw[j * 64 + cb + i]; }
        af[ks] = pk8(a8[0], a8[1], a8[2], a8[3], a8[4], a8[5], a8[6], a8[7]);
        if (XC) *(bf16x8*)(sXc + tA * 72 + cb) = af[ks];
        else {
#pragma unroll
          for (int i = 0; i < 8; ++i) sX[(w * 16 + lr) * 65 + cb + i] = a8[i]; }
      }
      if (ci + 1 < nch && !(XC && dir == 1)) { const int pN = pA + 128; const int tN = dir ? L - 1 - pN : pN;
#pragma unroll
        for (int ks = 0; ks < 2; ++ks)
#pragma unroll
          for (int j = 0; j < 4; ++j) { const int tt = min(max(tN + j - 1, 0), L - 1); xin[ks][j] = *(const bf16x8*)(U + (size_t)(m0 + tt) * DP + 1280 + chb + ks * 32 + g * 8); } }
      float Ap[NTL][4], Bp[NTL][4];
#pragma unroll
      for (int nt = 0; nt < NTL; ++nt) {
        f32x4 pr = (f32x4){0.f, 0.f, 0.f, 0.f}, pi = (f32x4){0.f, 0.f, 0.f, 0.f};
#pragma unroll
        for (int ks = 0; ks < 2; ++ks) { const bf16x8 wr_ = *(const bf16x8*)(sW + (cq + nt * 16 + lr) * 72 + ks * 32 + g * 8), wi_ = *(const bf16x8*)(sW + (64 + cq + nt * 16 + lr) * 72 + ks * 32 + g * 8);
          pr = mfma16(af[ks], wr_, pr); pi = mfma16(af[ks], wi_, pi); }
#pragma unroll
        for (int r = 0; r < 4; ++r) {
          float x;
          if (XC) { const int pq = pbase + 4 * g + r; const int tq = dir ? L - 1 - pq : pq; x = bf2f(sXc[tq * 72 + cq + nt * 16 + lr]); }
          else x = sX[(w * 16 + 4 * g + r) * 65 + cq + nt * 16 + lr];
          const float rr_ = sigm(pr[r] + ba[nt]), ii = sigm(pi[r] + bx[nt]);
          const float la = rr_ * sp[nt]; const float a = fexp(la); const float om = 1.f - a * a; const float b = __builtin_amdgcn_sqrtf(fmaxf(om, 0.f)) * ii * x;
          if (r == 0) { Ap[nt][0] = a; Bp[nt][0] = b; } else { Ap[nt][r] = a * Ap[nt][r - 1]; Bp[nt][r] = a * Bp[nt][r - 1] + b; }
        }
      }
      float EA[NTL], EB[NTL], TA[NTL], TB[NTL];
#pragma unroll
      for (int nt = 0; nt < NTL; ++nt) { EA[nt] = 1.f; EB[nt] = 0.f; TA[nt] = 1.f; TB[nt] = 0.f;
#pragma unroll
        for (int k = 0; k < 4; ++k) { const float ak = __int_as_float(__builtin_amdgcn_ds_bpermute((lr + 16 * k) * 4, __float_as_int(Ap[nt][3]))), bk = __int_as_float(__builtin_amdgcn_ds_bpermute((lr + 16 * k) * 4, __float_as_int(Bp[nt][3])));
          if (k < g) { EB[nt] = ak * EB[nt] + bk; EA[nt] = ak * EA[nt]; }
          TB[nt] = ak * TB[nt] + bk; TA[nt] = ak * TA[nt]; }
        if (g == 0) { sTot[((par * 8 + w) * 2 + 0) * 64 + nt * 16 + lr] = TA[nt]; sTot[((par * 8 + w) * 2 + 1) * 64 + nt * 16 + lr] = TB[nt]; } }
      float yv[NTL][4]; u16 gl[NTL][4];
      if (dir == 1) {
#pragma unroll
        for (int nt = 0; nt < NTL; ++nt)
#pragma unroll
          for (int r = 0; r < 4; ++r) { const int pp = pbase + 4 * g + r; const int t = L - 1 - pp;
            yv[nt][r] = sYf[t * YS + nt * 16 + lr]; gl[nt][r] = U[(size_t)(m0 + t) * DP + 1792 + chb + cq + nt * 16 + lr]; } }
      __syncthreads();
#pragma unroll
      for (int nt = 0; nt < NTL; ++nt) {
        float hin = sCar[par * 64 + nt * 16 + lr];
        float ak7[7], bk7[7];
#pragma unroll
        for (int k = 0; k < 7; ++k) { ak7[k] = sTot[((par * 8 + k) * 2 + 0) * 64 + nt * 16 + lr]; bk7[k] = sTot[((par * 8 + k) * 2 + 1) * 64 + nt * 16 + lr]; }
#pragma unroll
        for (int k = 0; k < 7; ++k) { const float tnew = ak7[k] * hin + bk7[k]; hin = (k < w) ? tnew : hin; }
        if (w == 7 && g == 0) sCar[(par ^ 1) * 64 + nt * 16 + lr] = TA[nt] * hin + TB[nt];
        const float hg = EA[nt] * hin + EB[nt];
        const int dch = chb + cq + nt * 16 + lr;
#pragma unroll
        for (int r = 0; r < 4; ++r) {
          const float hv = Ap[nt][r] * hg + Bp[nt][r];
          const int pp = pbase + 4 * g + r; const int t = dir ? L - 1 - pp : pp;
          if (dir == 0) sYf[t * YS + nt * 16 + lr] = hv;
          else MIX[(size_t)(m0 + t) * DMIX + 1024 + dch] = f2bf((yv[nt][r] + hv) * siluf(bf2f(gl[nt][r])));
          if (!lat && pp == L - 1) p.out[(size_t)OUT_LRU + ((sb * 2 + layer) * 2 + dir) * 512 + dch] = hv;
        }
      }
    }
  }
  __syncthreads();
}

__device__ void mixers_phase(const P& p, int layer, char* smem, int rep = 0) {
  __shared__ int s_item;
  int* cnt = (int*)(p.ws + WS_CNT) + layer + 2 * rep;
  if (otid() == 0) s_item = atomicAdd(cnt, 1);
  __syncthreads();
  int it = s_item;
  __syncthreads();
  while (it < 1024) {
    int nxt = 0;
    if (otid() == 0) nxt = atomicAdd(cnt, 1);
    if (it < 64) { for (int r = 0; r < REP_LRU; ++r) lru_item<1>(p, layer, 1, it >> 5, (it >> 2) & 7, it & 3, smem); }
    else if (it < 128) { const int i = it - 64; for (int r = 0; r < REP_HY; ++r) hyena_item<1024, 2, 1>(p, layer, MCTX, i * 8, smem); }
    else if (it < 256) { const int i = it - 128; for (int r = 0; r < REP_AT; ++r) attn_item(p, layer, 1, i >> 6, (i >> 3) & 7, i & 7, smem); }
    else if (it < 512) { const int i = it - 256; for (int r = 0; r < REP_HY; ++r) hyena_item<256, 8, 2>(p, layer, (i >> 6) * 2048, (i & 63) * 8, smem); }
    else if (it < 768) { const int i = it - 512; for (int r = 0; r < REP_LRU; ++r) lru_item<4>(p, layer, 0, i >> 3, i & 7, 0, smem); }
    else { const int i = it - 768; for (int r = 0; r < REP_AT; ++r) attn_ctx_item(p, layer, i >> 3, (i >> 2) & 1, i & 3, smem); }
    if (otid() == 0) s_item = nxt;
    __syncthreads();
    it = s_item;
    __syncthreads();
  }
}

#define XB_TMO      128
#define XB_XCNT(j)  (256  + 64 * (j))
#define XB_XSUB(j)  (1280 + 64 * (j))
#define XB_XGEN(j)  (2304 + 64 * (j))
#define XB_TOP      3328
#define XB_TOPGEN   3392
#define XCD_BAR_WORDS 3456
#define XB_SPIN_CAP (1u << 18)
#define LAS __attribute__((address_space(3)))

__device__ __forceinline__ unsigned xb_ld(unsigned* p)              { return __hip_atomic_load(p, __ATOMIC_RELAXED, __HIP_MEMORY_SCOPE_AGENT); }
__device__ __forceinline__ unsigned xb_add(unsigned* p, unsigned v) { return __hip_atomic_fetch_add(p, v, __ATOMIC_RELAXED, __HIP_MEMORY_SCOPE_AGENT); }
__device__ __forceinline__ unsigned xb_xcc_id() { return (unsigned)__builtin_amdgcn_s_getreg((3 << 11) | 20) & 0xFu; }
#define XB_SPIN(cond, bar) do { unsigned _sp = 0; while (cond) { __builtin_amdgcn_s_sleep(1); \
    if ((++_sp & 255u) == 0u) { if (xb_ld(&(bar)[XB_TMO])) break; if (_sp > XB_SPIN_CAP) { atomicAdd(&(bar)[XB_TMO], 1u); break; } } } } while (0)

struct XcdBarrier {
    unsigned* bar; unsigned x;
    volatile LAS unsigned* st;
};

__device__ __forceinline__ XcdBarrier xcd_barrier_post(unsigned* bar, volatile LAS unsigned* st) {
    XcdBarrier b; b.bar = bar; b.x = xb_xcc_id(); b.st = st;
    if (threadIdx.x == 0) (void)xb_add(&bar[XB_XCNT(b.x)], 1u);
    return b;
}
__device__ __forceinline__ void xcd_barrier_complete(unsigned* bar, unsigned x, unsigned& nloc, unsigned& nx) {
    const unsigned G = gridDim.x * gridDim.y * gridDim.z;
    unsigned sum, cnt, mine, sp = 0u;
    for (;;) {
        sum = 0u; cnt = 0u; mine = 0u;
#pragma unroll
        for (unsigned j = 0; j < 16; ++j) { const unsigned c = xb_ld(&bar[XB_XCNT(j)]); sum += c; cnt += (c > 0u) ? 1u : 0u; mine = (j == x) ? c : mine; }
        if (sum == G) break;
        __builtin_amdgcn_s_sleep(1);
        if ((++sp & 255u) == 0u) { if (xb_ld(&bar[XB_TMO])) break; if (sp > XB_SPIN_CAP) { atomicAdd(&bar[XB_TMO], 1u); break; } }
    }
    nloc = mine > 0u ? mine : 1u; nx = cnt > 0u ? cnt : 1u;
}

__device__ __forceinline__ void xcd_barrier(const XcdBarrier& b) {
    asm volatile("s_waitcnt vmcnt(0)" ::: "memory");
    __syncthreads();
    if (threadIdx.x == 0) {
        unsigned* bar = b.bar;
        __builtin_amdgcn_s_waitcnt(0);
        unsigned nloc = b.st[0], nx = b.st[1];
        if (nloc == 0u) { xcd_barrier_complete(bar, b.x, nloc, nx); b.st[0] = nloc; b.st[1] = nx; }
        const unsigned old = xb_add(&bar[XB_XSUB(b.x)], 1u);
        const unsigned gen = old / nloc;
        if (old + 1u == (gen + 1u) * nloc) {
            __builtin_amdgcn_fence(__ATOMIC_RELEASE, "agent");
            asm volatile("s_waitcnt vmcnt(0)" ::: "memory");
            const unsigned og = xb_add(&bar[XB_TOP], 1u);
            const unsigned tg = og / nx;
            if (og + 1u == (tg + 1u) * nx) xb_add(&bar[XB_TOPGEN], 1u);
            else XB_SPIN(xb_ld(&bar[XB_TOPGEN]) == tg, bar);
            __builtin_amdgcn_fence(__ATOMIC_ACQUIRE, "agent");
            xb_add(&bar[XB_XGEN(b.x)], 1u);
            asm volatile("s_waitcnt vmcnt(0)" ::: "memory");
        } else {
            XB_SPIN(xb_ld(&bar[XB_XGEN(b.x)]) == gen, bar);
            __builtin_amdgcn_fence(__ATOMIC_ACQUIRE, "agent");
            asm volatile("s_waitcnt vmcnt(0)" ::: "memory");
        }
    }
    __syncthreads();
}


#ifndef MULTI
#define MULTI 0
#endif
#ifndef REP_NORM
#define REP_NORM 1
#endif
#ifndef REP_G0
#define REP_G0 1
#endif
#ifndef REP_MIX
#define REP_MIX 1
#endif
#ifndef REP_P0
#define REP_P0 1
#endif
#if MULTI
#ifndef XK
#define XK -1
#endif
#ifndef XN
#define XN 0
#endif
__global__ void __launch_bounds__(NT) k_phase0(P p) { extern __shared__ __attribute__((aligned(16))) char smem[]; phase0(p, smem); }
__global__ void __launch_bounds__(NT) k_prep1(P p) { extern __shared__ __attribute__((aligned(16))) char smem[]; phase0_items<1, 2>(p, smem); }
__global__ void __launch_bounds__(NT) k_norm(P p, int layer) { norm_phase(p, layer); }
__global__ void __launch_bounds__(NT) k_gemm0(P p, int layer) { extern __shared__ __attribute__((aligned(16))) char smem[]; gemm_phase<0>(p, layer, smem); }
__global__ void __launch_bounds__(NT) k_gemm1(P p, int layer) { extern __shared__ __attribute__((aligned(16))) char smem[]; gemm_phase<1>(p, layer, smem); }
__global__ void __launch_bounds__(NT) k_hy_lat(P p, int layer) { extern __shared__ __attribute__((aligned(16))) char smem[];
  for (int it = blockIdx.x; it < 64; it += gridDim.x) hyena_item<1024, 2, 1>(p, layer, MCTX, it * 8, smem); }
__global__ void __launch_bounds__(NT) k_hy_ctx(P p, int layer) { extern __shared__ __attribute__((aligned(16))) char smem[];
  for (int i = blockIdx.x; i < 256; i += gridDim.x) hyena_item<256, 8, 2>(p, layer, (i >> 6) * 2048, (i & 63) * 8, smem); }
__global__ void __launch_bounds__(NT) k_attn_lat(P p, int layer) { extern __shared__ __attribute__((aligned(16))) char smem[];
  for (int it = blockIdx.x; it < 128; it += gridDim.x) attn_item(p, layer, 1, it >> 6, (it >> 3) & 7, it & 7, smem); }
__global__ void __launch_bounds__(NT) k_attn_ctx(P p, int layer) { extern __shared__ __attribute__((aligned(16))) char smem[];
  for (int i = blockIdx.x; i < 256; i += gridDim.x) attn_ctx_item(p, layer, i >> 3, (i >> 2) & 1, i & 3, smem); }
__global__ void __launch_bounds__(NT) k_lru_lat(P p, int layer) { extern __shared__ __attribute__((aligned(16))) char smem[];
  for (int it = blockIdx.x; it < 64; it += gridDim.x) lru_item<1>(p, layer, 1, it >> 5, (it >> 2) & 7, it & 3, smem); }
__global__ void __launch_bounds__(NT) k_lru_ctx(P p, int layer) { extern __shared__ __attribute__((aligned(16))) char smem[];
  for (int i = blockIdx.x; i < 256; i += gridDim.x) lru_item<4>(p, layer, 0, i >> 3, i & 7, 0, smem); }
#else
__global__ void __launch_bounds__(NT) mega(P p) {
  extern __shared__ __attribute__((aligned(16))) char smem[];
  __shared__ uint4 xb_words;
  cg::grid_group grid = cg::this_grid();
  if (threadIdx.x == 0) xb_words = make_uint4(0u, 0u, 0u, 0u);
  __syncthreads();
  (void)xcd_barrier_post((unsigned*)(p.ws + WS_BAR), (volatile LAS unsigned*)&xb_words);
#define GRID_BAR() do { XcdBarrier xb_; xb_.bar = (unsigned*)(p.ws + WS_BAR); xb_.x = xb_xcc_id(); xb_.st = (volatile LAS unsigned*)&xb_words; xcd_barrier(xb_); } while (0)
  phase0(p, smem);
  if (p.ws == nullptr) grid.sync();
  GRID_BAR();
#pragma unroll 1
  for (int layer_ = 0; layer_ < 2; ++layer_) {
    const int layer = osgpr(layer_);
#pragma unroll 1
    for (int rep = 0; rep < REP_NORM; ++rep) { norm_phase(p, osgpr(layer)); GRID_BAR(); }
    gemm_phase<0>(p, osgpr(layer), smem);
    if (layer == 0 && ((int)gridDim.x <= 168 || (int)blockIdx.x >= 168)) phase0_items<0, 1>(p, smem);
    GRID_BAR();
#pragma unroll 1
    for (int rep = 0; rep < REP_MIX; ++rep) { mixers_phase(p, osgpr(layer), smem, osgpr(rep)); GRID_BAR(); }
    gemm_phase<1>(p, osgpr(layer), smem);
    if (layer == 0 && ((int)gridDim.x <= 160 || (int)blockIdx.x >= 160)) phase0_items<1, 2>(p, smem);
    GRID_BAR();
  }
  norm_phase(p, 2);
}
#endif

extern "C" void kernel_launch(void* const* d_in, const int* in_sizes, int n_in, void* d_out, int out_size, void* d_ws, size_t ws_size, hipStream_t stream) {
  static int grid = 0;
  if (grid == 0) {
    if (n_in != 32 || ws_size < WS_END) { fprintf(stderr, "kernel_launch: unexpected n_in %d / ws %zu (need %zu)\n", n_in, ws_size, (size_t)WS_END); grid = -1; return; }
    int dev = 0, cus = 0, per_cu = 0;
    (void)hipGetDevice(&dev);
    (void)hipDeviceGetAttribute(&cus, hipDeviceAttributeMultiprocessorCount, dev);
#if MULTI
    const void* ks[] = {(const void*)k_phase0, (const void*)k_prep1, (const void*)k_gemm0, (const void*)k_gemm1, (const void*)k_hy_lat, (const void*)k_hy_ctx, (const void*)k_attn_lat, (const void*)k_attn_ctx, (const void*)k_lru_lat, (const void*)k_lru_ctx};
    for (int i = 0; i < 10; ++i) if (hipFuncSetAttribute(ks[i], hipFuncAttributeMaxDynamicSharedMemorySize, LDS_BYTES) != hipSuccess) { fprintf(stderr, "hipFuncSetAttribute failed\n"); grid = -1; return; }
    (void)per_cu;
#else
    if (hipFuncSetAttribute((const void*)mega, hipFuncAttributeMaxDynamicSharedMemorySize, LDS_BYTES) != hipSuccess) { fprintf(stderr, "hipFuncSetAttribute failed\n"); grid = -1; return; }
    if (hipOccupancyMaxActiveBlocksPerMultiprocessor(&per_cu, (const void*)mega, NT, LDS_BYTES) != hipSuccess || per_cu < 1) { fprintf(stderr, "occupancy query failed (%d)\n", per_cu); grid = -1; return; }
#endif
    grid = cus;
  }
  if (grid < 0) return;
  (void)hipMemsetAsync((char*)d_ws + WS_CNT, 0, 256 + 13824, stream);
  P prm{};
  for (int i = 0; i < 32; ++i) prm.in[i] = (const float*)d_in[i];
  prm.out = (float*)d_out; prm.ws = (char*)d_ws;
#if MULTI
  k_phase0<<<grid, NT, LDS_BYTES, stream>>>(prm);
  k_prep1<<<grid, NT, LDS_BYTES, stream>>>(prm);
  for (int layer = 0; layer < 2; ++layer) {
    for (int x = 0; x < 1 + (XK == 0 ? XN : 0); ++x) k_norm<<<grid, NT, 0, stream>>>(prm, layer);
    for (int x = 0; x < 1 + (XK == 1 ? XN : 0); ++x) k_gemm0<<<grid, NT, LDS_BYTES, stream>>>(prm, layer);
    for (int x = 0; x < 1 + (XK == 2 ? XN : 0); ++x) k_hy_lat<<<64, NT, LDS_BYTES, stream>>>(prm, layer);
    for (int x = 0; x < 1 + (XK == 3 ? XN : 0); ++x) k_hy_ctx<<<grid, NT, LDS_BYTES, stream>>>(prm, layer);
    for (int x = 0; x < 1 + (XK == 4 ? XN : 0); ++x) k_attn_lat<<<grid, NT, LDS_BYTES, stream>>>(prm, layer);
    for (int x = 0; x < 1 + (XK == 5 ? XN : 0); ++x) k_attn_ctx<<<grid, NT, LDS_BYTES, stream>>>(prm, layer);
    for (int x = 0; x < 1 + (XK == 6 ? XN : 0); ++x) k_lru_lat<<<64, NT, LDS_BYTES, stream>>>(prm, layer);
    for (int x = 0; x < 1 + (XK == 7 ? XN : 0); ++x) k_lru_ctx<<<grid, NT, LDS_BYTES, stream>>>(prm, layer);
    k_gemm1<<<grid, NT, LDS_BYTES, stream>>>(prm, layer);
  }
  k_norm<<<grid, NT, 0, stream>>>(prm, 2);
#else
  void* args[] = {&prm};
  hipError_t e = hipLaunchCooperativeKernel((const void*)mega, dim3(grid), dim3(NT), args, LDS_BYTES, stream);
  if (e != hipSuccess) fprintf(stderr, "cooperative launch failed: %s (grid %d)\n", hipGetErrorString(e), grid);
#endif
}
```
